# Optimizing an MI355X kernel written in HIP

```python
import jax
import jax.numpy as jnp
from jax import lax

D_MODEL = 1024
BATCH = 8
SEQ = 4096
DEPTH = 4

CTX_LEN = 256
GRID_W = 64
N_MIXERS = 2
N_NA_LAYERS = (DEPTH + N_MIXERS - 1) // N_MIXERS
N_LRU_LAYERS = DEPTH // N_MIXERS
N_HEADS = 16
HEAD_DIM = D_MODEL // N_HEADS
WIN_ROWS = 8
WIN_COLS = 16
Q_BLOCK_W = 16
K_BLOCK_W = Q_BLOCK_W + WIN_COLS
D_RNN = D_MODEL
LRU_BLOCKS = 16
LRU_BLOCK_W = D_RNN // LRU_BLOCKS
LRU_CONV_W = 4
LRU_C = 8.0
D_FF = 3 * D_MODEL
FFN_CONV_W = 3
N_MODS = 6
EPS = 1e-6

kernel_name = 'hybrid_na_rglru_diffusion_block'


def rms_norm(t, gain):
    tf = t.astype(jnp.float32)
    y = tf * lax.rsqrt(jnp.mean(tf * tf, axis=-1, keepdims=True) + EPS)
    return (y * gain.astype(jnp.float32)).astype(t.dtype)


def modulate(t, gain, shift, scale):
    return rms_norm(t, gain) * (1.0 + scale[:, None, :]) + shift[:, None, :]


def depthwise_conv_centred(t, w, b):
    width, length = w.shape[0], t.shape[1]
    left = width // 2
    tp = jnp.pad(t, ((0, 0), (left, width - 1 - left), (0, 0)))
    y = b + tp[:, 0:length] * w[0]
    for k in range(1, width):
        y = y + tp[:, k:k + length] * w[k]
    return y


def neighbourhood_attention(q, k, v, kc, vc, rpb):
    B, S, H, Dh = q.shape
    rows = S // GRID_W
    wr = min(WIN_ROWS, rows)
    n_cb = GRID_W // Q_BLOCK_W
    scale = Dh ** -0.5
    qg = q.reshape(B, rows, GRID_W, H, Dh)
    kg = k.reshape(B, rows, GRID_W, H, Dh)
    vg = v.reshape(B, rows, GRID_W, H, Dh)
    n_lat = wr * K_BLOCK_W

    def attend_block(idx):
        r = idx // n_cb
        q0 = (idx % n_cb) * Q_BLOCK_W
        rs = jnp.clip(r - WIN_ROWS // 2, 0, rows - wr)
        ks = jnp.clip(q0 - WIN_COLS // 2, 0, GRID_W - K_BLOCK_W)
        qb = lax.dynamic_slice(qg, (0, r, q0, 0, 0), (B, 1, Q_BLOCK_W, H, Dh))[:, 0]
        kb = lax.dynamic_slice(kg, (0, rs, ks, 0, 0), (B, wr, K_BLOCK_W, H, Dh)).reshape(B, n_lat, H, Dh)
        vb = lax.dynamic_slice(vg, (0, rs, ks, 0, 0), (B, wr, K_BLOCK_W, H, Dh)).reshape(B, n_lat, H, Dh)
        q_col = q0 + jnp.arange(Q_BLOCK_W)
        win_start = jnp.clip(q_col - WIN_COLS // 2, 0, GRID_W - WIN_COLS)
        k_col = ks + jnp.arange(K_BLOCK_W)
        col_ok = (k_col[None, :] >= win_start[:, None]) & (k_col[None, :] < win_start[:, None] + WIN_COLS)
        mask = jnp.broadcast_to(col_ok[:, None, :], (Q_BLOCK_W, wr, K_BLOCK_W)).reshape(Q_BLOCK_W, n_lat)
        d_row = rs + jnp.arange(wr) - r + (WIN_ROWS - 1)
        d_col = jnp.clip(k_col[None, :] - q_col[:, None] + (WIN_COLS - 1), 0, 2 * WIN_COLS - 2)
        bias = rpb[:, d_row[None, :, None], d_col[:, None, :]].reshape(H, Q_BLOCK_W, n_lat)
        s_lat = jnp.einsum('bqhd,bkhd->bhqk', qb, kb).astype(jnp.float32) * scale + bias.astype(jnp.float32)[None]
        s_lat = jnp.where(mask[None, None], s_lat, -jnp.inf)
        s_ctx = jnp.einsum('bqhd,bkhd->bhqk', qb, kc).astype(jnp.float32) * scale
        p = jax.nn.softmax(jnp.concatenate([s_lat, s_ctx], axis=-1), axis=-1).astype(v.dtype)
        return (jnp.einsum('bhqk,bkhd->bqhd', p[..., :n_lat], vb)
                + jnp.einsum('bhqk,bkhd->bqhd', p[..., n_lat:], vc))

    out = lax.map(attend_block, jnp.arange(rows * n_cb))
    out = out.reshape(rows, n_cb, B, Q_BLOCK_W, H, Dh).transpose(2, 0, 1, 3, 4, 5)
    return out.reshape(B, S, H * Dh)


def context_attention(qc, kc, vc):
    s = jnp.einsum('bqhd,bkhd->bhqk', qc, kc).astype(jnp.float32) * (qc.shape[-1] ** -0.5)
    p = jax.nn.softmax(s, axis=-1).astype(vc.dtype)
    o = jnp.einsum('bhqk,bkhd->bqhd', p, vc)
    return o.reshape(qc.shape[0], qc.shape[1], -1)


def na_mixer(h, hc, w_qkv, q_gain, k_gain, rpb, w_out, with_ctx):
    B, S, D = h.shape
    qkv = (h @ w_qkv).reshape(B, S, 3, N_HEADS, HEAD_DIM)
    q = rms_norm(qkv[:, :, 0], q_gain)
    k = rms_norm(qkv[:, :, 1], k_gain)
    v = qkv[:, :, 2]
    C = hc.shape[1]
    if with_ctx:
        qkv_c = (hc @ w_qkv).reshape(B, C, 3, N_HEADS, HEAD_DIM)
        qc = rms_norm(qkv_c[:, :, 0], q_gain)
        kc = rms_norm(qkv_c[:, :, 1], k_gain)
        vc = qkv_c[:, :, 2]
    else:
        kv_c = (hc @ w_qkv[:, D:]).reshape(B, C, 2, N_HEADS, HEAD_DIM)
        kc = rms_norm(kv_c[:, :, 0], k_gain)
        vc = kv_c[:, :, 1]
    y = neighbourhood_attention(q, k, v, kc, vc, rpb) @ w_out
    yc = context_attention(qc, kc, vc) @ w_out if with_ctx else None
    return y, yc


def block_diag_linear(t, w, b):
    tb = t.reshape(t.shape[:-1] + (LRU_BLOCKS, LRU_BLOCK_W))
    return jnp.einsum('blnd,nde->blne', tb, w).reshape(t.shape) + b


def _lru_combine(left, right):
    a_l, b_l = left
    a_r, b_r = right
    return a_l * a_r, a_r * b_l + b_r


def rglru(xr, wa, ba, wx, bx, lam, h0, reverse):
    xf = xr.astype(jnp.float32)
    r = jax.nn.sigmoid(block_diag_linear(xf, wa.astype(jnp.float32), ba.astype(jnp.float32)))
    i = jax.nn.sigmoid(block_diag_linear(xf, wx.astype(jnp.float32), bx.astype(jnp.float32)))
    log_a = -LRU_C * r * jax.nn.softplus(-lam.astype(jnp.float32))
    a = jnp.exp(log_a)
    b = jnp.sqrt(-jnp.expm1(2.0 * log_a)) * (i * xf)
    if h0 is not None:
        first = -1 if reverse else 0
        b = b.at[:, first].add(a[:, first] * h0.astype(jnp.float32))
    _, hs = lax.associative_scan(_lru_combine, (a, b), axis=1, reverse=reverse)
    return hs.astype(xr.dtype)


def lru_mixer(h, hc, w_in, conv_w, conv_b, ga_w, ga_b, gx_w, gx_b, lam, w_out, with_ctx):
    gate, rec = jnp.split(h @ w_in, 2, axis=-1)
    xr = depthwise_conv_centred(rec, conv_w, conv_b)
    if with_ctx:
        gate_c, rec_c = jnp.split(hc @ w_in, 2, axis=-1)
    else:
        rec_c = hc @ w_in[:, D_RNN:]
    xr_c = depthwise_conv_centred(rec_c, conv_w, conv_b)
    hs_c_f = rglru(xr_c, ga_w[0], ga_b[0], gx_w[0], gx_b[0], lam[0], None, False)
    hs_f = rglru(xr, ga_w[0], ga_b[0], gx_w[0], gx_b[0], lam[0], hs_c_f[:, -1], False)
    hs_c_b = rglru(xr_c, ga_w[1], ga_b[1], gx_w[1], gx_b[1], lam[1], None, True)
    hs_b = rglru(xr, ga_w[1], ga_b[1], gx_w[1], gx_b[1], lam[1], hs_c_b[:, 0], True)
    y = ((hs_f + hs_b) * jax.nn.gelu(gate, approximate=True)) @ w_out
    yc = ((hs_c_f + hs_c_b) * jax.nn.gelu(gate_c, approximate=True)) @ w_out if with_ctx else None
    return y, yc


def conv_ffn(t, w_up, conv_w, conv_b, w_down):
    u = depthwise_conv_centred(t @ w_up, conv_w, conv_b)
    val, gate = jnp.split(u, 2, axis=-1)
    return (val * jax.nn.silu(gate)) @ w_down


def setup_inputs(seed: int = 0) -> dict:
    key = jax.random.key(seed)
    ks = jax.random.split(key, 32)
    f32 = jnp.float32

    def nrm(k, shape, scale):
        return jax.random.normal(k, shape, f32) * scale

    L, NA, NL = DEPTH, N_NA_LAYERS, N_LRU_LAYERS
    u = jax.random.uniform(ks[20], (NL, 2, D_RNN), f32, 0.9, 0.999)
    a_base = u ** (1.0 / LRU_C)
    lam = jnp.log(a_base) - jnp.log1p(-a_base)
    return {
        'x': nrm(ks[0], (BATCH, SEQ, D_MODEL), 1.0),
        'c': nrm(ks[1], (BATCH, D_MODEL), 1.0),
        'ctx': nrm(ks[2], (BATCH, CTX_LEN, D_MODEL), 1.0),
        'c_ctx': nrm(ks[3], (D_MODEL,), 1.0),
        'ada_w': nrm(ks[4], (L, D_MODEL, N_MODS * D_MODEL), 0.5 * D_MODEL ** -0.5),
        'ada_b': nrm(ks[5], (L, N_MODS * D_MODEL), 0.02),
        'norm_mix': 1.0 + nrm(ks[6], (L, D_MODEL), 0.02),
        'norm_ffn': 1.0 + nrm(ks[7], (L, D_MODEL), 0.02),
        'na_w_qkv': nrm(ks[8], (NA, D_MODEL, 3 * D_MODEL), D_MODEL ** -0.5),
        'na_q_gain': 1.0 + nrm(ks[9], (NA, HEAD_DIM), 0.02),
        'na_k_gain': 1.0 + nrm(ks[10], (NA, HEAD_DIM), 0.02),
        'na_rpb': nrm(ks[11], (NA, N_HEADS, 2 * WIN_ROWS - 1, 2 * WIN_COLS - 1), 0.5),
        'na_w_out': nrm(ks[12], (NA, D_MODEL, D_MODEL), D_MODEL ** -0.5),
        'lru_w_in': nrm(ks[13], (NL, D_MODEL, 2 * D_RNN), D_MODEL ** -0.5),
        'lru_conv_w': nrm(ks[14], (NL, LRU_CONV_W, D_RNN), LRU_CONV_W ** -0.5),
        'lru_conv_b': nrm(ks[15], (NL, D_RNN), 0.02),
        'lru_ga_w': nrm(ks[16], (NL, 2, LRU_BLOCKS, LRU_BLOCK_W, LRU_BLOCK_W), LRU_BLOCK_W ** -0.5),
        'lru_ga_b': nrm(ks[17], (NL, 2, D_RNN), 0.02),
        'lru_gx_w': nrm(ks[18], (NL, 2, LRU_BLOCKS, LRU_BLOCK_W, LRU_BLOCK_W), LRU_BLOCK_W ** -0.5),
        'lru_gx_b': nrm(ks[19], (NL, 2, D_RNN), 0.02),
        'lru_lambda': lam,
        'lru_w_out': nrm(ks[21], (NL, D_RNN, D_MODEL), D_RNN ** -0.5),
        'ffn_w_up': nrm(ks[22], (L, D_MODEL, 2 * D_FF), D_MODEL ** -0.5),
        'ffn_conv_w': nrm(ks[23], (L, FFN_CONV_W, 2 * D_FF), FFN_CONV_W ** -0.5),
        'ffn_conv_b': nrm(ks[24], (L, 2 * D_FF), 0.02),
        'ffn_w_down': nrm(ks[25], (L, D_FF, D_MODEL), D_FF ** -0.5),
    }


def reference(x, c, ctx, c_ctx, ada_w, ada_b, norm_mix, norm_ffn,
              na_w_qkv, na_q_gain, na_k_gain, na_rpb, na_w_out,
              lru_w_in, lru_conv_w, lru_conv_b, lru_ga_w, lru_ga_b,
              lru_gx_w, lru_gx_b, lru_lambda, lru_w_out,
              ffn_w_up, ffn_conv_w, ffn_conv_b, ffn_w_down):
    s_lat = jax.nn.silu(c)
    s_ctx = jax.nn.silu(c_ctx)[None]
    for i in range(DEPTH):
        last = i == DEPTH - 1
        j = i // N_MIXERS
        sh1, sc1, g1, sh2, sc2, g2 = jnp.split(s_lat @ ada_w[i] + ada_b[i], N_MODS, axis=-1)
        csh1, csc1, cg1, csh2, csc2, cg2 = jnp.split(s_ctx @ ada_w[i] + ada_b[i], N_MODS, axis=-1)
        h = modulate(x, norm_mix[i], sh1, sc1)
        hc = modulate(ctx, norm_mix[i], csh1, csc1)
        if i % N_MIXERS == 0:
            y, yc = na_mixer(h, hc, na_w_qkv[j], na_q_gain[j], na_k_gain[j], na_rpb[j],
                             na_w_out[j], not last)
        else:
            y, yc = lru_mixer(h, hc, lru_w_in[j], lru_conv_w[j], lru_conv_b[j],
                              lru_ga_w[j], lru_ga_b[j], lru_gx_w[j], lru_gx_b[j],
                              lru_lambda[j], lru_w_out[j], not last)
        x = x + g1[:, None] * y
        h = modulate(x, norm_ffn[i], sh2, sc2)
        x = x + g2[:, None] * conv_ffn(h, ffn_w_up[i], ffn_conv_w[i], ffn_conv_b[i], ffn_w_down[i])
        if not last:
            ctx = ctx + cg1[:, None] * yc
            hc = modulate(ctx, norm_ffn[i], csh2, csc2)
            ctx = ctx + cg2[:, None] * conv_ffn(hc, ffn_w_up[i], ffn_conv_w[i], ffn_conv_b[i], ffn_w_down[i])
    return x
```

```cpp
#include <hip/hip_runtime.h>
#include <hip/hip_cooperative_groups.h>
#include <cstdio>
#include <cstdint>
namespace cg = cooperative_groups;
#define MULTI_LAUNCH 1
namespace pg8 {
#define PG8_LAS __attribute__((address_space(3)))
typedef unsigned short bf16_t;
typedef short bf16x8 __attribute__((ext_vector_type(8)));
typedef float f32x4 __attribute__((ext_vector_type(4)));
typedef unsigned u32x4 __attribute__((ext_vector_type(4)));
constexpr int BM = 256, BK = 64, HALF = 128, HTB = HALF * BK * 2  , STAGE_BYTES = 8 * HTB, NXCD = 8, WGM = 8;

__host__ __device__ __forceinline__ int lds_byte(int r, int c) { const int st = (r >> 4) * 2 + (c >> 5), rr = r & 15, cc = c & 31, ob = rr * 64 + cc * 2; return st * 1024 + (ob ^ (((ob >> 9) & 1) << 5)); }
__host__ __device__ __forceinline__ void stage_rc(int b, int& R, int& C) { const int st = b / 1024, sb = b % 1024, swz = sb ^ (((sb >> 9) & 1) << 5); R = (st >> 1) * 16 + swz / 64; C = (st & 1) * 32 + (swz % 64) / 2; }
__host__ __device__ __forceinline__ int perm32(int rho) { const int n = rho >> 4, i = rho & 15; return 8 * (i >> 2) + 4 * n + (i & 3); }

struct Unit { int pm, pn; };
struct Gemm { const bf16_t* A; const bf16_t* Bt; int M, N, K; };

struct StaticOrder {
    int nM, nN, nwg, G, c;
    __host__ __device__ void init(int M, int N, int G_, int c_) { nM = M / BM; nN = N / BM; nwg = nM * nN; G = G_; c = c_; }
    __host__ __device__ bool next(int i, Unit& u) const {
        const long L = (long)i * G + c; if (L >= nwg) return false;
        int wgid = (int)L; { const int q = nwg / NXCD, r = nwg % NXCD, xcd = wgid % NXCD, off = wgid / NXCD; wgid = (xcd < r ? xcd * (q + 1) : r * (q + 1) + (xcd - r) * q) + off; }
        const int nig = WGM * nN, gid = wgid / nig, fm = gid * WGM, gsz = (nM - fm) < WGM ? (nM - fm) : WGM;
        u.pm = fm + ((wgid % nig) % gsz); u.pn = (wgid % nig) / gsz; return true;
    }
    __device__ __forceinline__ void a_ready(const Unit&) const {}
    __device__ __forceinline__ void done(const Unit&) const {}
};
__device__ __forceinline__ unsigned cvt_pk_bf16(float lo, float hi) { unsigned r; asm volatile("v_cvt_pk_bf16_f32 %0, %1, %2" : "=v"(r) : "v"(lo), "v"(hi)); return r; }
template <class Epi, class Sched>
__device__ __forceinline__ void gemm_phase(PG8_LAS unsigned char* lds, const Gemm g, const Sched& S, const Epi& E) {
    const int tid = threadIdx.x, wid = __builtin_amdgcn_readfirstlane(tid >> 6), lane = tid & 63, wr = wid >> 2, wc = wid & 3, fr = lane & 15, fq = lane >> 4;
    const int K = g.K, nt = K / BK;
    unsigned voffA[2], voffB[2];
#pragma unroll
    for (int i = 0; i < 2; ++i) { int R, C; stage_rc(tid * 16 + i * 8192, R, C); const int Rb = Epi::PERM ? ((R & ~31) + perm32(R & 31)) : R;
        voffA[i] = (unsigned)(R * K + C) * 2u; voffB[i] = (unsigned)(Rb * K + C) * 2u; }
    const size_t kstep = (size_t)(BK * 2);
    const size_t hstep = (size_t)HALF * K * 2;
    const size_t tstep = 2 * hstep;
    const unsigned ldsw = (unsigned)wid * 1024u;
    const int aoff = lds_byte(wr * 64 + fr, fq * 8), boff = lds_byte(wc * 32 + fr, fq * 8);
#define PG8_SA(b, h) (((b) * 2 + (h)) * HTB)
#define PG8_SB(b, h) ((4 + (b) * 2 + (h)) * HTB)
#define PG8_STAGE(bufoff, gbase, voff) do { _Pragma("unroll") for (int _i = 0; _i < 2; ++_i) \
        __builtin_amdgcn_global_load_lds((const unsigned*)((const char*)(gbase) + (voff)[_i]), (PG8_LAS unsigned*)(lds + (bufoff) + ldsw + _i * 8192), 16, 0, 0); } while (0)
#define PG8_LDA(dst, b, h) do { _Pragma("unroll") for (int m = 0; m < 4; ++m) _Pragma("unroll") for (int k = 0; k < 2; ++k) dst[m][k] = *(const PG8_LAS bf16x8*)(lds + PG8_SA(b, h) + aoff + m * 2048 + k * 1024); } while (0)
#define PG8_LDB(dst, b, h) do { _Pragma("unroll") for (int n = 0; n < 2; ++n) _Pragma("unroll") for (int k = 0; k < 2; ++k) dst[n][k] = *(const PG8_LAS bf16x8*)(lds + PG8_SB(b, h) + boff + n * 2048 + k * 1024); } while (0)
#define PG8_MMA(ai, bj, At, Bt) do { __builtin_amdgcn_s_setprio(1); _Pragma("unroll") for (int m = 0; m < 4; ++m) _Pragma("unroll") for (int n = 0; n < 2; ++n) _Pragma("unroll") for (int k = 0; k < 2; ++k) \
        acc[ai][bj][m][n] = __builtin_amdgcn_mfma_f32_16x16x32_bf16(Bt[n][k], At[m][k], acc[ai][bj][m][n], 0, 0, 0); __builtin_amdgcn_s_setprio(0); } while (0)
#define PG8_WAIT_V(n) asm volatile("s_waitcnt vmcnt(" #n ")" ::: "memory")
#define PG8_WAIT_L(n) asm volatile("s_waitcnt lgkmcnt(" #n ")" ::: "memory")
#define PG8_BAR __builtin_amdgcn_s_barrier()
#define PG8_SCHED __builtin_amdgcn_sched_barrier(0)
    Unit cur, nxt; int ui = 0;
    if (!S.next(0, cur)) return;
    f32x4 acc[2][2][4][2];
#pragma unroll
    for (int a = 0; a < 2; ++a)
#pragma unroll
        for (int b = 0; b < 2; ++b)
#pragma unroll
            for (int m = 0; m < 4; ++m)
#pragma unroll
                for (int n = 0; n < 2; ++n) acc[a][b][m][n] = (f32x4){0.f, 0.f, 0.f, 0.f};
    bf16x8 At[4][2], B0[2][2], B1[2][2];
    const char* cA = (const char*)g.A + (size_t)cur.pm * tstep; const char* cB = (const char*)g.Bt + (size_t)cur.pn * tstep;
    S.a_ready(cur);
    PG8_STAGE(PG8_SB(0, 0), cB, voffB); PG8_STAGE(PG8_SA(0, 0), cA, voffA); PG8_STAGE(PG8_SB(0, 1), cB + hstep, voffB); PG8_STAGE(PG8_SA(0, 1), cA + hstep, voffA);
    if (wr == 1) PG8_BAR;
    PG8_WAIT_V(4); PG8_BAR;
    PG8_STAGE(PG8_SB(1, 0), cB + kstep, voffB); PG8_STAGE(PG8_SA(1, 0), cA + kstep, voffA); PG8_STAGE(PG8_SB(1, 1), cB + hstep + kstep, voffB);
    PG8_WAIT_V(6); PG8_BAR;
    for (;;) {
        const bool has_next = S.next(ui + 1, nxt);
        const char* nA = has_next ? (const char*)g.A + (size_t)nxt.pm * tstep : cA; const char* nB = has_next ? (const char*)g.Bt + (size_t)nxt.pn * tstep : cB;
        for (int t = 0; t < nt; t += 2) {
            const bool last = (t == nt - 2);
            const char* a1 = cA + (size_t)(t + 1) * kstep;
            const char* a2 = last ? nA : cA + (size_t)(t + 2) * kstep; const char* b2 = last ? nB : cB + (size_t)(t + 2) * kstep;
            const char* a3 = a2 + kstep; const char* b3 = b2 + kstep;
            if (last && has_next) S.a_ready(nxt);
            PG8_LDB(B0, 0, 0); PG8_SCHED; PG8_LDA(At, 0, 0); PG8_STAGE(PG8_SA(1, 1), a1 + hstep, voffA);
            PG8_WAIT_L(8); PG8_BAR; PG8_WAIT_L(0); PG8_MMA(0, 0, At, B0); PG8_BAR; PG8_SCHED;
            PG8_LDB(B1, 0, 1); PG8_STAGE(PG8_SB(0, 0), b2, voffB);
            PG8_BAR; PG8_WAIT_L(0); PG8_MMA(0, 1, At, B1); PG8_BAR;
            PG8_LDA(At, 0, 1); PG8_STAGE(PG8_SA(0, 0), a2, voffA);
            PG8_BAR; PG8_WAIT_L(0); PG8_MMA(1, 0, At, B0); PG8_BAR; PG8_SCHED;
            PG8_STAGE(PG8_SB(0, 1), b2 + hstep, voffB);
            PG8_WAIT_V(6); PG8_BAR; PG8_MMA(1, 1, At, B1); PG8_BAR;
            PG8_LDB(B0, 1, 0); PG8_SCHED; PG8_LDA(At, 1, 0); PG8_STAGE(PG8_SA(0, 1), a2 + hstep, voffA);
            PG8_WAIT_L(8); PG8_BAR; PG8_WAIT_L(0); PG8_MMA(0, 0, At, B0); PG8_BAR; PG8_SCHED;
            PG8_LDB(B1, 1, 1); PG8_STAGE(PG8_SB(1, 0), b3, voffB);
            PG8_BAR; PG8_WAIT_L(0); PG8_MMA(0, 1, At, B1); PG8_BAR;
            PG8_LDA(At, 1, 1); PG8_STAGE(PG8_SA(1, 0), a3, voffA);
            PG8_BAR; PG8_WAIT_L(0); PG8_MMA(1, 0, At, B0); PG8_BAR; PG8_SCHED;
            PG8_STAGE(PG8_SB(1, 1), b3 + hstep, voffB);
            PG8_WAIT_V(6); PG8_BAR; PG8_MMA(1, 1, At, B1); PG8_BAR;
        }
        if constexpr (!Epi::AFTER_DRAIN) { E(acc, cur, wr, wc, fr, fq); S.done(cur); }
        if (!has_next) break;
#pragma unroll
        for (int a = 0; a < 2; ++a)
#pragma unroll
            for (int b = 0; b < 2; ++b)
#pragma unroll
                for (int m = 0; m < 4; ++m)
#pragma unroll
                    for (int n = 0; n < 2; ++n) acc[a][b][m][n] = (f32x4){0.f, 0.f, 0.f, 0.f};
        cur = nxt; cA = nA; cB = nB; ++ui;
    }
    PG8_WAIT_V(0);
    if (wr == 0) PG8_BAR;
    PG8_BAR;
    if constexpr (Epi::AFTER_DRAIN) { E.fused(acc, cur, wr, wc, fr, fq, lds, wid, lane); S.done(cur); }
#undef PG8_SA
#undef PG8_SB
#undef PG8_STAGE
#undef PG8_LDA
#undef PG8_LDB
#undef PG8_MMA
#undef PG8_WAIT_V
#undef PG8_WAIT_L
#undef PG8_BAR
#undef PG8_SCHED
}
}

using pg8::bf16_t; using pg8::bf16x8; using pg8::f32x4; using pg8::u32x4;
#define LAS __attribute__((address_space(3)))
typedef float f32x16 __attribute__((ext_vector_type(16)));
typedef unsigned u32x2 __attribute__((ext_vector_type(2)));

constexpr int DM = 1024, NB = 8, SEQ = 4096, CTXL = 256, ML = NB * SEQ, MC = NB * CTXL, MT = ML + MC, NH = 16, HD = 64, DFF = 3072;
constexpr int NCHUNK = 34;
constexpr float EPSN = 1e-6f;
constexpr size_t MiB = (size_t)1 << 20, MEL = (size_t)1 << 20;
constexpr size_t WS_MODS = 0, WS_SUM = 1 * MiB, WS_BDW = 9 * MiB, WS_CTXR = 10 * MiB, WS_WB = 18 * MiB, WS_HN = 118 * MiB, WS_R = 186 * MiB, WS_END = 510 * MiB;
constexpr size_t R_Q = 0, R_K = (size_t)MT * DM, R_VT = 2 * (size_t)MT * DM;
constexpr size_t R_GATE = 0, R_REC = (size_t)MT * DM, R_XR = 2 * (size_t)MT * DM, R_YP = 3 * (size_t)MT * DM;
constexpr size_t R_U = 0, R_G = (size_t)18432 * 6144;
constexpr int LDS_BYTES = 147456;

enum { OP_PRO = 0, OP_NORM, OP_GQK, OP_GST, OP_GRES, OP_ATTN, OP_LCONV, OP_LRUA, OP_LRUC, OP_FCONV };
#define FFN_OPS(i) {OP_NORM, i, 1, 1}, {OP_GST, i, 2, 1}, {OP_FCONV, i, 2, 1}, {OP_GRES, i, 2, 0}, {OP_GST, i, 3, 1}, {OP_FCONV, i, 3, 1}, {OP_GRES, i, 3, 1}
#define NA_OPS(i) {OP_NORM, i, 0, 1}, {OP_GQK, i, 0, 0}, {OP_GST, i, 0, 1}, {OP_ATTN, i, 0, 1}, {OP_GRES, i, 0, 1}, FFN_OPS(i)
#define LRU_OPS(i) {OP_NORM, i, 0, 1}, {OP_GST, i, 1, 1}, {OP_LCONV, i, 0, 1}, {OP_LRUA, i, 0, 1}, {OP_LRUC, i, 0, 1}, {OP_GRES, i, 0, 1}, FFN_OPS(i)
__device__ const int PROG[][4] = { {OP_PRO, 0, 0, 1}, NA_OPS(0), LRU_OPS(1), NA_OPS(2), LRU_OPS(3) };
constexpr int NPROG = 1 + 12 + 13 + 12 + 13;

struct Args { const float* in[26]; float* out; unsigned char* ws; int pc_lo, pc_hi; };

__device__ __forceinline__ unsigned f2bf(float f) { unsigned u = __float_as_uint(f); return (u + 0x7fffu + ((u >> 16) & 1u)) >> 16; }
__device__ __forceinline__ unsigned pk2(float lo, float hi) { return f2bf(lo) | (f2bf(hi) << 16); }
__device__ __forceinline__ float bflo(unsigned w) { return __uint_as_float(w << 16); }
__device__ __forceinline__ float bfhi(unsigned w) { return __uint_as_float(w & 0xffff0000u); }
__device__ __forceinline__ float wave_sum(float v) {
#pragma unroll
    for (int o = 1; o < 64; o <<= 1) v += __shfl_xor(v, o);
    return v;
}
__device__ __forceinline__ float sigmoidf_(float x) { return __builtin_amdgcn_rcpf(1.0f + __expf(-x)); }
__device__ __forceinline__ f32x16 mfma32(bf16x8 a, bf16x8 b, f32x16 c) { return __builtin_amdgcn_mfma_f32_32x32x16_bf16(a, b, c, 0, 0, 0); }
__device__ __forceinline__ f32x4 mfma16(bf16x8 a, bf16x8 b, f32x4 c) { return __builtin_amdgcn_mfma_f32_16x16x32_bf16(a, b, c, 0, 0, 0); }

struct EpiStore {
    static constexpr bool PERM = true, AFTER_DRAIN = false;
    bf16_t* O; int ldc; int split_cols; size_t split_stride;
    __device__ __forceinline__ void operator()(const f32x4 (&acc)[2][2][4][2], const pg8::Unit& u, int wr, int wc, int fr, int fq) const {
        const int row0 = u.pm * 256 + wr * 64 + fr; int colt = u.pn * 256; bf16_t* base = O;
        if (split_cols) { const int t = colt / split_cols; base += (size_t)t * split_stride; colt -= t * split_cols; }
        const int col0 = colt + wc * 32 + 8 * fq;
#pragma unroll
        for (int ai = 0; ai < 2; ++ai)
#pragma unroll
            for (int m = 0; m < 4; ++m) { bf16_t* rowp = base + (size_t)(row0 + ai * 128 + m * 16) * ldc + col0;
#pragma unroll
                for (int bj = 0; bj < 2; ++bj) { const f32x4 v0 = acc[ai][bj][m][0], v1 = acc[ai][bj][m][1];
                    u32x4 w; w.x = pg8::cvt_pk_bf16(v0[0], v0[1]); w.y = pg8::cvt_pk_bf16(v0[2], v0[3]); w.z = pg8::cvt_pk_bf16(v1[0], v1[1]); w.w = pg8::cvt_pk_bf16(v1[2], v1[3]);
                    *(u32x4*)(rowp + bj * 128) = w; } }
    }
};
struct EpiQK {
    static constexpr bool PERM = true, AFTER_DRAIN = false;
    bf16_t* Q; bf16_t* K; const float* qg; const float* kg;
    __device__ __forceinline__ void operator()(const f32x4 (&acc)[2][2][4][2], const pg8::Unit& u, int wr, int wc, int fr, int fq) const {
        const int row0 = u.pm * 256 + wr * 64 + fr; const bool isk = u.pn >= 4;
        bf16_t* base = (isk ? K : Q) + (u.pn & 3) * 256 + 64 * wc + 8 * fq;
        const float* g = isk ? kg : qg; const float sc = isk ? 1.0f : 0.125f;
        f32x4 gv[2][2];
#pragma unroll
        for (int bj = 0; bj < 2; ++bj)
#pragma unroll
            for (int n = 0; n < 2; ++n) gv[bj][n] = *(const f32x4*)(g + 32 * bj + 8 * fq + 4 * n) * sc;
#pragma unroll
        for (int ai = 0; ai < 2; ++ai)
#pragma unroll
            for (int m = 0; m < 4; ++m) {
                float ss = 0.f;
#pragma unroll
                for (int bj = 0; bj < 2; ++bj)
#pragma unroll
                    for (int n = 0; n < 2; ++n) { const f32x4 x = acc[ai][bj][m][n]; ss += (x[0] * x[0] + x[1] * x[1]) + (x[2] * x[2] + x[3] * x[3]); }
                ss += __shfl_xor(ss, 16); ss += __shfl_xor(ss, 32);
                const float rs = __builtin_amdgcn_rsqf(ss * (1.0f / 64.0f) + EPSN);
                bf16_t* rowp = base + (size_t)(row0 + ai * 128 + m * 16) * DM;
#pragma unroll
                for (int bj = 0; bj < 2; ++bj) { const f32x4 v0 = acc[ai][bj][m][0] * rs * gv[bj][0], v1 = acc[ai][bj][m][1] * rs * gv[bj][1];
                    u32x4 w; w.x = pg8::cvt_pk_bf16(v0[0], v0[1]); w.y = pg8::cvt_pk_bf16(v0[2], v0[3]); w.z = pg8::cvt_pk_bf16(v1[0], v1[1]); w.w = pg8::cvt_pk_bf16(v1[2], v1[3]);
                    *(u32x4*)(rowp + 32 * bj) = w; }
            }
    }
};
struct EpiRes {
    static constexpr bool PERM = false, AFTER_DRAIN = false;
    const float* in_lat; const float* in_ctx; float* out_lat; float* out_ctx; const float* gate; int row_off;
    __device__ __forceinline__ void operator()(const f32x4 (&acc)[2][2][4][2], const pg8::Unit& u, int wr, int wc, int fr, int fq) const {
        const int R0 = row_off + u.pm * 256;
        const float* inp; float* outp; int bidx;
        if (R0 < ML) { bidx = R0 >> 12; inp = in_lat + (size_t)R0 * DM; outp = out_lat + (size_t)R0 * DM; }
        else { bidx = 8; inp = in_ctx + (size_t)(R0 - ML) * DM; outp = out_ctx + (size_t)(R0 - ML) * DM; }
        const int col0 = u.pn * 256 + wc * 32 + 4 * fq;
        const float* gp = gate + (size_t)bidx * 6144 + col0;
        f32x4 gv[2][2];
#pragma unroll
        for (int bj = 0; bj < 2; ++bj)
#pragma unroll
            for (int n = 0; n < 2; ++n) gv[bj][n] = *(const f32x4*)(gp + bj * 128 + n * 16);
#pragma unroll
        for (int ai = 0; ai < 2; ++ai)
#pragma unroll
            for (int m = 0; m < 4; ++m) { const size_t ro = (size_t)(wr * 64 + fr + ai * 128 + m * 16) * DM + col0;
#pragma unroll
                for (int bj = 0; bj < 2; ++bj)
#pragma unroll
                    for (int n = 0; n < 2; ++n) { const size_t o = ro + bj * 128 + n * 16; *(f32x4*)(outp + o) = *(const f32x4*)(inp + o) + gv[bj][n] * acc[ai][bj][m][n]; } }
    }
};

__device__ __forceinline__ void transpose_item(const float* W, int ldw, int K, int ncol0, int ncols, bf16_t* WT, int perm, LAS float* scr, int item, int lane) {
    const int nblk = ncols / 32, kb = item / nblk, nb = item % nblk, k0 = 64 * kb, n0 = 32 * nb;
#pragma unroll 8
    for (int i = 0; i < 32; ++i) { const int kk = 2 * i + (lane >> 5); scr[kk * 33 + (lane & 31)] = W[(size_t)(k0 + kk) * ldw + ncol0 + n0 + (lane & 31)]; }
    asm volatile("s_waitcnt lgkmcnt(0)" ::: "memory");
    int d0 = n0;
    if (perm) { const int pn = n0 >> 8, wc = (n0 >> 6) & 3, bj = (n0 >> 5) & 1; d0 = pn * 256 + bj * 128 + wc * 32; }
    const int c = lane & 7;
#pragma unroll
    for (int j = 0; j < 4; ++j) { const int n = (lane >> 3) + 8 * j; const LAS float* s = scr + (8 * c) * 33 + n;
        u32x4 o; o.x = pk2(s[0 * 33], s[1 * 33]); o.y = pk2(s[2 * 33], s[3 * 33]); o.z = pk2(s[4 * 33], s[5 * 33]); o.w = pk2(s[6 * 33], s[7 * 33]);
        *(u32x4*)(WT + (size_t)(d0 + n) * K + k0 + 8 * c) = o; }
    asm volatile("s_waitcnt lgkmcnt(0)" ::: "memory");
}
struct TDesc { const float* src; int ldw, K, ncol0, ncols, perm; bf16_t* dst; int nitems; };
__device__ __forceinline__ TDesc get_tdesc(int m, const Args& a, bf16_t* WB) {
    TDesc t;
    if (m < 6) { const int j = m / 3, w = m % 3;
        if (w == 0) { t.src = a.in[8] + (size_t)j * DM * 3072; t.ldw = 3072; t.K = DM; t.ncol0 = 0; t.ncols = 2048; t.perm = 1; t.dst = WB + (size_t)j * 4 * MEL; }
        else if (w == 1) { t.src = a.in[8] + (size_t)j * DM * 3072; t.ldw = 3072; t.K = DM; t.ncol0 = 2048; t.ncols = 1024; t.perm = 0; t.dst = WB + (size_t)j * 4 * MEL + 2 * MEL; }
        else { t.src = a.in[12] + (size_t)j * DM * DM; t.ldw = DM; t.K = DM; t.ncol0 = 0; t.ncols = DM; t.perm = 0; t.dst = WB + (size_t)j * 4 * MEL + 3 * MEL; }
    } else if (m < 10) { const int j = (m - 6) / 2, w = (m - 6) % 2;
        if (w == 0) { t.src = a.in[13] + (size_t)j * DM * 2048; t.ldw = 2048; t.K = DM; t.ncol0 = 0; t.ncols = 2048; t.perm = 0; t.dst = WB + 8 * MEL + (size_t)j * 3 * MEL; }
        else { t.src = a.in[21] + (size_t)j * DM * DM; t.ldw = DM; t.K = DM; t.ncol0 = 0; t.ncols = DM; t.perm = 0; t.dst = WB + 8 * MEL + (size_t)j * 3 * MEL + 2 * MEL; }
    } else { const int i = (m - 10) / 2, w = (m - 10) % 2;
        if (w == 0) { t.src = a.in[22] + (size_t)i * DM * 6144; t.ldw = 6144; t.K = DM; t.ncol0 = 0; t.ncols = 6144; t.perm = 0; t.dst = WB + 14 * MEL + (size_t)i * 9 * MEL; }
        else { t.src = a.in[25] + (size_t)i * DFF * DM; t.ldw = DM; t.K = DFF; t.ncol0 = 0; t.ncols = DM; t.perm = 0; t.dst = WB + 14 * MEL + (size_t)i * 9 * MEL + 6 * MEL; }
    }
    t.nitems = (t.K / 64) * (t.ncols / 32);
    return t;
}
__device__ __forceinline__ void prologue(const Args& a, LAS unsigned char* lds, int tid, int lane, int wave, int G) {
    unsigned char* ws = a.ws;
    float* MODS = (float*)(ws + WS_MODS);
    bf16_t* WB = (bf16_t*)(ws + WS_WB);
    bf16_t* BDW = (bf16_t*)(ws + WS_BDW);
    LAS float* sl = (LAS float*)(lds + 69632);
    LAS float* red = (LAS float*)(lds + 69632 + 36864);
    for (int i = tid; i < 9 * DM; i += 512) { const int bi = i >> 10, k = i & 1023; const float v = bi < 8 ? a.in[1][bi * DM + k] : a.in[3][k]; sl[i] = v * sigmoidf_(v); }
    __syncthreads();
    for (int it = blockIdx.x; it < 4 * 96; it += G) {
        const int l = it / 96, n0 = (it % 96) * 64;
        const float* wp = a.in[4] + ((size_t)l * DM + wave * 128) * 6144 + n0 + lane;
        float acc[9];
#pragma unroll
        for (int bi = 0; bi < 9; ++bi) acc[bi] = 0.f;
        for (int k = 0; k < 128; k += 4) {
            const float w0 = wp[(size_t)(k + 0) * 6144], w1 = wp[(size_t)(k + 1) * 6144], w2 = wp[(size_t)(k + 2) * 6144], w3 = wp[(size_t)(k + 3) * 6144];
#pragma unroll
            for (int bi = 0; bi < 9; ++bi) { const f32x4 s = *(const LAS f32x4*)(sl + bi * DM + wave * 128 + k); acc[bi] += (s[0] * w0 + s[1] * w1) + (s[2] * w2 + s[3] * w3); }
        }
#pragma unroll
        for (int bi = 0; bi < 9; ++bi) red[(wave * 9 + bi) * 64 + lane] = acc[bi];
        __syncthreads();
        for (int o = tid; o < 9 * 64; o += 512) { const int bi = o >> 6, ln = o & 63; float s = a.in[5][(size_t)l * 6144 + n0 + ln];
#pragma unroll
            for (int w = 0; w < 8; ++w) s += red[(w * 9 + bi) * 64 + ln];
            MODS[((size_t)l * 9 + bi) * 6144 + n0 + ln] = s; }
        __syncthreads();
    }
    for (int idx = blockIdx.x * 512 + tid; idx < 2 * 2 * 2 * 16 * 4096; idx += G * 512) {
        const int d = idx & 63, e = (idx >> 6) & 63, n = (idx >> 12) & 15, gt = (idx >> 16) & 1, dir = (idx >> 17) & 1, j = idx >> 18;
        const float* W = gt ? a.in[18] : a.in[16];
        BDW[idx] = (bf16_t)f2bf(W[((((size_t)j * 2 + dir) * 16 + n) * 64 + d) * 64 + e]);
    }
    LAS float* scr = (LAS float*)(lds + wave * 8448);
    const int gw = blockIdx.x * 8 + wave, NGW = G * 8;
    int base = 0;
    for (int m = 0; m < 18; ++m) {
        const TDesc t = get_tdesc(m, a, WB);
        int first = (gw - base) % NGW; if (first < 0) first += NGW;
        for (int it = first; it < t.nitems; it += NGW) transpose_item(t.src, t.ldw, t.K, t.ncol0, t.ncols, t.dst, t.perm, scr, it, lane);
        base = (base + t.nitems) % NGW;
    }
}

__device__ __forceinline__ void norm_phase(const float* xl, const float* xc, bf16_t* HN, const float* gain, const float* mods_l, int sidx, int nrows, int lane, int gw, int NGW) {
    for (int row = gw; row < nrows; row += NGW) {
        const float* src; int bidx;
        if (row < ML) { src = xl + (size_t)row * DM; bidx = row >> 12; } else { src = xc + (size_t)(row - ML) * DM; bidx = 8; }
        const f32x4* xr = (const f32x4*)src + lane;
        f32x4 v[4]; float s = 0.f;
#pragma unroll
        for (int j = 0; j < 4; ++j) { v[j] = xr[64 * j]; s += (v[j][0] * v[j][0] + v[j][1] * v[j][1]) + (v[j][2] * v[j][2] + v[j][3] * v[j][3]); }
        const float rstd = __builtin_amdgcn_rsqf(wave_sum(s) * (1.0f / DM) + EPSN);
        const float* shp = mods_l + (size_t)bidx * 6144 + sidx * DM; const float* scp = shp + DM;
        u32x2* o8 = (u32x2*)(HN + (size_t)row * DM) + lane;
#pragma unroll
        for (int j = 0; j < 4; ++j) { const int col = 4 * (lane + 64 * j);
            const f32x4 g = *(const f32x4*)(gain + col), sh = *(const f32x4*)(shp + col), sc = *(const f32x4*)(scp + col);
            const f32x4 y = v[j] * rstd * g * (sc + 1.0f) + sh;
            u32x2 w; w.x = pk2(y[0], y[1]); w.y = pk2(y[2], y[3]); o8[64 * j] = w; }
    }
}

template <bool CTXQ>
__device__ __forceinline__ void attn_task(bf16_t* QO, const bf16_t* Kb, const bf16_t* VT, const float* rpb, int lane, int task) {
    constexpr int G0 = CTXQ ? 8 : 0;
    const int q = lane & 15, g = lane >> 4;
    int cb, r, h, b, q0, ks, rs; size_t qrow;
    if (CTXQ) { const int qb = task & 15; h = (task >> 4) & 15; b = task >> 8; cb = 0; r = 0; q0 = 0; ks = 0; rs = 0; qrow = (size_t)ML + b * CTXL + qb * 16 + q; }
    else { cb = task & 3; r = (task >> 2) & 63; h = (task >> 8) & 15; b = task >> 12; q0 = cb * 16; ks = min(max(q0 - 8, 0), 32); rs = min(max(r - 4, 0), 56); qrow = (size_t)b * SEQ + r * 64 + q0 + q; }
    const bf16x8 qf0 = *(const bf16x8*)(QO + qrow * DM + h * 64 + 8 * g), qf1 = *(const bf16x8*)(QO + qrow * DM + h * 64 + 32 + 8 * g);
    const int qcol = q0 + q, wstart = min(max(qcol - 8, 0), 48);
    const float* rp = rpb + h * 465;
    const int koff = 8 * (q >> 2) + (q & 3);
    f32x4 S[16][2];
#pragma unroll
    for (int grp = G0; grp < 16; ++grp) {
        const size_t base = grp < 8 ? (size_t)b * SEQ + (rs + grp) * 64 + ks : (size_t)ML + b * CTXL + 32 * (grp - 8);
#pragma unroll
        for (int T = 0; T < 2; ++T) {
            const bf16_t* kp = Kb + (base + koff + 4 * T) * DM + h * 64 + 8 * g;
            const bf16x8 kf0 = *(const bf16x8*)kp, kf1 = *(const bf16x8*)(kp + 32);
            f32x4 s = {0.f, 0.f, 0.f, 0.f};
            s = mfma16(kf0, qf0, s); s = mfma16(kf1, qf1, s);
            if (grp < 8) {
                const int drow = rs + grp - r + 7;
#pragma unroll
                for (int j = 0; j < 4; ++j) { const int kcol = ks + 8 * g + 4 * T + j; const bool ok = (kcol >= wstart) && (kcol < wstart + 16);
                    const int dcol = min(max(kcol - qcol + 15, 0), 30);
                    const float bias = rp[drow * 31 + dcol];
                    s[j] = ok ? s[j] + bias : -1e30f; }
            }
            S[grp][T] = s;
        }
    }
    float mx = -1e30f;
#pragma unroll
    for (int grp = G0; grp < 16; ++grp)
#pragma unroll
        for (int T = 0; T < 2; ++T) mx = fmaxf(mx, fmaxf(fmaxf(S[grp][T][0], S[grp][T][1]), fmaxf(S[grp][T][2], S[grp][T][3])));
    mx = fmaxf(mx, __shfl_xor(mx, 16)); mx = fmaxf(mx, __shfl_xor(mx, 32));
    float sum = 0.f;
#pragma unroll
    for (int grp = G0; grp < 16; ++grp)
#pragma unroll
        for (int T = 0; T < 2; ++T) {
#pragma unroll
            for (int j = 0; j < 4; ++j) { const float p = __expf(S[grp][T][j] - mx); S[grp][T][j] = p; sum += p; } }
    sum += __shfl_xor(sum, 16); sum += __shfl_xor(sum, 32);
    f32x4 O[4];
#pragma unroll
    for (int dt = 0; dt < 4; ++dt) O[dt] = (f32x4){0.f, 0.f, 0.f, 0.f};
#pragma unroll
    for (int grp = G0; grp < 16; ++grp) {
        const size_t base = grp < 8 ? (size_t)b * SEQ + (rs + grp) * 64 + ks : (size_t)ML + b * CTXL + 32 * (grp - 8);
        u32x4 pw; pw.x = pk2(S[grp][0][0], S[grp][0][1]); pw.y = pk2(S[grp][0][2], S[grp][0][3]); pw.z = pk2(S[grp][1][0], S[grp][1][1]); pw.w = pk2(S[grp][1][2], S[grp][1][3]);
        const bf16x8 pf = __builtin_bit_cast(bf16x8, pw);
#pragma unroll
        for (int dt = 0; dt < 4; ++dt) {
            const bf16x8 vf = *(const bf16x8*)(VT + (size_t)(h * 64 + 16 * dt + q) * MT + base + 8 * g);
            O[dt] = mfma16(vf, pf, O[dt]);
        }
    }
    const float inv = __builtin_amdgcn_rcpf(sum);
#pragma unroll
    for (int dt = 0; dt < 4; ++dt) { u32x2 w; w.x = pk2(O[dt][0] * inv, O[dt][1] * inv); w.y = pk2(O[dt][2] * inv, O[dt][3] * inv);
        *(u32x2*)(QO + qrow * DM + h * 64 + 16 * dt + 4 * g) = w; }
}
__device__ __forceinline__ void attn_phase(bf16_t* QO, const bf16_t* Kb, const bf16_t* VT, const float* rpb, int lane, int wave, int G) {
    for (int t0 = blockIdx.x; t0 < 4096; t0 += G) attn_task<false>(QO, Kb, VT, rpb, lane, t0 * 8 + wave);
    for (int t0 = blockIdx.x; t0 < 256; t0 += G) attn_task<true>(QO, Kb, VT, rpb, lane, t0 * 8 + wave);
}

__device__ __forceinline__ void lconv_phase(const bf16_t* REC, bf16_t* XR, const float* cw, const float* cbias, int tid, int G) {
    for (int it = blockIdx.x * 512 + tid; it < MT * 128; it += G * 512) {
        const int row = it >> 7, ch = (it & 127) * 8;
        int pos, len; if (row < ML) { pos = row & (SEQ - 1); len = SEQ; } else { pos = (row - ML) & (CTXL - 1); len = CTXL; }
        float acc[8];
        { const f32x4 b0 = *(const f32x4*)(cbias + ch), b1 = *(const f32x4*)(cbias + ch + 4);
#pragma unroll
          for (int e = 0; e < 4; ++e) { acc[e] = b0[e]; acc[4 + e] = b1[e]; } }
#pragma unroll
        for (int k = 0; k < 4; ++k) { const int t = pos + k - 2;
            if (t >= 0 && t < len) {
                const u32x4 v = *(const u32x4*)(REC + (size_t)(row + k - 2) * DM + ch);
                const f32x4 w0 = *(const f32x4*)(cw + k * DM + ch), w1 = *(const f32x4*)(cw + k * DM + ch + 4);
                acc[0] += w0[0] * bflo(v.x); acc[1] += w0[1] * bfhi(v.x); acc[2] += w0[2] * bflo(v.y); acc[3] += w0[3] * bfhi(v.y);
                acc[4] += w1[0] * bflo(v.z); acc[5] += w1[1] * bfhi(v.z); acc[6] += w1[2] * bflo(v.w); acc[7] += w1[3] * bfhi(v.w);
            } }
        u32x4 o; o.x = pk2(acc[0], acc[1]); o.y = pk2(acc[2], acc[3]); o.z = pk2(acc[4], acc[5]); o.w = pk2(acc[6], acc[7]);
        *(u32x4*)(XR + (size_t)row * DM + ch) = o;
    }
}

template <int DIR, bool APPLY>
__device__ __forceinline__ void lru_sweep(const bf16_t* XR, const bf16_t* GATE, bf16_t* YP, const bf16_t* bdw_dir, float bias_r, float bias_i, float sp,
                                          int row0, int n, int half, int lane, float& hcar, float& ptot, f32x16 (&hsf)[4]) {
    const int e = lane & 31, hh = lane >> 5;
    const int tau = 16 * ((e >> 2) & 1) + (e & 3) + 4 * (e >> 3);
    bf16x8 Br[4], Bi[4];
    const bf16_t* wrp = bdw_dir + (size_t)n * 4096 + (half * 32 + e) * 64 + 8 * hh;
    const bf16_t* wip = wrp + 16 * 4096;
#pragma unroll
    for (int kk = 0; kk < 4; ++kk) { Br[kk] = *(const bf16x8*)(wrp + 16 * kk); Bi[kk] = *(const bf16x8*)(wip + 16 * kk); }
    bf16x8 I0, I1;
#pragma unroll
    for (int jj = 0; jj < 8; ++jj) { I0[jj] = (8 * hh + jj == e) ? (short)0x3F80 : (short)0; I1[jj] = (16 + 8 * hh + jj == e) ? (short)0x3F80 : (short)0; }
    const bool first = (hh == DIR);
    const int chcol = n * 64 + half * 32;
#pragma unroll
    for (int tt = 0; tt < 4; ++tt) {
        const int tile = DIR == 0 ? tt : 3 - tt; const int trow = row0 + tile * 32;
        const bf16_t* ap = XR + (size_t)(trow + tau) * DM + n * 64 + 8 * hh;
        bf16x8 A[4];
#pragma unroll
        for (int kk = 0; kk < 4; ++kk) A[kk] = *(const bf16x8*)(ap + 16 * kk);
        f32x16 ar, ai, xv;
#pragma unroll
        for (int r = 0; r < 16; ++r) { ar[r] = 0.f; ai[r] = 0.f; xv[r] = 0.f; }
#pragma unroll
        for (int kk = 0; kk < 4; ++kk) { ar = mfma32(A[kk], Br[kk], ar); ai = mfma32(A[kk], Bi[kk], ai); }
        const bf16x8 Ax0 = half ? A[2] : A[0], Ax1 = half ? A[3] : A[1];
        xv = mfma32(Ax0, I0, xv); xv = mfma32(Ax1, I1, xv);
        f32x16 av, bv;
#pragma unroll
        for (int r = 0; r < 16; ++r) {
            const float rg = sigmoidf_(ar[r] + bias_r), ig = sigmoidf_(ai[r] + bias_i);
            const float aa = __expf(-8.0f * rg * sp);
            av[r] = aa; bv[r] = sqrtf(fmaxf(1.0f - aa * aa, 0.f)) * ig * xv[r];
        }
        float Hl = 0.f, Pl = 1.f;
#pragma unroll
        for (int rr = 0; rr < 16; ++rr) { const int r = DIR == 0 ? rr : 15 - rr; Hl = av[r] * Hl + bv[r]; Pl *= av[r]; }
        const float val = Hl + Pl * hcar, got = __shfl_xor(val, 32);
        const float start = first ? hcar : got;
        float endv;
        f32x16 hs;
        if (APPLY) {
            float hcur = start;
#pragma unroll
            for (int rr = 0; rr < 16; ++rr) { const int r = DIR == 0 ? rr : 15 - rr; hcur = av[r] * hcur + bv[r]; hs[r] = hcur; }
            endv = hcur;
        } else { endv = Hl + Pl * start; }
        const float got2 = __shfl_xor(endv, 32);
        hcar = first ? got2 : endv;
        if (!APPLY) ptot *= Pl * __shfl_xor(Pl, 32);
        if (APPLY) {
            if (DIR == 0) hsf[tile] = hs;
            else {
                const bf16_t* gp = GATE + (size_t)(trow + tau) * DM + chcol + 8 * hh;
                const bf16x8 G0 = *(const bf16x8*)gp, G1 = *(const bf16x8*)(gp + 16);
                f32x16 gv;
#pragma unroll
                for (int r = 0; r < 16; ++r) gv[r] = 0.f;
                gv = mfma32(G0, I0, gv); gv = mfma32(G1, I1, gv);
                bf16_t* yp = YP + (size_t)(trow + 16 * hh) * DM + chcol + e;
#pragma unroll
                for (int r = 0; r < 16; ++r) { const float x = gv[r], u2 = 1.5957691216f * (x + 0.044715f * x * x * x);
                    const float y = (hsf[tile][r] + hs[r]) * x * sigmoidf_(u2);
                    yp[(size_t)r * DM] = (bf16_t)f2bf(y); }
            }
        }
    }
}
template <bool APPLY>
__device__ __forceinline__ void lru_phase(const bf16_t* XR, const bf16_t* GATE, bf16_t* YP, const bf16_t* bdw_j, const float* ga_b, const float* gx_b, const float* lam, float* SUM,
                                          int lane, int gw, int NGW) {
    for (int task = gw; task < NB * NCHUNK * 32; task += NGW) {
        const int n2 = task & 31, c = (task >> 5) % NCHUNK, b = task / (32 * NCHUNK);
        const int row0 = c < 2 ? ML + b * CTXL + c * 128 : b * SEQ + (c - 2) * 128;
        const int n = n2 >> 1, half = n2 & 1, ch = n2 * 32 + (lane & 31);
        f32x16 hsf[4];
#pragma unroll
        for (int dir = 0; dir < 2; ++dir) {
            const float bias_r = ga_b[dir * DM + ch], bias_i = gx_b[dir * DM + ch];
            const float sp = log1pf(__expf(-lam[dir * DM + ch]));
            const int p = dir == 0 ? c : (c < 2 ? 1 - c : 35 - c);
            float* sump = SUM + ((size_t)(dir * NB + b) * NCHUNK) * DM * 2 + (size_t)ch * 2;
            float hcar = 0.f, ptot = 1.f;
            if (APPLY) { for (int pp = 0; pp < p; ++pp) { const float2 ph = *(const float2*)(sump + (size_t)pp * DM * 2); hcar = ph.x * hcar + ph.y; } }
            if (dir == 0) lru_sweep<0, APPLY>(XR, GATE, YP, bdw_j, bias_r, bias_i, sp, row0, n, half, lane, hcar, ptot, hsf);
            else lru_sweep<1, APPLY>(XR, GATE, YP, bdw_j + 2 * 16 * 4096, bias_r, bias_i, sp, row0, n, half, lane, hcar, ptot, hsf);
            if (!APPLY) { if (lane < 32) *(float2*)(sump + (size_t)p * DM * 2) = make_float2(ptot, hcar); }
        }
    }
}

__device__ __forceinline__ void fconv_phase(const bf16_t* U, bf16_t* Gb, const float* cw, const float* cbias, int rbeg, int nrows, int tid, int G) {
    const int total = nrows * 384;
    for (int it = blockIdx.x * 512 + tid; it < total; it += G * 512) {
        const int r = it / 384, ch = (it % 384) * 8, row = rbeg + r;
        int pos, len; if (row < ML) { pos = row & (SEQ - 1); len = SEQ; } else { pos = (row - ML) & (CTXL - 1); len = CTXL; }
        float va[8], ga[8];
        { const f32x4 b0 = *(const f32x4*)(cbias + ch), b1 = *(const f32x4*)(cbias + ch + 4), c0 = *(const f32x4*)(cbias + DFF + ch), c1 = *(const f32x4*)(cbias + DFF + ch + 4);
#pragma unroll
          for (int e = 0; e < 4; ++e) { va[e] = b0[e]; va[4 + e] = b1[e]; ga[e] = c0[e]; ga[4 + e] = c1[e]; } }
#pragma unroll
        for (int k = 0; k < 3; ++k) { const int t = pos + k - 1;
            if (t >= 0 && t < len) {
                const bf16_t* up = U + (size_t)(r + k - 1) * 6144 + ch;
                const u32x4 v = *(const u32x4*)up, gq = *(const u32x4*)(up + DFF);
                const float* wp = cw + (size_t)k * 6144 + ch;
                const f32x4 w0 = *(const f32x4*)wp, w1 = *(const f32x4*)(wp + 4), x0 = *(const f32x4*)(wp + DFF), x1 = *(const f32x4*)(wp + DFF + 4);
                va[0] += w0[0] * bflo(v.x); va[1] += w0[1] * bfhi(v.x); va[2] += w0[2] * bflo(v.y); va[3] += w0[3] * bfhi(v.y);
                va[4] += w1[0] * bflo(v.z); va[5] += w1[1] * bfhi(v.z); va[6] += w1[2] * bflo(v.w); va[7] += w1[3] * bfhi(v.w);
                ga[0] += x0[0] * bflo(gq.x); ga[1] += x0[1] * bfhi(gq.x); ga[2] += x0[2] * bflo(gq.y); ga[3] += x0[3] * bfhi(gq.y);
                ga[4] += x1[0] * bflo(gq.z); ga[5] += x1[1] * bfhi(gq.z); ga[6] += x1[2] * bflo(gq.w); ga[7] += x1[3] * bfhi(gq.w);
            } }
        float o[8];
#pragma unroll
        for (int e = 0; e < 8; ++e) o[e] = va[e] * ga[e] * sigmoidf_(ga[e]);
        u32x4 w; w.x = pk2(o[0], o[1]); w.y = pk2(o[2], o[3]); w.z = pk2(o[4], o[5]); w.w = pk2(o[6], o[7]);
        *(u32x4*)(Gb + (size_t)r * DFF + ch) = w;
    }
}

template <int OP>
__device__ __forceinline__ void run_op(const Args& a, LAS unsigned char* lds, const int li, const int arg) {
    const int tid = threadIdx.x, lane = tid & 63, wave = __builtin_amdgcn_readfirstlane(tid >> 6), G = gridDim.x;
    const int gw = blockIdx.x * 8 + wave, NGW = G * 8;
    unsigned char* ws = a.ws;
    float* MODS = (float*)(ws + WS_MODS);
    float* SUM = (float*)(ws + WS_SUM);
    bf16_t* BDW = (bf16_t*)(ws + WS_BDW);
    float* CTXR = (float*)(ws + WS_CTXR);
    bf16_t* WB = (bf16_t*)(ws + WS_WB);
    bf16_t* HN = (bf16_t*)(ws + WS_HN);
    bf16_t* RR = (bf16_t*)(ws + WS_R);
    const int j = li >> 1;
    const float* mods_l = MODS + (size_t)li * 9 * 6144;
    if constexpr (OP == OP_PRO) {
        prologue(a, lds, tid, lane, wave, G);
    } else if constexpr (OP == OP_NORM) {
        const bool first = (li == 0 && arg == 0);
        const float* gain = (arg ? a.in[7] : a.in[6]) + (size_t)li * DM;
        const int nrows = (arg == 1 && li == 3) ? ML : MT;
        norm_phase(first ? a.in[0] : a.out, first ? a.in[2] : CTXR, HN, gain, mods_l, arg * 3, nrows, lane, gw, NGW);
    } else if constexpr (OP == OP_GQK) {
        pg8::Gemm g{HN, WB + (size_t)j * 4 * MEL, MT, 2048, DM};
        pg8::StaticOrder S; S.init(g.M, g.N, G, (int)blockIdx.x);
        EpiQK E{RR + R_Q, RR + R_K, a.in[9] + j * HD, a.in[10] + j * HD};
        pg8::gemm_phase<EpiQK, pg8::StaticOrder>(lds, g, S, E);
    } else if constexpr (OP == OP_GST) {
        pg8::Gemm g; EpiStore E; int c = (int)blockIdx.x;
        if (arg == 0) { g = pg8::Gemm{WB + (size_t)j * 4 * MEL + 2 * MEL, HN, DM, MT, DM}; E = EpiStore{RR + R_VT, MT, 0, 0}; c = (c + G - (64 % G)) % G; }
        else if (arg == 1) { g = pg8::Gemm{HN, WB + 8 * MEL + (size_t)j * 3 * MEL, MT, 2048, DM}; E = EpiStore{RR + R_GATE, DM, DM, (size_t)MT * DM}; }
        else { const int rbeg = arg == 2 ? 0 : 16384, nrows = arg == 2 ? 16384 : (li == 3 ? 16384 : 18432);
            g = pg8::Gemm{HN + (size_t)rbeg * DM, WB + 14 * MEL + (size_t)li * 9 * MEL, nrows, 6144, DM}; E = EpiStore{RR + R_U, 6144, 0, 0}; }
        pg8::StaticOrder S; S.init(g.M, g.N, G, c);
        pg8::gemm_phase<EpiStore, pg8::StaticOrder>(lds, g, S, E);
    } else if constexpr (OP == OP_GRES) {
        pg8::Gemm g; EpiRes E;
        const bool l0 = (li == 0 && arg == 0);
        E.in_lat = l0 ? a.in[0] : a.out; E.in_ctx = l0 ? a.in[2] : CTXR; E.out_lat = a.out; E.out_ctx = CTXR;
        if (arg == 0) {
            E.gate = mods_l + 2 * DM; E.row_off = 0;
            if (li & 1) g = pg8::Gemm{RR + R_YP, WB + 8 * MEL + (size_t)j * 3 * MEL + 2 * MEL, li == 3 ? ML : MT, DM, DM};
            else g = pg8::Gemm{RR + R_Q, WB + (size_t)j * 4 * MEL + 3 * MEL, MT, DM, DM};
        } else { const int rbeg = arg == 2 ? 0 : 16384, nrows = arg == 2 ? 16384 : (li == 3 ? 16384 : 18432);
            E.gate = mods_l + 5 * DM; E.row_off = rbeg;
            g = pg8::Gemm{RR + R_G, WB + 14 * MEL + (size_t)li * 9 * MEL + 6 * MEL, nrows, DM, DFF}; }
        pg8::StaticOrder S; S.init(g.M, g.N, G, (int)blockIdx.x);
        pg8::gemm_phase<EpiRes, pg8::StaticOrder>(lds, g, S, E);
    } else if constexpr (OP == OP_ATTN) {
        attn_phase(RR + R_Q, RR + R_K, RR + R_VT, a.in[11] + (size_t)j * NH * 465, lane, wave, G);
    } else if constexpr (OP == OP_LCONV) {
        lconv_phase(RR + R_REC, RR + R_XR, a.in[14] + (size_t)j * 4 * DM, a.in[15] + (size_t)j * DM, tid, G);
    } else if constexpr (OP == OP_LRUA) {
        lru_phase<false>(RR + R_XR, RR + R_GATE, RR + R_YP, BDW + (size_t)j * 4 * 16 * 4096, a.in[17] + (size_t)j * 2 * DM, a.in[19] + (size_t)j * 2 * DM, a.in[20] + (size_t)j * 2 * DM, SUM, lane, gw, NGW);
    } else if constexpr (OP == OP_LRUC) {
        lru_phase<true>(RR + R_XR, RR + R_GATE, RR + R_YP, BDW + (size_t)j * 4 * 16 * 4096, a.in[17] + (size_t)j * 2 * DM, a.in[19] + (size_t)j * 2 * DM, a.in[20] + (size_t)j * 2 * DM, SUM, lane, gw, NGW);
    } else if constexpr (OP == OP_FCONV) {
        const int rbeg = arg == 2 ? 0 : 16384, nrows = arg == 2 ? 16384 : (li == 3 ? 16384 : 18432);
        fconv_phase(RR + R_U, RR + R_G, a.in[23] + (size_t)li * 3 * 6144, a.in[24] + (size_t)li * 6144, rbeg, nrows, tid, G);
    }
}

#ifdef MULTI_LAUNCH
template <int OP> __global__ void __launch_bounds__(512, 2) op_kernel(Args a, int li, int arg) {
    extern __shared__ __attribute__((aligned(16))) unsigned char lds_raw[];
    run_op<OP>(a, (LAS unsigned char*)lds_raw, li, arg);
}
template <int OP> static void launch_op(const Args& a, int li, int arg, int grid, hipStream_t stream) {
    static bool attr = false;
    if (!attr) { (void)hipFuncSetAttribute((const void*)op_kernel<OP>, hipFuncAttributeMaxDynamicSharedMemorySize, LDS_BYTES); attr = true; }
    hipLaunchKernelGGL(op_kernel<OP>, dim3(grid), dim3(512), LDS_BYTES, stream, a, li, arg);
}
#else
__global__ void __launch_bounds__(512, 2) fwd_kernel(Args a) {
    extern __shared__ __attribute__((aligned(16))) unsigned char lds_raw[];
    LAS unsigned char* lds = (LAS unsigned char*)lds_raw;
    cg::grid_group grid = cg::this_grid();
    for (int pc = a.pc_lo; pc < a.pc_hi; ++pc) {
        const int op = PROG[pc][0], li = PROG[pc][1], arg = PROG[pc][2], sync = PROG[pc][3];
        switch (op) {
            case OP_PRO: run_op<OP_PRO>(a, lds, li, arg); break;
            case OP_NORM: run_op<OP_NORM>(a, lds, li, arg); break;
            case OP_GQK: run_op<OP_GQK>(a, lds, li, arg); break;
            case OP_GST: run_op<OP_GST>(a, lds, li, arg); break;
            case OP_GRES: run_op<OP_GRES>(a, lds, li, arg); break;
            case OP_ATTN: run_op<OP_ATTN>(a, lds, li, arg); break;
            case OP_LCONV: run_op<OP_LCONV>(a, lds, li, arg); break;
            case OP_LRUA: run_op<OP_LRUA>(a, lds, li, arg); break;
            case OP_LRUC: run_op<OP_LRUC>(a, lds, li, arg); break;
            default: run_op<OP_FCONV>(a, lds, li, arg); break;
        }
        if (sync && pc + 1 < a.pc_hi) grid.sync();
    }
}
#endif

extern "C" void kernel_launch(void* const* d_in, const int* in_sizes, int n_in, void* d_out, int out_size, void* d_ws, size_t ws_size, hipStream_t stream) {
    static int grid = 0;
    if (grid == 0) {
        if (n_in != 26 || out_size != ML * DM || ws_size < WS_END) { fprintf(stderr, "kernel_launch: unexpected shapes: n_in %d out %d ws %zu (need %zu)\n", n_in, out_size, ws_size, (size_t)WS_END); grid = -1; return; }
        int dev = 0, cus = 0, per_cu = 1;
        (void)hipGetDevice(&dev);
        (void)hipDeviceGetAttribute(&cus, hipDeviceAttributeMultiprocessorCount, dev);
#ifndef MULTI_LAUNCH
        if (hipFuncSetAttribute((const void*)fwd_kernel, hipFuncAttributeMaxDynamicSharedMemorySize, LDS_BYTES) != hipSuccess) { fprintf(stderr, "kernel_launch: hipFuncSetAttribute failed\n"); grid = -1; return; }
        if (hipOccupancyMaxActiveBlocksPerMultiprocessor(&per_cu, (const void*)fwd_kernel, 512, LDS_BYTES) != hipSuccess || per_cu < 1) { fprintf(stderr, "kernel_launch: occupancy query gave %d\n", per_cu); per_cu = 1; }
        (void)hipGetLastError();
#endif
        grid = cus * per_cu;
        fprintf(stderr, "kernel_launch: grid %d (cus %d x %d), ws %zu\n", grid, cus, per_cu, ws_size);
    }
    if (grid < 0) return;
    Args a{};
    for (int i = 0; i < 26; ++i) a.in[i] = (const float*)d_in[i];
    a.out = (float*)d_out; a.ws = (unsigned char*)d_ws;
    a.pc_lo = 0; a.pc_hi = NPROG;
#ifdef MULTI_LAUNCH
    static const int hostprog[][4] = { {OP_PRO, 0, 0, 1}, NA_OPS(0), LRU_OPS(1), NA_OPS(2), LRU_OPS(3) };
    for (int pc = 0; pc < NPROG; ++pc) {
        const int op = hostprog[pc][0], li = hostprog[pc][1], arg = hostprog[pc][2];
        switch (op) {
            case OP_PRO: launch_op<OP_PRO>(a, li, arg, grid, stream); break;
            case OP_NORM: launch_op<OP_NORM>(a, li, arg, grid, stream); break;
            case OP_GQK: launch_op<OP_GQK>(a, li, arg, grid, stream); break;
            case OP_GST: launch_op<OP_GST>(a, li, arg, grid, stream); break;
            case OP_GRES: launch_op<OP_GRES>(a, li, arg, grid, stream); break;
            case OP_ATTN: launch_op<OP_ATTN>(a, li, arg, grid, stream); break;
            case OP_LCONV: launch_op<OP_LCONV>(a, li, arg, grid, stream); break;
            case OP_LRUA: launch_op<OP_LRUA>(a, li, arg, grid, stream); break;
            case OP_LRUC: launch_op<OP_LRUC>(a, li, arg, grid, stream); break;
            default: launch_op<OP_FCONV>(a, li, arg, grid, stream); break;
        }
    }
#else
    void* args[] = {&a};
    hipError_t e = hipLaunchCooperativeKernel((const void*)fwd_kernel, dim3(grid), dim3(512), args, LDS_BYTES, stream);
    if (e != hipSuccess) fprintf(stderr, "kernel_launch: cooperative launch failed: %s (grid %d)\n", hipGetErrorString(e), grid);
#endif
}
```

```cpp
#include <hip/hip_runtime.h>
#include <hip/hip_cooperative_groups.h>
#include <cstdio>
#include <cstdint>
namespace cg = cooperative_groups;
__device__ __forceinline__ int opaque_tid() { int t; asm volatile("v_mov_b32 %0, %1" : "=v"(t) : "v"((int)threadIdx.x)); return t; }
__device__ __forceinline__ int opaque_bid() { int t; asm volatile("s_mov_b32 %0, %1" : "=s"(t) : "s"((int)blockIdx.x)); return t; }
#define LAS __attribute__((address_space(3)))
namespace pg8 {
#define PG8_LAS __attribute__((address_space(3)))
typedef unsigned short bf16_t;
typedef short bf16x8 __attribute__((ext_vector_type(8)));
typedef float f32x4 __attribute__((ext_vector_type(4)));
typedef unsigned u32x4 __attribute__((ext_vector_type(4)));
constexpr int BM = 256, BK = 64, HALF = 128, HTB = HALF * BK * 2  , STAGE_BYTES = 8 * HTB, NXCD = 8, WGM = 8;

__host__ __device__ __forceinline__ int lds_byte(int r, int c) { const int st = (r >> 4) * 2 + (c >> 5), rr = r & 15, cc = c & 31, ob = rr * 64 + cc * 2; return st * 1024 + (ob ^ (((ob >> 9) & 1) << 5)); }
__host__ __device__ __forceinline__ void stage_rc(int b, int& R, int& C) { const int st = b / 1024, sb = b % 1024, swz = sb ^ (((sb >> 9) & 1) << 5); R = (st >> 1) * 16 + swz / 64; C = (st & 1) * 32 + (swz % 64) / 2; }
__host__ __device__ __forceinline__ int perm32(int rho) { const int n = rho >> 4, i = rho & 15; return 8 * (i >> 2) + 4 * n + (i & 3); }

struct Unit { int pm, pn, kc; };
struct Gemm { const bf16_t* A; const bf16_t* Bt; int M, N, K; int a_step_rows; int ldk; };

struct StaticOrder {
    int nM, nN, nwg, G, c;
    __host__ __device__ void init(int M, int N, int G_, int c_) { nM = M / BM; nN = N / BM; nwg = nM * nN; G = G_; c = c_; }
    __host__ __device__ bool next(int i, Unit& u) const {
        const long L = (long)i * G + c; if (L >= nwg) return false;
        int wgid = (int)L; { const int q = nwg / NXCD, r = nwg % NXCD, xcd = wgid % NXCD, off = wgid / NXCD; wgid = (xcd < r ? xcd * (q + 1) : r * (q + 1) + (xcd - r) * q) + off; }
        const int nig = WGM * nN, gid = wgid / nig, fm = gid * WGM, gsz = (nM - fm) < WGM ? (nM - fm) : WGM;
        u.pm = fm + ((wgid % nig) % gsz); u.pn = (wgid % nig) / gsz; u.kc = 0; return true;
    }
    __device__ __forceinline__ void a_ready(const Unit&) const {}
    __device__ __forceinline__ void done(const Unit&) const {}
};
__device__ __forceinline__ unsigned cvt_pk_bf16(float lo, float hi) { unsigned r; asm volatile("v_cvt_pk_bf16_f32 %0, %1, %2" : "=v"(r) : "v"(lo), "v"(hi)); return r; }
template <class Epi, class Sched>
__device__ __forceinline__ void gemm_phase(PG8_LAS unsigned char* lds, const Gemm g, const Sched& S, const Epi& E) {
    const int tid = opaque_tid(), wid = __builtin_amdgcn_readfirstlane(tid >> 6), lane = tid & 63, wr = wid >> 2, wc = wid & 3, fr = lane & 15, fq = lane >> 4;
    const int K = g.K, nt = K / BK, P = g.ldk ? g.ldk : K;
    unsigned voffA[2], voffB[2];
#pragma unroll
    for (int i = 0; i < 2; ++i) { int R, C; stage_rc(tid * 16 + i * 8192, R, C); const int Rb = Epi::PERM ? ((R & ~31) + perm32(R & 31)) : R;
        voffA[i] = (unsigned)(R * P + C) * 2u; voffB[i] = (unsigned)(Rb * P + C) * 2u; }
    const size_t kstep = (size_t)(BK * 2);
    const size_t hstep = (size_t)HALF * P * 2;
    const size_t tstep = 2 * hstep; const size_t tstepA = g.a_step_rows ? (size_t)g.a_step_rows * P * 2 : tstep; const size_t cstep = (size_t)K * 2;
    const unsigned ldsw = (unsigned)wid * 1024u;
    const int aoff = lds_byte(wr * 64 + fr, fq * 8), boff = lds_byte(wc * 32 + fr, fq * 8);
#define PG8_SA(b, h) (((b) * 2 + (h)) * HTB)
#define PG8_SB(b, h) ((4 + (b) * 2 + (h)) * HTB)
#define PG8_STAGE(bufoff, gbase, voff) do { _Pragma("unroll") for (int _i = 0; _i < 2; ++_i) \
        __builtin_amdgcn_global_load_lds((const unsigned*)((const char*)(gbase) + (voff)[_i]), (PG8_LAS unsigned*)(lds + (bufoff) + ldsw + _i * 8192), 16, 0, 0); } while (0)
#define PG8_LDA(dst, b, h) do { _Pragma("unroll") for (int m = 0; m < 4; ++m) _Pragma("unroll") for (int k = 0; k < 2; ++k) dst[m][k] = *(const PG8_LAS bf16x8*)(lds + PG8_SA(b, h) + aoff + m * 2048 + k * 1024); } while (0)
#define PG8_LDB(dst, b, h) do { _Pragma("unroll") for (int n = 0; n < 2; ++n) _Pragma("unroll") for (int k = 0; k < 2; ++k) dst[n][k] = *(const PG8_LAS bf16x8*)(lds + PG8_SB(b, h) + boff + n * 2048 + k * 1024); } while (0)
#define PG8_MMA(ai, bj, At, Bt) do { __builtin_amdgcn_s_setprio(1); _Pragma("unroll") for (int m = 0; m < 4; ++m) _Pragma("unroll") for (int n = 0; n < 2; ++n) _Pragma("unroll") for (int k = 0; k < 2; ++k) \
        acc[ai][bj][m][n] = __builtin_amdgcn_mfma_f32_16x16x32_bf16(Bt[n][k], At[m][k], acc[ai][bj][m][n], 0, 0, 0); __builtin_amdgcn_s_setprio(0); } while (0)
#define PG8_WAIT_V(n) asm volatile("s_waitcnt vmcnt(" #n ")" ::: "memory")
#define PG8_WAIT_L(n) asm volatile("s_waitcnt lgkmcnt(" #n ")" ::: "memory")
#define PG8_BAR __builtin_amdgcn_s_barrier()
#define PG8_SCHED __builtin_amdgcn_sched_barrier(0)
    Unit cur, nxt; int ui = 0;
    if (!S.next(0, cur)) return;
    f32x4 acc[2][2][4][2];
#pragma unroll
    for (int a = 0; a < 2; ++a)
#pragma unroll
        for (int b = 0; b < 2; ++b)
#pragma unroll
            for (int m = 0; m < 4; ++m)
#pragma unroll
                for (int n = 0; n < 2; ++n) acc[a][b][m][n] = (f32x4){0.f, 0.f, 0.f, 0.f};
    bf16x8 At[4][2], B0[2][2], B1[2][2];
    const char* cA = (const char*)g.A + (size_t)cur.pm * tstepA + (size_t)cur.kc * cstep; const char* cB = (const char*)g.Bt + (size_t)cur.pn * tstep + (size_t)cur.kc * cstep;
    S.a_ready(cur);
    PG8_STAGE(PG8_SB(0, 0), cB, voffB); PG8_STAGE(PG8_SA(0, 0), cA, voffA); PG8_STAGE(PG8_SB(0, 1), cB + hstep, voffB); PG8_STAGE(PG8_SA(0, 1), cA + hstep, voffA);
    if (wr == 1) PG8_BAR;
    PG8_WAIT_V(4); PG8_BAR;
    PG8_STAGE(PG8_SB(1, 0), cB + kstep, voffB); PG8_STAGE(PG8_SA(1, 0), cA + kstep, voffA); PG8_STAGE(PG8_SB(1, 1), cB + hstep + kstep, voffB);
    PG8_WAIT_V(6); PG8_BAR;
    for (;;) {
        const bool has_next = S.next(ui + 1, nxt);
        const char* nA = has_next ? (const char*)g.A + (size_t)nxt.pm * tstepA + (size_t)nxt.kc * cstep : cA; const char* nB = has_next ? (const char*)g.Bt + (size_t)nxt.pn * tstep + (size_t)nxt.kc * cstep : cB;
        for (int t = 0; t < nt; t += 2) {
            const bool last = (t == nt - 2);
            const char* a1 = cA + (size_t)(t + 1) * kstep;
            const char* a2 = last ? nA : cA + (size_t)(t + 2) * kstep; const char* b2 = last ? nB : cB + (size_t)(t + 2) * kstep;
            const char* a3 = a2 + kstep; const char* b3 = b2 + kstep;
            if (last && has_next) S.a_ready(nxt);
            PG8_LDB(B0, 0, 0); PG8_SCHED; PG8_LDA(At, 0, 0); PG8_STAGE(PG8_SA(1, 1), a1 + hstep, voffA);
            PG8_WAIT_L(8); PG8_BAR; PG8_WAIT_L(0); PG8_MMA(0, 0, At, B0); PG8_BAR; PG8_SCHED;
            PG8_LDB(B1, 0, 1); PG8_STAGE(PG8_SB(0, 0), b2, voffB);
            PG8_BAR; PG8_WAIT_L(0); PG8_MMA(0, 1, At, B1); PG8_BAR;
            PG8_LDA(At, 0, 1); PG8_STAGE(PG8_SA(0, 0), a2, voffA);
            PG8_BAR; PG8_WAIT_L(0); PG8_MMA(1, 0, At, B0); PG8_BAR; PG8_SCHED;
            PG8_STAGE(PG8_SB(0, 1), b2 + hstep, voffB);
            PG8_WAIT_V(6); PG8_BAR; PG8_MMA(1, 1, At, B1); PG8_BAR;
            PG8_LDB(B0, 1, 0); PG8_SCHED; PG8_LDA(At, 1, 0); PG8_STAGE(PG8_SA(0, 1), a2 + hstep, voffA);
            PG8_WAIT_L(8); PG8_BAR; PG8_WAIT_L(0); PG8_MMA(0, 0, At, B0); PG8_BAR; PG8_SCHED;
            PG8_LDB(B1, 1, 1); PG8_STAGE(PG8_SB(1, 0), b3, voffB);
            PG8_BAR; PG8_WAIT_L(0); PG8_MMA(0, 1, At, B1); PG8_BAR;
            PG8_LDA(At, 1, 1); PG8_STAGE(PG8_SA(1, 0), a3, voffA);
            PG8_BAR; PG8_WAIT_L(0); PG8_MMA(1, 0, At, B0); PG8_BAR; PG8_SCHED;
            PG8_STAGE(PG8_SB(1, 1), b3 + hstep, voffB);
            PG8_WAIT_V(6); PG8_BAR; PG8_MMA(1, 1, At, B1); PG8_BAR;
        }
        if constexpr (!Epi::AFTER_DRAIN) { E(acc, cur, wr, wc, fr, fq); S.done(cur); }
        if (!has_next) break;
#pragma unroll
        for (int a = 0; a < 2; ++a)
#pragma unroll
            for (int b = 0; b < 2; ++b)
#pragma unroll
                for (int m = 0; m < 4; ++m)
#pragma unroll
                    for (int n = 0; n < 2; ++n) acc[a][b][m][n] = (f32x4){0.f, 0.f, 0.f, 0.f};
        cur = nxt; cA = nA; cB = nB; ++ui;
    }
    PG8_WAIT_V(0);
    if (wr == 0) PG8_BAR;
    PG8_BAR;
    if constexpr (Epi::AFTER_DRAIN) { E.fused(acc, cur, wr, wc, fr, fq, lds, wid, lane); S.done(cur); }
#undef PG8_SA
#undef PG8_SB
#undef PG8_STAGE
#undef PG8_LDA
#undef PG8_LDB
#undef PG8_MMA
#undef PG8_WAIT_V
#undef PG8_WAIT_L
#undef PG8_BAR
#undef PG8_SCHED
}
}
#define XB_TMO      128
#define XB_XCNT(j)  (256  + 64 * (j))
#define XB_XSUB(j)  (1280 + 64 * (j))
#define XB_XGEN(j)  (2304 + 64 * (j))
#define XB_TOP      3328
#define XB_TOPGEN   3392
#define XCD_BAR_WORDS 3456
#define XB_SPIN_CAP (1u << 18)

__device__ __forceinline__ unsigned xb_ld(unsigned* p)              { return __hip_atomic_load(p, __ATOMIC_RELAXED, __HIP_MEMORY_SCOPE_AGENT); }
__device__ __forceinline__ unsigned xb_add(unsigned* p, unsigned v) { return __hip_atomic_fetch_add(p, v, __ATOMIC_RELAXED, __HIP_MEMORY_SCOPE_AGENT); }
__device__ __forceinline__ unsigned xb_xcc_id() { return (unsigned)__builtin_amdgcn_s_getreg((3 << 11) | 20) & 0xFu; }
#define XB_SPIN(cond, bar) do { unsigned _sp = 0; while (cond) { __builtin_amdgcn_s_sleep(1); \
    if ((++_sp & 255u) == 0u) { if (xb_ld(&(bar)[XB_TMO])) break; if (_sp > XB_SPIN_CAP) { atomicAdd(&(bar)[XB_TMO], 1u); break; } } } } while (0)

struct XcdBarrier {
    unsigned* bar; unsigned x;
    volatile LAS unsigned* st;
};

__device__ __forceinline__ XcdBarrier xcd_barrier_post(unsigned* bar, volatile LAS unsigned* st) {
    XcdBarrier b; b.bar = bar; b.x = xb_xcc_id(); b.st = st;
    if (threadIdx.x == 0) (void)xb_add(&bar[XB_XCNT(b.x)], 1u);
    return b;
}
__device__ __forceinline__ void xcd_barrier_complete(unsigned* bar, unsigned x, unsigned& nloc, unsigned& nx) {
    const unsigned G = gridDim.x * gridDim.y * gridDim.z;
    unsigned sum, cnt, mine, sp = 0u;
    for (;;) {
        sum = 0u; cnt = 0u; mine = 0u;
#pragma unroll
        for (unsigned j = 0; j < 16; ++j) { const unsigned c = xb_ld(&bar[XB_XCNT(j)]); sum += c; cnt += (c > 0u) ? 1u : 0u; mine = (j == x) ? c : mine; }
        if (sum == G) break;
        __builtin_amdgcn_s_sleep(1);
        if ((++sp & 255u) == 0u) { if (xb_ld(&bar[XB_TMO])) break; if (sp > XB_SPIN_CAP) { atomicAdd(&bar[XB_TMO], 1u); break; } }
    }
    nloc = mine > 0u ? mine : 1u; nx = cnt > 0u ? cnt : 1u;
}

__device__ __forceinline__ void xcd_barrier(const XcdBarrier& b) {
    asm volatile("s_waitcnt vmcnt(0)" ::: "memory");
    __syncthreads();
    if (threadIdx.x == 0) {
        unsigned* bar = b.bar;
        __builtin_amdgcn_s_waitcnt(0);
        unsigned nloc = b.st[0], nx = b.st[1];
        if (nloc == 0u) { xcd_barrier_complete(bar, b.x, nloc, nx); b.st[0] = nloc; b.st[1] = nx; }
        const unsigned old = xb_add(&bar[XB_XSUB(b.x)], 1u);
        const unsigned gen = old / nloc;
        if (old + 1u == (gen + 1u) * nloc) {
            __builtin_amdgcn_fence(__ATOMIC_RELEASE, "agent");
            asm volatile("s_waitcnt vmcnt(0)" ::: "memory");
            const unsigned og = xb_add(&bar[XB_TOP], 1u);
            const unsigned tg = og / nx;
            if (og + 1u == (tg + 1u) * nx) xb_add(&bar[XB_TOPGEN], 1u);
            else XB_SPIN(xb_ld(&bar[XB_TOPGEN]) == tg, bar);
            __builtin_amdgcn_fence(__ATOMIC_ACQUIRE, "agent");
            xb_add(&bar[XB_XGEN(b.x)], 1u);
            asm volatile("s_waitcnt vmcnt(0)" ::: "memory");
        } else {
            XB_SPIN(xb_ld(&bar[XB_XGEN(b.x)]) == gen, bar);
            __builtin_amdgcn_fence(__ATOMIC_ACQUIRE, "agent");
            asm volatile("s_waitcnt vmcnt(0)" ::: "memory");
        }
    }
    __syncthreads();
}


using pg8::bf16_t; using pg8::bf16x8; using pg8::f32x4; using pg8::u32x4;
typedef float f32x16 __attribute__((ext_vector_type(16)));
typedef unsigned u32x2 __attribute__((ext_vector_type(2)));

constexpr int DM = 1024, NB = 8, SEQ = 4096, CTXL = 256, ML = NB * SEQ, MC = NB * CTXL, MT = ML + MC, NH = 16, HD = 64, DFF = 3072;
constexpr int NCHUNK = 34;
constexpr float EPSN = 1e-6f;
constexpr size_t MiB = (size_t)1 << 20, MEL = (size_t)1 << 20;
constexpr size_t WS_MODS = 0, WS_SUM = 1 * MiB, WS_BAR = 8 * MiB, WS_BDW = 9 * MiB, WS_CTXR = 10 * MiB, WS_WB = 18 * MiB, WS_HN = 118 * MiB, WS_R = 186 * MiB, WS_PART = (186 + 272) * MiB, WS_END = 510 * MiB;
constexpr size_t R_Q = 0, R_K = (size_t)MT * DM, R_VT = 2 * (size_t)MT * DM;
constexpr size_t R_GATE = 0, R_REC = (size_t)MT * DM, R_XR = 2 * (size_t)MT * DM, R_YP = 3 * (size_t)MT * DM;
constexpr size_t R_U = 0, R_G = 0;
constexpr int LDS_BYTES = 147456;

enum { OP_PRO = 0, OP_NORM, OP_GQK, OP_GST, OP_GRES, OP_ATTN, OP_LCONV, OP_LRUA, OP_LRUC, OP_FCONV, OP_GUP };
#ifndef DUP_MASK
#define DUP_MASK 0
#endif
#define DUPE(op, i, arg) DUPE_(((DUP_MASK >> op) & 1), op, i, arg)
#define DUPE_(c, op, i, arg) DUPE__(c, op, i, arg)
#define DUPE__(c, op, i, arg) DUPE_##c(op, i, arg)
#define DUPE_0(op, i, arg)
#define DUPE_1(op, i, arg) {op, i, arg, 0},
#if DUP_MASK & 2
#define DN(i, a) {OP_NORM, i, a, 0},
#else
#define DN(i, a)
#endif
#if DUP_MASK & 4
#define DQK(i) {OP_GQK, i, 0, 0},
#else
#define DQK(i)
#endif
#if DUP_MASK & 8
#define DST(i, a) {OP_GST, i, a, 0},
#else
#define DST(i, a)
#endif
#if DUP_MASK & 32
#define DAT(i) {OP_ATTN, i, 1, 0},
#else
#define DAT(i)
#endif
#if DUP_MASK & 64
#define DLC(i) {OP_LCONV, i, 0, 0},
#else
#define DLC(i)
#endif
#if DUP_MASK & 128
#define DLA(i) {OP_LRUA, i, 0, 0},
#else
#define DLA(i)
#endif
#if DUP_MASK & 256
#define DLCC(i) {OP_LRUC, i, 0, 0},
#else
#define DLCC(i)
#endif
#if DUP_MASK & 1024
#define DUP_(i) {OP_GUP, i, 0, 0},
#else
#define DUP_(i)
#endif
#if DUP_MASK & 1
#define DPRO {OP_PRO, 0, 0, 0},
#else
#define DPRO
#endif
#define FFN_OPS(i) DN(i, 1) {OP_NORM, i, 1, 1}, DUP_(i) {OP_GUP, i, 0, 1}, {OP_GRES, i, 2, 1}
#define NA_OPS(i) DN(i, 0) {OP_NORM, i, 0, 1}, DQK(i) {OP_GQK, i, 0, 0}, DST(i, 0) {OP_GST, i, 0, 1}, DAT(i) {OP_ATTN, i, 0, 1}, {OP_GRES, i, 0, 1}, FFN_OPS(i)
#define LRU_OPS(i) DN(i, 0) {OP_NORM, i, 0, 1}, DST(i, 1) {OP_GST, i, 1, 1}, DLC(i) {OP_LCONV, i, 0, 1}, DLA(i) {OP_LRUA, i, 0, 1}, DLCC(i) {OP_LRUC, i, 0, 1}, {OP_GRES, i, 0, 1}, FFN_OPS(i)
#define PROG_INIT { DPRO {OP_PRO, 0, 0, 1}, NA_OPS(0), LRU_OPS(1), NA_OPS(2), LRU_OPS(3) }
__device__ const int PROG[][4] = PROG_INIT;
static const int HOSTPROG[][4] = PROG_INIT;
constexpr int NPROG = (int)(sizeof(HOSTPROG) / sizeof(HOSTPROG[0]));

struct Args { const float* in[26]; float* out; unsigned char* ws; int pc_lo, pc_hi; };

__device__ __forceinline__ unsigned f2bf(float f) { unsigned u = __float_as_uint(f); return (u + 0x7fffu + ((u >> 16) & 1u)) >> 16; }
__device__ __forceinline__ unsigned pk2(float lo, float hi) { return f2bf(lo) | (f2bf(hi) << 16); }
__device__ __forceinline__ float bflo(unsigned w) { return __uint_as_float(w << 16); }
__device__ __forceinline__ float bfhi(unsigned w) { return __uint_as_float(w & 0xffff0000u); }
__device__ __forceinline__ float wave_sum(float v) {
#pragma unroll
    for (int o = 1; o < 64; o <<= 1) v += __shfl_xor(v, o);
    return v;
}
__device__ __forceinline__ float fexp(float x) { return __builtin_amdgcn_exp2f(x * 1.4426950408889634f); }
__device__ __forceinline__ float sigmoidf_(float x) { return __builtin_amdgcn_rcpf(1.0f + __builtin_amdgcn_exp2f(x * -1.4426950408889634f)); }
__device__ __forceinline__ f32x16 mfma32(bf16x8 a, bf16x8 b, f32x16 c) { return __builtin_amdgcn_mfma_f32_32x32x16_bf16(a, b, c, 0, 0, 0); }
__device__ __forceinline__ f32x4 mfma16(bf16x8 a, bf16x8 b, f32x4 c) { return __builtin_amdgcn_mfma_f32_16x16x32_bf16(a, b, c, 0, 0, 0); }

struct EpiStore {
    static constexpr bool PERM = true, AFTER_DRAIN = false;
    bf16_t* O; int ldc; int split_cols; size_t split_stride;
    __device__ __forceinline__ void operator()(const f32x4 (&acc)[2][2][4][2], const pg8::Unit& u, int wr, int wc, int fr, int fq) const {
        const int row0 = u.pm * 256 + wr * 64 + fr; int colt = u.pn * 256; bf16_t* base = O;
        if (split_cols) { const int t = colt / split_cols; base += (size_t)t * split_stride; colt -= t * split_cols; }
        const int col0 = colt + wc * 32 + 8 * fq;
#pragma unroll
        for (int ai = 0; ai < 2; ++ai)
#pragma unroll
            for (int m = 0; m < 4; ++m) { bf16_t* rowp = base + (size_t)(row0 + ai * 128 + m * 16) * ldc + col0;
#pragma unroll
                for (int bj = 0; bj < 2; ++bj) { const f32x4 v0 = acc[ai][bj][m][0], v1 = acc[ai][bj][m][1];
                    u32x4 w; w.x = pg8::cvt_pk_bf16(v0[0], v0[1]); w.y = pg8::cvt_pk_bf16(v0[2], v0[3]); w.z = pg8::cvt_pk_bf16(v1[0], v1[1]); w.w = pg8::cvt_pk_bf16(v1[2], v1[3]);
                    *(u32x4*)(rowp + bj * 128) = w; } }
    }
};
struct EpiQK {
    static constexpr bool PERM = true, AFTER_DRAIN = false;
    bf16_t* Q; bf16_t* K; const float* qg; const float* kg;
    __device__ __forceinline__ void operator()(const f32x4 (&acc)[2][2][4][2], const pg8::Unit& u, int wr, int wc, int fr, int fq) const {
        const int row0 = u.pm * 256 + wr * 64 + fr; const bool isk = u.pn >= 4;
        bf16_t* base = (isk ? K : Q) + (u.pn & 3) * 256 + 64 * wc + 8 * fq;
        const float* g = isk ? kg : qg; const float sc = isk ? 1.0f : 0.125f;
        f32x4 gv[2][2];
#pragma unroll
        for (int bj = 0; bj < 2; ++bj)
#pragma unroll
            for (int n = 0; n < 2; ++n) gv[bj][n] = *(const f32x4*)(g + 32 * bj + 8 * fq + 4 * n) * sc;
#pragma unroll
        for (int ai = 0; ai < 2; ++ai)
#pragma unroll
            for (int m = 0; m < 4; ++m) {
                float ss = 0.f;
#pragma unroll
                for (int bj = 0; bj < 2; ++bj)
#pragma unroll
                    for (int n = 0; n < 2; ++n) { const f32x4 x = acc[ai][bj][m][n]; ss += (x[0] * x[0] + x[1] * x[1]) + (x[2] * x[2] + x[3] * x[3]); }
                ss += __shfl_xor(ss, 16); ss += __shfl_xor(ss, 32);
                const float rs = __builtin_amdgcn_rsqf(ss * (1.0f / 64.0f) + EPSN);
                bf16_t* rowp = base + (size_t)(row0 + ai * 128 + m * 16) * DM;
#pragma unroll
                for (int bj = 0; bj < 2; ++bj) { const f32x4 v0 = acc[ai][bj][m][0] * rs * gv[bj][0], v1 = acc[ai][bj][m][1] * rs * gv[bj][1];
                    u32x4 w; w.x = pg8::cvt_pk_bf16(v0[0], v0[1]); w.y = pg8::cvt_pk_bf16(v0[2], v0[3]); w.z = pg8::cvt_pk_bf16(v1[0], v1[1]); w.w = pg8::cvt_pk_bf16(v1[2], v1[3]);
                    *(u32x4*)(rowp + 32 * bj) = w; }
            }
    }
};
struct EpiRes {
    static constexpr bool PERM = false, AFTER_DRAIN = false;
    const float* in_lat; const float* in_ctx; float* out_lat; float* out_ctx; const float* gate; int row_off;
    __device__ __forceinline__ void operator()(const f32x4 (&acc)[2][2][4][2], const pg8::Unit& u, int wr, int wc, int fr, int fq) const {
        const int R0 = row_off + u.pm * 256;
        const float* inp; float* outp; int bidx;
        if (R0 < ML) { bidx = R0 >> 12; inp = in_lat + (size_t)R0 * DM; outp = out_lat + (size_t)R0 * DM; }
        else { bidx = 8; inp = in_ctx + (size_t)(R0 - ML) * DM; outp = out_ctx + (size_t)(R0 - ML) * DM; }
        const int col0 = u.pn * 256 + wc * 32 + 4 * fq;
        const float* gp = gate + (size_t)bidx * 6144 + col0;
        f32x4 gv[2][2];
#pragma unroll
        for (int bj = 0; bj < 2; ++bj)
#pragma unroll
            for (int n = 0; n < 2; ++n) gv[bj][n] = *(const f32x4*)(gp + bj * 128 + n * 16);
#pragma unroll
        for (int ai = 0; ai < 2; ++ai)
#pragma unroll
            for (int m = 0; m < 4; ++m) { const size_t ro = (size_t)(wr * 64 + fr + ai * 128 + m * 16) * DM + col0;
#pragma unroll
                for (int bj = 0; bj < 2; ++bj)
#pragma unroll
                    for (int n = 0; n < 2; ++n) { const size_t o = ro + bj * 128 + n * 16; *(f32x4*)(outp + o) = *(const f32x4*)(inp + o) + gv[bj][n] * acc[ai][bj][m][n]; } }
    }
};


struct CtxSplitOrder {
    int nkc, G, c, pm0;
    __device__ __forceinline__ bool next(int i, pg8::Unit& u) const {
        const int L = i * G + c; if (L >= 8 * 4 * nkc) return false;
        u.kc = L % nkc; u.pn = (L / nkc) & 3; u.pm = pm0 + L / (nkc * 4); return true;
    }
    __device__ __forceinline__ void a_ready(const pg8::Unit&) const {}
    __device__ __forceinline__ void done(const pg8::Unit&) const {}
};
struct EpiPart {
    static constexpr bool PERM = false, AFTER_DRAIN = false;
    float* part;
    __device__ __forceinline__ void operator()(const f32x4 (&acc)[2][2][4][2], const pg8::Unit& u, int wr, int wc, int fr, int fq) const {
        float* outp = part + ((size_t)u.kc * MC + (size_t)(u.pm * 256 - ML)) * DM;
        const int col0 = u.pn * 256 + wc * 32 + 4 * fq;
#pragma unroll
        for (int ai = 0; ai < 2; ++ai)
#pragma unroll
            for (int m = 0; m < 4; ++m) { float* rp = outp + (size_t)(wr * 64 + fr + ai * 128 + m * 16) * DM + col0;
#pragma unroll
                for (int bj = 0; bj < 2; ++bj)
#pragma unroll
                    for (int n = 0; n < 2; ++n) *(f32x4*)(rp + bj * 128 + n * 16) = acc[ai][bj][m][n]; }
    }
};

template <int CTRL> __device__ __forceinline__ float dppf(float x) { return __int_as_float(__builtin_amdgcn_mov_dpp(__float_as_int(x), CTRL, 0xf, 0xf, true)); }
struct EpiUpConv {
    static constexpr bool PERM = true, AFTER_DRAIN = false;
    bf16_t* Gb; const float* cw; const float* cbias; LAS float* xb;
    __device__ __forceinline__ void operator()(const f32x4 (&acc)[2][2][4][2], const pg8::Unit& u, int wr, int wc, int fr, int fq) const {
        const int cl = 32 * wc + 8 * fq, cv = u.pn * 128 + cl;
#pragma unroll
        for (int ai = 0; ai < 2; ++ai) { const int s = 2 * ai + wr;
            if (fr == 0) { LAS float* p = xb + (s * 2 + 0) * 256 + cl; *(LAS f32x4*)p = acc[ai][0][0][0]; *(LAS f32x4*)(p + 4) = acc[ai][0][0][1]; *(LAS f32x4*)(p + 128) = acc[ai][1][0][0]; *(LAS f32x4*)(p + 132) = acc[ai][1][0][1]; }
            if (fr == 15) { LAS float* p = xb + (s * 2 + 1) * 256 + cl; *(LAS f32x4*)p = acc[ai][0][3][0]; *(LAS f32x4*)(p + 4) = acc[ai][0][3][1]; *(LAS f32x4*)(p + 128) = acc[ai][1][3][0]; *(LAS f32x4*)(p + 132) = acc[ai][1][3][1]; } }
        asm volatile("s_waitcnt lgkmcnt(0)\n\ts_barrier\n\ts_barrier" ::: "memory");
        const int R0 = 254 * u.pm - 1;
        bool bnd = false;
#pragma unroll
        for (int ai = 0; ai < 2; ++ai)
#pragma unroll
            for (int m = 0; m < 4; ++m) { const int row = R0 + 128 * ai + 64 * wr + 16 * m + fr;
                int pos, last; if (row < ML) { pos = row & (SEQ - 1); last = SEQ - 1; } else { pos = (row - ML) & (CTXL - 1); last = CTXL - 1; }
                bnd = bnd || pos == 0 || pos == last || row < 0 || row >= MT; }
        if (__builtin_amdgcn_ballot_w64(bnd) == 0ull) {
#pragma unroll
            for (int n = 0; n < 2; ++n) {
                f32x4 wv[3], wg[3], bv, bg;
#pragma unroll
                for (int k = 0; k < 3; ++k) { wv[k] = *(const f32x4*)(cw + k * 6144 + cv + 4 * n); wg[k] = *(const f32x4*)(cw + k * 6144 + DFF + cv + 4 * n); }
                bv = *(const f32x4*)(cbias + cv + 4 * n); bg = *(const f32x4*)(cbias + DFF + cv + 4 * n);
#pragma unroll
                for (int ai = 0; ai < 2; ++ai) { const int s = 2 * ai + wr;
#pragma unroll
                    for (int m = 0; m < 4; ++m) {
                        const int rl = 128 * ai + 64 * wr + 16 * m + fr, row = R0 + rl;
                        f32x4 xpv, xpg, xnv, xng;
                        if (m == 0) { const LAS float* p = xb + ((s > 0 ? s - 1 : 0) * 2 + 1) * 256 + cl + 4 * n; xpv = *(const LAS f32x4*)p; xpg = *(const LAS f32x4*)(p + 128); }
                        if (m == 3) { const LAS float* p = xb + ((s < 3 ? s + 1 : 3) * 2 + 0) * 256 + cl + 4 * n; xnv = *(const LAS f32x4*)p; xng = *(const LAS f32x4*)(p + 128); }
                        float o[4];
#pragma unroll
                        for (int e = 0; e < 4; ++e) {
                            const float cvv = acc[ai][0][m][n][e], cgg = acc[ai][1][m][n][e];
                            const float upv = m > 0 ? acc[ai][0][m > 0 ? m - 1 : 0][n][e] : xpv[e], upg = m > 0 ? acc[ai][1][m > 0 ? m - 1 : 0][n][e] : xpg[e];
                            const float dnv = m < 3 ? acc[ai][0][m < 3 ? m + 1 : 3][n][e] : xnv[e], dng = m < 3 ? acc[ai][1][m < 3 ? m + 1 : 3][n][e] : xng[e];
                            const float xpv_ = fr == 15 ? upv : cvv, xpg_ = fr == 15 ? upg : cgg;
                            const float xnv_ = fr == 0 ? dnv : cvv, xng_ = fr == 0 ? dng : cgg;
                            float val = bv[e] + wv[1][e] * cvv; val += wv[0][e] * dppf<0x121>(xpv_); val += wv[2][e] * dppf<0x12F>(xnv_);
                            float gt = bg[e] + wg[1][e] * cgg; gt += wg[0][e] * dppf<0x121>(xpg_); gt += wg[2][e] * dppf<0x12F>(xng_);
                            o[e] = val * gt * sigmoidf_(gt);
                        }
                        u32x2 ow; ow.x = pg8::cvt_pk_bf16(o[0], o[1]); ow.y = pg8::cvt_pk_bf16(o[2], o[3]);
                        if (rl >= 1 && rl <= 254) *(u32x2*)(Gb + (size_t)row * DFF + cv + 4 * n) = ow;
                    }
                }
            }
            return;
        }
#pragma unroll
        for (int n = 0; n < 2; ++n) {
            f32x4 wv[3], wg[3], bv, bg;
#pragma unroll
            for (int k = 0; k < 3; ++k) { wv[k] = *(const f32x4*)(cw + k * 6144 + cv + 4 * n); wg[k] = *(const f32x4*)(cw + k * 6144 + DFF + cv + 4 * n); }
            bv = *(const f32x4*)(cbias + cv + 4 * n); bg = *(const f32x4*)(cbias + DFF + cv + 4 * n);
#pragma unroll
            for (int ai = 0; ai < 2; ++ai) { const int s = 2 * ai + wr;
#pragma unroll
                for (int m = 0; m < 4; ++m) {
                    const int rl = 128 * ai + 64 * wr + 16 * m + fr, row = R0 + rl;
                    int pos, last; if (row < ML) { pos = row & (SEQ - 1); last = SEQ - 1; } else { pos = (row - ML) & (CTXL - 1); last = CTXL - 1; }
                    const bool pok = pos > 0, nok = pos < last;
                    f32x4 xpv, xpg, xnv, xng;
                    if (m == 0) { const LAS float* p = xb + ((s > 0 ? s - 1 : 0) * 2 + 1) * 256 + cl + 4 * n; xpv = *(const LAS f32x4*)p; xpg = *(const LAS f32x4*)(p + 128); }
                    if (m == 3) { const LAS float* p = xb + ((s < 3 ? s + 1 : 3) * 2 + 0) * 256 + cl + 4 * n; xnv = *(const LAS f32x4*)p; xng = *(const LAS f32x4*)(p + 128); }
                    float o[4];
#pragma unroll
                    for (int e = 0; e < 4; ++e) {
                        const float cvv = acc[ai][0][m][n][e], cgg = acc[ai][1][m][n][e];
                        const float av = dppf<0x121>(cvv), ag = dppf<0x121>(cgg);
                        float bvv, bgg;
                        if (m > 0) { bvv = dppf<0x121>(acc[ai][0][m > 0 ? m - 1 : 0][n][e]); bgg = dppf<0x121>(acc[ai][1][m > 0 ? m - 1 : 0][n][e]); } else { bvv = xpv[e]; bgg = xpg[e]; }
                        float pvv = fr == 0 ? bvv : av, pgg = fr == 0 ? bgg : ag;
                        const float a2v = dppf<0x12F>(cvv), a2g = dppf<0x12F>(cgg);
                        float b2v, b2g;
                        if (m < 3) { b2v = dppf<0x12F>(acc[ai][0][m < 3 ? m + 1 : 3][n][e]); b2g = dppf<0x12F>(acc[ai][1][m < 3 ? m + 1 : 3][n][e]); } else { b2v = xnv[e]; b2g = xng[e]; }
                        float nvv = fr == 15 ? b2v : a2v, ngg = fr == 15 ? b2g : a2g;
                        pvv = pok ? pvv : 0.f; pgg = pok ? pgg : 0.f; nvv = nok ? nvv : 0.f; ngg = nok ? ngg : 0.f;
                        const float val = bv[e] + wv[0][e] * pvv + wv[1][e] * cvv + wv[2][e] * nvv;
                        const float gt = bg[e] + wg[0][e] * pgg + wg[1][e] * cgg + wg[2][e] * ngg;
                        o[e] = val * gt * sigmoidf_(gt);
                    }
                    u32x2 ow; ow.x = pg8::cvt_pk_bf16(o[0], o[1]); ow.y = pg8::cvt_pk_bf16(o[2], o[3]);
                    if (rl >= 1 && rl <= 254 && row >= 0 && row < MT) *(u32x2*)(Gb + (size_t)row * DFF + cv + 4 * n) = ow;
                }
            }
        }
    }
};

__device__ __forceinline__ void transpose_item(const float* W, int ldw, int K, int ncol0, int ncols, bf16_t* WT, int perm, LAS float* scr, int item, int lane) {
    const int nblk = ncols / 32, kb = item / nblk, nb = item % nblk, k0 = 64 * kb, n0 = 32 * nb;
    { f32x4 v[8];
#pragma unroll
      for (int i = 0; i < 8; ++i) v[i] = *(const f32x4*)(W + (size_t)(k0 + (lane >> 3) + 8 * i) * ldw + ncol0 + n0 + 4 * (lane & 7));
#pragma unroll
      for (int i = 0; i < 8; ++i) { LAS float* d = scr + ((lane >> 3) + 8 * i) * 33 + 4 * (lane & 7); d[0] = v[i][0]; d[1] = v[i][1]; d[2] = v[i][2]; d[3] = v[i][3]; } }
    asm volatile("s_waitcnt lgkmcnt(0)" ::: "memory");
    int d0 = n0;
    if (perm == 1) { const int pn = n0 >> 8, wc = (n0 >> 6) & 3, bj = (n0 >> 5) & 1; d0 = pn * 256 + bj * 128 + wc * 32; }
    else if (perm == 2) { const int isg = n0 >= DFF, nn = isg ? n0 - DFF : n0; d0 = (nn >> 7) * 256 + isg * 128 + (nn & 127); }
    const int c = lane & 7;
#pragma unroll
    for (int j = 0; j < 4; ++j) { const int n = (lane >> 3) + 8 * j; const LAS float* s = scr + (8 * c) * 33 + n;
        u32x4 o; o.x = pk2(s[0 * 33], s[1 * 33]); o.y = pk2(s[2 * 33], s[3 * 33]); o.z = pk2(s[4 * 33], s[5 * 33]); o.w = pk2(s[6 * 33], s[7 * 33]);
        *(u32x4*)(WT + (size_t)(d0 + n) * K + k0 + 8 * c) = o; }
    asm volatile("s_waitcnt lgkmcnt(0)" ::: "memory");
}
struct TDesc { const float* src; int ldw, K, ncol0, ncols, perm; bf16_t* dst; int nitems; };
__device__ __forceinline__ TDesc get_tdesc(int m, const Args& a, bf16_t* WB) {
    TDesc t;
    if (m < 6) { const int j = m / 3, w = m % 3;
        if (w == 0) { t.src = a.in[8] + (size_t)j * DM * 3072; t.ldw = 3072; t.K = DM; t.ncol0 = 0; t.ncols = 2048; t.perm = 1; t.dst = WB + (size_t)j * 4 * MEL; }
        else if (w == 1) { t.src = a.in[8] + (size_t)j * DM * 3072; t.ldw = 3072; t.K = DM; t.ncol0 = 2048; t.ncols = 1024; t.perm = 0; t.dst = WB + (size_t)j * 4 * MEL + 2 * MEL; }
        else { t.src = a.in[12] + (size_t)j * DM * DM; t.ldw = DM; t.K = DM; t.ncol0 = 0; t.ncols = DM; t.perm = 0; t.dst = WB + (size_t)j * 4 * MEL + 3 * MEL; }
    } else if (m < 10) { const int j = (m - 6) / 2, w = (m - 6) % 2;
        if (w == 0) { t.src = a.in[13] + (size_t)j * DM * 2048; t.ldw = 2048; t.K = DM; t.ncol0 = 0; t.ncols = 2048; t.perm = 0; t.dst = WB + 8 * MEL + (size_t)j * 3 * MEL; }
        else { t.src = a.in[21] + (size_t)j * DM * DM; t.ldw = DM; t.K = DM; t.ncol0 = 0; t.ncols = DM; t.perm = 0; t.dst = WB + 8 * MEL + (size_t)j * 3 * MEL + 2 * MEL; }
    } else { const int i = (m - 10) / 2, w = (m - 10) % 2;
        if (w == 0) { t.src = a.in[22] + (size_t)i * DM * 6144; t.ldw = 6144; t.K = DM; t.ncol0 = 0; t.ncols = 6144; t.perm = 2; t.dst = WB + 14 * MEL + (size_t)i * 9 * MEL; }
        else { t.src = a.in[25] + (size_t)i * DFF * DM; t.ldw = DM; t.K = DFF; t.ncol0 = 0; t.ncols = DM; t.perm = 0; t.dst = WB + 14 * MEL + (size_t)i * 9 * MEL + 6 * MEL; }
    }
    t.nitems = (t.K / 64) * (t.ncols / 32);
    return t;
}
__device__ __forceinline__ void prologue(const Args& a, LAS unsigned char* lds, int tid, int lane, int wave, int G) {
    unsigned char* ws = a.ws;
    float* MODS = (float*)(ws + WS_MODS);
    bf16_t* WB = (bf16_t*)(ws + WS_WB);
    bf16_t* BDW = (bf16_t*)(ws + WS_BDW);
    LAS float* sl = (LAS float*)(lds + 69632);
    LAS float* red = (LAS float*)(lds + 69632 + 36864);
    for (int i = tid; i < 9 * DM; i += 512) { const int bi = i >> 10, k = i & 1023; const float v = bi < 8 ? a.in[1][bi * DM + k] : a.in[3][k]; sl[i] = v * sigmoidf_(v); }
    __syncthreads();
    for (int it = opaque_bid(); it < 4 * 96; it += G) {
        const int l = it / 96, n0 = (it % 96) * 64;
        const float* wp = a.in[4] + ((size_t)l * DM + wave * 128) * 6144 + n0 + lane;
        float acc[9];
#pragma unroll
        for (int bi = 0; bi < 9; ++bi) acc[bi] = 0.f;
        for (int k = 0; k < 128; k += 16) {
            float w[16];
#pragma unroll
            for (int kk = 0; kk < 16; ++kk) w[kk] = wp[(size_t)(k + kk) * 6144];
#pragma unroll
            for (int k4 = 0; k4 < 16; k4 += 4)
#pragma unroll
                for (int bi = 0; bi < 9; ++bi) { const f32x4 s = *(const LAS f32x4*)(sl + bi * DM + wave * 128 + k + k4); acc[bi] += (s[0] * w[k4] + s[1] * w[k4 + 1]) + (s[2] * w[k4 + 2] + s[3] * w[k4 + 3]); }
        }
#pragma unroll
        for (int bi = 0; bi < 9; ++bi) red[(wave * 9 + bi) * 64 + lane] = acc[bi];
        __syncthreads();
        for (int o = tid; o < 9 * 64; o += 512) { const int bi = o >> 6, ln = o & 63; float s = a.in[5][(size_t)l * 6144 + n0 + ln];
#pragma unroll
            for (int w = 0; w < 8; ++w) s += red[(w * 9 + bi) * 64 + ln];
            MODS[((size_t)l * 9 + bi) * 6144 + n0 + ln] = s; }
        __syncthreads();
    }
    { float* CTXR = (float*)(ws + WS_CTXR);
      for (int i = opaque_bid() * 512 + tid; i < MC * DM / 4; i += G * 512) { asm volatile("" : "+v"(i)); ((f32x4*)CTXR)[i] = ((const f32x4*)a.in[2])[i]; } }
#pragma unroll 1
    for (int idx = opaque_bid() * 512 + tid; idx < 2 * 2 * 2 * 16 * 4096; idx += G * 512) { asm volatile("" : "+v"(idx));
        const int d = idx & 63, e = (idx >> 6) & 63, n = (idx >> 12) & 15, gt = (idx >> 16) & 1, dir = (idx >> 17) & 1, j = idx >> 18;
        const float* W = gt ? a.in[18] : a.in[16];
        BDW[idx] = (bf16_t)f2bf(W[((((size_t)j * 2 + dir) * 16 + n) * 64 + d) * 64 + e]);
    }
    LAS float* scr = (LAS float*)(lds + wave * 8448);
    const int gw = opaque_bid() * 8 + wave, NGW = G * 8;
    int base = 0;
    for (int m = 0; m < 18; ++m) {
        const TDesc t = get_tdesc(m, a, WB);
        int first = (gw - base) % NGW; if (first < 0) first += NGW;
        for (int it = first; it < t.nitems; it += NGW) transpose_item(t.src, t.ldw, t.K, t.ncol0, t.ncols, t.dst, t.perm, scr, it, lane);
        base = (base + t.nitems) % NGW;
    }
}

__device__ __forceinline__ void norm_phase(const float* xl, const float* xc, bf16_t* HN, const float* gain, const float* mods_l, int sidx, int nrows, int lane, int gw, int NGW,
                                           float* ctxr_rw, const float* part, int npart, const float* pgate) {
    for (int row = gw; row < nrows; row += NGW) {
        const float* src; int bidx;
        if (row < ML) { src = xl + (size_t)row * DM; bidx = row >> 12; } else { src = xc + (size_t)(row - ML) * DM; bidx = 8; }
        const f32x4* xr = (const f32x4*)src + lane;
        f32x4 v[4]; float s = 0.f;
#pragma unroll
        for (int j = 0; j < 4; ++j) v[j] = xr[64 * j];
        if (row >= ML && npart > 0) {
            f32x4 ps[4];
#pragma unroll
            for (int j = 0; j < 4; ++j) ps[j] = (f32x4){0.f, 0.f, 0.f, 0.f};
            for (int kc = 0; kc < npart; ++kc) { const f32x4* pr = (const f32x4*)(part + ((size_t)kc * MC + (row - ML)) * DM) + lane;
#pragma unroll
                for (int j = 0; j < 4; ++j) ps[j] += pr[64 * j]; }
            f32x4* wr_ = (f32x4*)(ctxr_rw + (size_t)(row - ML) * DM) + lane;
#pragma unroll
            for (int j = 0; j < 4; ++j) { v[j] += *(const f32x4*)(pgate + 4 * (lane + 64 * j)) * ps[j]; wr_[64 * j] = v[j]; }
        }
#pragma unroll
        for (int j = 0; j < 4; ++j) s += (v[j][0] * v[j][0] + v[j][1] * v[j][1]) + (v[j][2] * v[j][2] + v[j][3] * v[j][3]);
        const float rstd = __builtin_amdgcn_rsqf(wave_sum(s) * (1.0f / DM) + EPSN);
        const float* shp = mods_l + (size_t)bidx * 6144 + sidx * DM; const float* scp = shp + DM;
        u32x2* o8 = (u32x2*)(HN + (size_t)row * DM) + lane;
#pragma unroll
        for (int j = 0; j < 4; ++j) { const int col = 4 * (lane + 64 * j);
            const f32x4 g = *(const f32x4*)(gain + col), sh = *(const f32x4*)(shp + col), sc = *(const f32x4*)(scp + col);
            const f32x4 y = v[j] * rstd * g * (sc + 1.0f) + sh;
            u32x2 w; w.x = pk2(y[0], y[1]); w.y = pk2(y[2], y[3]); o8[64 * j] = w; }
    }
}

template <bool CTXQ>
__device__ __forceinline__ void attn_task(const bf16_t* QO, bf16_t* OO, const bf16_t* Kb, const bf16_t* VT, const float* rpb, int lane, int task) {
    constexpr int G0 = CTXQ ? 8 : 0;
    const int q = lane & 15, g = lane >> 4;
    int cb, r, h, b, q0, ks, rs; size_t qrow;
    if (CTXQ) { const int qb = task & 15; h = (task >> 4) & 15; b = task >> 8; cb = 0; r = 0; q0 = 0; ks = 0; rs = 0; qrow = (size_t)ML + b * CTXL + qb * 16 + q; }
    else { cb = task & 3; r = (task >> 2) & 63; h = (task >> 8) & 15; b = task >> 12; q0 = cb * 16; ks = min(max(q0 - 8, 0), 32); rs = min(max(r - 4, 0), 56); qrow = (size_t)b * SEQ + r * 64 + q0 + q; }
    const bf16x8 qf0 = *(const bf16x8*)(QO + qrow * DM + h * 64 + 8 * g), qf1 = *(const bf16x8*)(QO + qrow * DM + h * 64 + 32 + 8 * g);
    const int qcol = q0 + q, wstart = min(max(qcol - 8, 0), 48);
    const float* rp = rpb + h * 465;
    const int koff = 8 * (q >> 2) + (q & 3);
    f32x4 S[16][2];
#pragma unroll
    for (int grp = G0; grp < 16; ++grp) {
        const size_t base = grp < 8 ? (size_t)b * SEQ + (rs + grp) * 64 + ks : (size_t)ML + b * CTXL + 32 * (grp - 8);
#pragma unroll
        for (int T = 0; T < 2; ++T) {
            const bf16_t* kp = Kb + (base + koff + 4 * T) * DM + h * 64 + 8 * g;
            const bf16x8 kf0 = *(const bf16x8*)kp, kf1 = *(const bf16x8*)(kp + 32);
            f32x4 s = {0.f, 0.f, 0.f, 0.f};
            s = mfma16(kf0, qf0, s); s = mfma16(kf1, qf1, s);
            if (grp < 8) {
                const int drow = rs + grp - r + 7;
#pragma unroll
                for (int j = 0; j < 4; ++j) { const int kcol = ks + 8 * g + 4 * T + j; const bool ok = (kcol >= wstart) && (kcol < wstart + 16);
                    const int dcol = min(max(kcol - qcol + 15, 0), 30);
                    const float bias = rp[drow * 31 + dcol];
                    s[j] = ok ? s[j] + bias : -1e30f; }
            }
            S[grp][T] = s;
        }
    }
    float mx = -1e30f;
#pragma unroll
    for (int grp = G0; grp < 16; ++grp)
#pragma unroll
        for (int T = 0; T < 2; ++T) mx = fmaxf(mx, fmaxf(fmaxf(S[grp][T][0], S[grp][T][1]), fmaxf(S[grp][T][2], S[grp][T][3])));
    mx = fmaxf(mx, __shfl_xor(mx, 16)); mx = fmaxf(mx, __shfl_xor(mx, 32));
    float sum = 0.f;
#pragma unroll
    for (int grp = G0; grp < 16; ++grp)
#pragma unroll
        for (int T = 0; T < 2; ++T) {
#pragma unroll
            for (int j = 0; j < 4; ++j) { const float p = __expf(S[grp][T][j] - mx); S[grp][T][j] = p; sum += p; } }
    sum += __shfl_xor(sum, 16); sum += __shfl_xor(sum, 32);
    f32x4 O[4];
#pragma unroll
    for (int dt = 0; dt < 4; ++dt) O[dt] = (f32x4){0.f, 0.f, 0.f, 0.f};
#pragma unroll
    for (int grp = G0; grp < 16; ++grp) {
        const size_t base = grp < 8 ? (size_t)b * SEQ + (rs + grp) * 64 + ks : (size_t)ML + b * CTXL + 32 * (grp - 8);
        u32x4 pw; pw.x = pk2(S[grp][0][0], S[grp][0][1]); pw.y = pk2(S[grp][0][2], S[grp][0][3]); pw.z = pk2(S[grp][1][0], S[grp][1][1]); pw.w = pk2(S[grp][1][2], S[grp][1][3]);
        const bf16x8 pf = __builtin_bit_cast(bf16x8, pw);
#pragma unroll
        for (int dt = 0; dt < 4; ++dt) {
            const bf16x8 vf = *(const bf16x8*)(VT + (size_t)(h * 64 + 16 * dt + q) * MT + base + 8 * g);
            O[dt] = mfma16(vf, pf, O[dt]);
        }
        if (grp & 1) __builtin_amdgcn_sched_barrier(0);
    }
    const float inv = __builtin_amdgcn_rcpf(sum);
#pragma unroll
    for (int dt = 0; dt < 4; ++dt) { u32x2 w; w.x = pk2(O[dt][0] * inv, O[dt][1] * inv); w.y = pk2(O[dt][2] * inv, O[dt][3] * inv);
        *(u32x2*)(OO + qrow * DM + h * 64 + 16 * dt + 4 * g) = w; }
}
constexpr int AT_PITCH = 144;
template <bool CTXQ>
__device__ __forceinline__ void attn_super(const bf16_t* QO, bf16_t* OO, const bf16_t* Kb, const bf16_t* VT, const float* rpb, LAS unsigned char* lds, int tid_, int lane_, int wave, int st) {
    constexpr int G0 = CTXQ ? 8 : 0, I0 = CTXQ ? 9 : 0;
    const int tid = opaque_tid(), lane = tid & 63;
    const int q = lane & 15, g = lane >> 4;
    int b, h, r = 0, q0 = 0, ks = 0, rs = 0, kbase = 0, krl0 = 0; size_t qrow;
    if (CTXQ) { const int hf = st & 1; h = (st >> 1) & 15; b = st >> 5; qrow = (size_t)ML + b * CTXL + hf * 128 + wave * 16 + q; }
    else { const int rp = st & 31; h = (st >> 5) & 15; b = st >> 9; r = 2 * rp + (wave >> 2); q0 = (wave & 3) * 16; ks = min(max(q0 - 8, 0), 32); rs = min(max(r - 4, 0), 56);
        kbase = min(min(max(2 * rp - 4, 0), 56), 55); krl0 = rs - kbase; qrow = (size_t)b * SEQ + r * 64 + q0 + q; }
    u32x4 stg[13];
#pragma unroll
    for (int i = I0; i < 13; ++i) { const int c = tid + 512 * i, t = c >> 3, cc = c & 7;
        const size_t urow = t < 576 ? (size_t)b * SEQ + kbase * 64 + t : (size_t)ML + b * CTXL + (t - 576);
        stg[i] = *(const u32x4*)(Kb + urow * DM + h * 64 + cc * 8); }
    const bf16x8 qf0 = *(const bf16x8*)(QO + qrow * DM + h * 64 + 8 * g), qf1 = *(const bf16x8*)(QO + qrow * DM + h * 64 + 32 + 8 * g);
    LAS float* rpl = (LAS float*)(lds + 832 * AT_PITCH);
    if (!CTXQ) { if (tid < 465) rpl[tid] = rpb[h * 465 + tid]; }
#pragma unroll
    for (int i = I0; i < 13; ++i) { const int c = tid + 512 * i, t = c >> 3, cc = c & 7; *(LAS u32x4*)(lds + t * AT_PITCH + cc * 16) = stg[i]; }
    __syncthreads();
    const int qcol = q0 + q, wstart = min(max(qcol - 8, 0), 48);
    const int koff = 8 * (q >> 2) + (q & 3);
    f32x4 S[16][2];
#pragma unroll
    for (int grp = G0; grp < 16; ++grp) {
        const int tb = grp < 8 ? (krl0 + grp) * 64 + ks : 576 + 32 * (grp - 8);
#pragma unroll
        for (int T = 0; T < 2; ++T) {
            const LAS unsigned char* kp = lds + (tb + koff + 4 * T) * AT_PITCH + g * 16;
            const bf16x8 kf0 = *(const LAS bf16x8*)kp, kf1 = *(const LAS bf16x8*)(kp + 64);
            f32x4 s = {0.f, 0.f, 0.f, 0.f};
            s = mfma16(kf0, qf0, s); s = mfma16(kf1, qf1, s);
            if (grp < 8) {
                const int drow = rs + grp - r + 7;
#pragma unroll
                for (int j = 0; j < 4; ++j) { const int kcol = ks + 8 * g + 4 * T + j; const bool ok = (kcol >= wstart) && (kcol < wstart + 16);
                    const int dcol = min(max(kcol - qcol + 15, 0), 30);
                    const float bias = rpl[drow * 31 + dcol];
                    s[j] = ok ? s[j] + bias : -1e30f; }
            }
            S[grp][T] = s;
        }
        __builtin_amdgcn_sched_barrier(0);
    }
    __syncthreads();
    float mx = -1e30f;
#pragma unroll
    for (int grp = G0; grp < 16; ++grp)
#pragma unroll
        for (int T = 0; T < 2; ++T) mx = fmaxf(mx, fmaxf(fmaxf(S[grp][T][0], S[grp][T][1]), fmaxf(S[grp][T][2], S[grp][T][3])));
    mx = fmaxf(mx, __shfl_xor(mx, 16)); mx = fmaxf(mx, __shfl_xor(mx, 32));
    float sum = 0.f;
    u32x4 P[16];
#pragma unroll
    for (int grp = G0; grp < 16; ++grp) {
        float p[8];
#pragma unroll
        for (int T = 0; T < 2; ++T)
#pragma unroll
            for (int j = 0; j < 4; ++j) { p[4 * T + j] = __builtin_amdgcn_exp2f((S[grp][T][j] - mx) * 1.4426950408889634f); sum += p[4 * T + j]; }
        P[grp].x = pk2(p[0], p[1]); P[grp].y = pk2(p[2], p[3]); P[grp].z = pk2(p[4], p[5]); P[grp].w = pk2(p[6], p[7]);
        __builtin_amdgcn_sched_barrier(0);
    }
    sum += __shfl_xor(sum, 16); sum += __shfl_xor(sum, 32);
#pragma unroll
    for (int i = I0; i < 13; ++i) { const int d = (tid >> 3) & 63, cc = tid & 7;
        const size_t tokb = i < 9 ? (size_t)b * SEQ + (kbase + i) * 64 : (size_t)ML + b * CTXL + (i - 9) * 64;
        stg[i] = *(const u32x4*)(VT + (size_t)(h * 64 + d) * MT + tokb + cc * 8); }
#pragma unroll
    for (int i = I0; i < 13; ++i) { const int d = (tid >> 3) & 63, cc = tid & 7; *(LAS u32x4*)(lds + (i * 64 + d) * AT_PITCH + cc * 16) = stg[i]; }
    __syncthreads();
    f32x4 O[4];
#pragma unroll
    for (int dt = 0; dt < 4; ++dt) O[dt] = (f32x4){0.f, 0.f, 0.f, 0.f};
#pragma unroll
    for (int grp = G0; grp < 16; ++grp) {
        const int blk = grp < 8 ? krl0 + grp : 9 + ((grp - 8) >> 1), col = grp < 8 ? ks : 32 * ((grp - 8) & 1);
        const bf16x8 pf = __builtin_bit_cast(bf16x8, P[grp]);
#pragma unroll
        for (int dt = 0; dt < 4; ++dt) {
            const bf16x8 vf = *(const LAS bf16x8*)(lds + (blk * 64 + 16 * dt + q) * AT_PITCH + (col + 8 * g) * 2);
            O[dt] = mfma16(vf, pf, O[dt]);
        }
        if (grp & 1) __builtin_amdgcn_sched_barrier(0);
    }
    const float inv = __builtin_amdgcn_rcpf(sum);
#pragma unroll
    for (int dt = 0; dt < 4; ++dt) { u32x2 w; w.x = pk2(O[dt][0] * inv, O[dt][1] * inv); w.y = pk2(O[dt][2] * inv, O[dt][3] * inv);
        *(u32x2*)(OO + qrow * DM + h * 64 + 16 * dt + 4 * g) = w; }
    __syncthreads();
}
__device__ __forceinline__ void attn_phase(const bf16_t* QO, bf16_t* OO, const bf16_t* Kb, const bf16_t* VT, const float* rpb, LAS unsigned char* lds, int tid, int lane, int wave, int G) {
    const int bid = opaque_bid();
    if (G == 256) {
        const int x = bid & 7, c = bid >> 3;
        for (int it = 0; it < 16; ++it) attn_super<false>(QO, OO, Kb, VT, rpb, lds, tid, lane, wave, ((it * 8 + x) << 5) | c);
        attn_super<true>(QO, OO, Kb, VT, rpb, lds, tid, lane, wave, ((((c >> 1) * 8) + x) << 1) | (c & 1));
    } else {
        for (int st = bid; st < 4096; st += G) attn_super<false>(QO, OO, Kb, VT, rpb, lds, tid, lane, wave, st);
        for (int st = bid; st < 256; st += G) attn_super<true>(QO, OO, Kb, VT, rpb, lds, tid, lane, wave, st);
    }
}

__device__ __forceinline__ void lconv_phase(const bf16_t* REC, bf16_t* XR, const float* cw, const float* cbias, int tid, int G) {
#pragma unroll 1
    for (int it = opaque_bid() * 512 + tid; it < MT * 128; it += G * 512) { asm volatile("" : "+v"(it));
        const int row = it >> 7, ch = (it & 127) * 8;
        int pos, len; if (row < ML) { pos = row & (SEQ - 1); len = SEQ; } else { pos = (row - ML) & (CTXL - 1); len = CTXL; }
        float acc[8];
        { const f32x4 b0 = *(const f32x4*)(cbias + ch), b1 = *(const f32x4*)(cbias + ch + 4);
#pragma unroll
          for (int e = 0; e < 4; ++e) { acc[e] = b0[e]; acc[4 + e] = b1[e]; } }
#pragma unroll
        for (int k = 0; k < 4; ++k) { const int t = pos + k - 2;
            if (t >= 0 && t < len) {
                const u32x4 v = *(const u32x4*)(REC + (size_t)(row + k - 2) * DM + ch);
                const f32x4 w0 = *(const f32x4*)(cw + k * DM + ch), w1 = *(const f32x4*)(cw + k * DM + ch + 4);
                acc[0] += w0[0] * bflo(v.x); acc[1] += w0[1] * bfhi(v.x); acc[2] += w0[2] * bflo(v.y); acc[3] += w0[3] * bfhi(v.y);
                acc[4] += w1[0] * bflo(v.z); acc[5] += w1[1] * bfhi(v.z); acc[6] += w1[2] * bflo(v.w); acc[7] += w1[3] * bfhi(v.w);
            } }
        u32x4 o; o.x = pk2(acc[0], acc[1]); o.y = pk2(acc[2], acc[3]); o.z = pk2(acc[4], acc[5]); o.w = pk2(acc[6], acc[7]);
        *(u32x4*)(XR + (size_t)row * DM + ch) = o;
    }
}

template <int DIR, bool APPLY>
__device__ __forceinline__ void lru_sweep(const bf16_t* XR, const bf16_t* GATE, bf16_t* YP, const bf16_t* bdw_dir, float bias_r, float bias_i, float sp,
                                          int row0, int n, int half, int lane, float& hcar, float& ptot, unsigned (&hsf)[4][8]) {
    const int e = lane & 31, hh = lane >> 5;
    const int tau = 16 * ((e >> 2) & 1) + (e & 3) + 4 * (e >> 3);
    bf16x8 Br[4], Bi[4];
    const bf16_t* wrp = bdw_dir + (size_t)n * 4096 + (half * 32 + e) * 64 + 8 * hh;
    const bf16_t* wip = wrp + 16 * 4096;
#pragma unroll
    for (int kk = 0; kk < 4; ++kk) { Br[kk] = *(const bf16x8*)(wrp + 16 * kk); Bi[kk] = *(const bf16x8*)(wip + 16 * kk); }
    bf16x8 I0, I1;
#pragma unroll
    for (int jj = 0; jj < 8; ++jj) { I0[jj] = (8 * hh + jj == e) ? (short)0x3F80 : (short)0; I1[jj] = (16 + 8 * hh + jj == e) ? (short)0x3F80 : (short)0; }
    const bool first = (hh == DIR);
    const int chcol = n * 64 + half * 32;
    const float spm = -8.0f * 1.4426950408889634f * sp;
#pragma unroll
    for (int tt = 0; tt < 4; ++tt) {
        const int tile = DIR == 0 ? tt : 3 - tt; const int trow = row0 + tile * 32;
        const bf16_t* ap = XR + (size_t)(trow + tau) * DM + n * 64 + 8 * hh;
        bf16x8 A[4];
#pragma unroll
        for (int kk = 0; kk < 4; ++kk) A[kk] = *(const bf16x8*)(ap + 16 * kk);
        f32x16 ar, ai, xv;
#pragma unroll
        for (int r = 0; r < 16; ++r) { ar[r] = 0.f; ai[r] = 0.f; xv[r] = 0.f; }
#pragma unroll
        for (int kk = 0; kk < 4; ++kk) { ar = mfma32(A[kk], Br[kk], ar); ai = mfma32(A[kk], Bi[kk], ai); }
        const bf16x8 Ax0 = half ? A[2] : A[0], Ax1 = half ? A[3] : A[1];
        xv = mfma32(Ax0, I0, xv); xv = mfma32(Ax1, I1, xv);
        f32x16 av, bv;
#pragma unroll
        for (int r = 0; r < 16; ++r) {
            const float rg = sigmoidf_(ar[r] + bias_r), ig = sigmoidf_(ai[r] + bias_i);
            const float aa = __builtin_amdgcn_exp2f(rg * spm);
            av[r] = aa; bv[r] = __builtin_amdgcn_sqrtf(fmaxf(1.0f - aa * aa, 0.f)) * ig * xv[r];
        }
        float Hl = 0.f, Pl = 1.f;
#pragma unroll
        for (int rr = 0; rr < 16; ++rr) { const int r = DIR == 0 ? rr : 15 - rr; Hl = av[r] * Hl + bv[r]; Pl *= av[r]; }
        const float val = Hl + Pl * hcar, got = __shfl_xor(val, 32);
        const float start = first ? hcar : got;
        float endv;
        f32x16 hs;
        if (APPLY) {
            float hcur = start;
#pragma unroll
            for (int rr = 0; rr < 16; ++rr) { const int r = DIR == 0 ? rr : 15 - rr; hcur = av[r] * hcur + bv[r]; hs[r] = hcur; }
            endv = hcur;
        } else { endv = Hl + Pl * start; }
        const float got2 = __shfl_xor(endv, 32);
        hcar = first ? got2 : endv;
        if (!APPLY) ptot *= Pl * __shfl_xor(Pl, 32);
        if (APPLY) {
            if (DIR == 0) {
#pragma unroll
                for (int r2 = 0; r2 < 8; ++r2) hsf[tile][r2] = pk2(hs[2 * r2], hs[2 * r2 + 1]);
            }
            else {
                const bf16_t* gp = GATE + (size_t)(trow + tau) * DM + chcol + 8 * hh;
                const bf16x8 G0 = *(const bf16x8*)gp, G1 = *(const bf16x8*)(gp + 16);
                f32x16 gv;
#pragma unroll
                for (int r = 0; r < 16; ++r) gv[r] = 0.f;
                gv = mfma32(G0, I0, gv); gv = mfma32(G1, I1, gv);
                bf16_t* yp = YP + (size_t)(trow + 16 * hh) * DM + chcol + e;
#pragma unroll
                for (int r = 0; r < 16; ++r) { const float x = gv[r], u2 = 1.5957691216f * (x + 0.044715f * x * x * x);
                    const float hf = (r & 1) ? bfhi(hsf[tile][r >> 1]) : bflo(hsf[tile][r >> 1]);
                    const float y = (hf + hs[r]) * x * sigmoidf_(u2);
                    yp[(size_t)r * DM] = (bf16_t)f2bf(y); }
            }
        }
    }
}
template <bool APPLY>
__device__ __forceinline__ void lru_phase(const bf16_t* XR, const bf16_t* GATE, bf16_t* YP, const bf16_t* bdw_j, const float* ga_b, const float* gx_b, const float* lam, float* SUM,
                                          int lane, int gw, int NGW) {
    for (int task = gw; task < NB * NCHUNK * 32; task += NGW) {
        const int n2 = task & 31, c = (task >> 5) % NCHUNK, b = task / (32 * NCHUNK);
        const int row0 = c < 2 ? ML + b * CTXL + c * 128 : b * SEQ + (c - 2) * 128;
        const int n = n2 >> 1, half = n2 & 1, ch = n2 * 32 + (lane & 31);
        unsigned hsf[4][8];
#pragma unroll
        for (int dir = 0; dir < 2; ++dir) {
            const float bias_r = ga_b[dir * DM + ch], bias_i = gx_b[dir * DM + ch];
            const float sp = log1pf(__expf(-lam[dir * DM + ch]));
            const int p = dir == 0 ? c : (c < 2 ? 1 - c : 35 - c);
            float* sump = SUM + ((size_t)(dir * NB + b) * NCHUNK) * DM * 2 + (size_t)ch * 2;
            float hcar = 0.f, ptot = 1.f;
            if (APPLY) { for (int pp = 0; pp < p; ++pp) { const float2 ph = *(const float2*)(sump + (size_t)pp * DM * 2); hcar = ph.x * hcar + ph.y; } }
            if (dir == 0) lru_sweep<0, APPLY>(XR, GATE, YP, bdw_j, bias_r, bias_i, sp, row0, n, half, lane, hcar, ptot, hsf);
            else lru_sweep<1, APPLY>(XR, GATE, YP, bdw_j + 2 * 16 * 4096, bias_r, bias_i, sp, row0, n, half, lane, hcar, ptot, hsf);
            if (!APPLY) { if (lane < 32) *(float2*)(sump + (size_t)p * DM * 2) = make_float2(ptot, hcar); }
        }
    }
}

__device__ __forceinline__ void fconv_phase(const bf16_t* U, bf16_t* Gb, const float* cw, const float* cbias, int rbeg, int nrows, int tid, int G) {
    const int total = nrows * 384;
#pragma unroll 1
    for (int it = opaque_bid() * 512 + tid; it < total; it += G * 512) { asm volatile("" : "+v"(it));
        const int r = it / 384, ch = (it % 384) * 8, row = rbeg + r;
        int pos, len; if (row < ML) { pos = row & (SEQ - 1); len = SEQ; } else { pos = (row - ML) & (CTXL - 1); len = CTXL; }
        float va[8], ga[8];
        { const f32x4 b0 = *(const f32x4*)(cbias + ch), b1 = *(const f32x4*)(cbias + ch + 4), c0 = *(const f32x4*)(cbias + DFF + ch), c1 = *(const f32x4*)(cbias + DFF + ch + 4);
#pragma unroll
          for (int e = 0; e < 4; ++e) { va[e] = b0[e]; va[4 + e] = b1[e]; ga[e] = c0[e]; ga[4 + e] = c1[e]; } }
#pragma unroll
        for (int k = 0; k < 3; ++k) { const int t = pos + k - 1;
            if (t >= 0 && t < len) {
                const bf16_t* up = U + (size_t)(r + k - 1) * 6144 + ch;
                const u32x4 v = *(const u32x4*)up, gq = *(const u32x4*)(up + DFF);
                const float* wp = cw + (size_t)k * 6144 + ch;
                const f32x4 w0 = *(const f32x4*)wp, w1 = *(const f32x4*)(wp + 4), x0 = *(const f32x4*)(wp + DFF), x1 = *(const f32x4*)(wp + DFF + 4);
                va[0] += w0[0] * bflo(v.x); va[1] += w0[1] * bfhi(v.x); va[2] += w0[2] * bflo(v.y); va[3] += w0[3] * bfhi(v.y);
                va[4] += w1[0] * bflo(v.z); va[5] += w1[1] * bfhi(v.z); va[6] += w1[2] * bflo(v.w); va[7] += w1[3] * bfhi(v.w);
                ga[0] += x0[0] * bflo(gq.x); ga[1] += x0[1] * bfhi(gq.x); ga[2] += x0[2] * bflo(gq.y); ga[3] += x0[3] * bfhi(gq.y);
                ga[4] += x1[0] * bflo(gq.z); ga[5] += x1[1] * bfhi(gq.z); ga[6] += x1[2] * bflo(gq.w); ga[7] += x1[3] * bfhi(gq.w);
            } }
        float o[8];
#pragma unroll
        for (int e = 0; e < 8; ++e) o[e] = va[e] * ga[e] * sigmoidf_(ga[e]);
        u32x4 w; w.x = pk2(o[0], o[1]); w.y = pk2(o[2], o[3]); w.z = pk2(o[4], o[5]); w.w = pk2(o[6], o[7]);
        *(u32x4*)(Gb + (size_t)r * DFF + ch) = w;
    }
}

template <int OP>
__device__ __forceinline__ void run_op(const Args& a, LAS unsigned char* lds, const int li, const int arg, const int rep) {
    const int tid = opaque_tid(), lane = tid & 63, wave = __builtin_amdgcn_readfirstlane(tid >> 6), G = gridDim.x;
    const int gw = opaque_bid() * 8 + wave, NGW = G * 8;
    unsigned char* ws = a.ws;
    float* MODS = (float*)(ws + WS_MODS);
    float* SUM = (float*)(ws + WS_SUM);
    bf16_t* BDW = (bf16_t*)(ws + WS_BDW);
    float* CTXR = (float*)(ws + WS_CTXR);
    bf16_t* WB = (bf16_t*)(ws + WS_WB);
    bf16_t* HN = (bf16_t*)(ws + WS_HN);
    bf16_t* RR = (bf16_t*)(ws + WS_R);
    const int j = li >> 1;
    const float* mods_l = MODS + (size_t)li * 9 * 6144;
    if constexpr (OP == OP_PRO) {
        prologue(a, lds, tid, lane, wave, G);
    } else if constexpr (OP == OP_NORM) {
        const bool first = (li == 0 && arg == 0);
        const float* gain = (arg ? a.in[7] : a.in[6]) + (size_t)li * DM;
        const int nrows = (arg == 1 && li == 3) ? ML : MT;
        const int npart = first ? 0 : (arg == 1 ? (li == 3 ? 0 : 4) : 6);
        const float* pgate = arg == 1 ? mods_l + 8 * 6144 + 2 * DM : MODS + (size_t)(li - 1) * 9 * 6144 + 8 * 6144 + 5 * DM;
        norm_phase(first ? a.in[0] : a.out, CTXR, HN, gain, mods_l, arg * 3, nrows, lane, gw, NGW, CTXR, (const float*)(ws + WS_PART), npart, pgate);
    } else if constexpr (OP == OP_GQK) {
        pg8::Gemm g{HN, WB + (size_t)j * 4 * MEL, MT, 2048, DM, 0, 0};
        pg8::StaticOrder S; S.init(g.M, g.N, G, opaque_bid());
        EpiQK E{RR + R_Q, RR + R_K, a.in[9] + j * HD, a.in[10] + j * HD};
        pg8::gemm_phase<EpiQK, pg8::StaticOrder>(lds, g, S, E);
    } else if constexpr (OP == OP_GST) {
        pg8::Gemm g; EpiStore E; int c = opaque_bid();
        if (arg == 0) { g = pg8::Gemm{WB + (size_t)j * 4 * MEL + 2 * MEL, HN, DM, MT, DM, 0, 0}; E = EpiStore{RR + R_VT, MT, 0, 0}; c = (c + G - (64 % G)) % G; }
        else if (arg == 1) { g = pg8::Gemm{HN, WB + 8 * MEL + (size_t)j * 3 * MEL, MT, 2048, DM, 0, 0}; E = EpiStore{RR + R_GATE, DM, DM, (size_t)MT * DM}; }
        else { const int rbeg = arg == 2 ? 0 : 16384, nrows = arg == 2 ? 16384 : (li == 3 ? 16384 : 18432);
            g = pg8::Gemm{HN + (size_t)rbeg * DM, WB + 14 * MEL + (size_t)li * 9 * MEL, nrows, 6144, DM, 0, 0}; E = EpiStore{RR + R_U, 6144, 0, 0}; }
        pg8::StaticOrder S; S.init(g.M, g.N, G, c);
        pg8::gemm_phase<EpiStore, pg8::StaticOrder>(lds, g, S, E);
    } else if constexpr (OP == OP_GRES) {
        pg8::Gemm g; EpiRes E;
        const bool l0 = (li == 0 && arg == 0);
        E.in_lat = l0 ? a.in[0] : a.out; E.in_ctx = CTXR; E.out_lat = a.out; E.out_ctx = CTXR; E.row_off = 0;
        const bf16_t* Ap; const bf16_t* Bp; int Kd, gidx;
        if (arg == 0) { gidx = 2; Kd = DM;
            if (li & 1) { Ap = RR + R_YP; Bp = WB + 8 * MEL + (size_t)j * 3 * MEL + 2 * MEL; } else { Ap = RR + R_Q; Bp = WB + (size_t)j * 4 * MEL + 3 * MEL; }
        } else { gidx = 5; Kd = DFF; Ap = RR + R_G; Bp = WB + 14 * MEL + (size_t)li * 9 * MEL + 6 * MEL; }
        E.gate = mods_l + gidx * DM;
        g = pg8::Gemm{Ap, Bp, ML, DM, Kd, 0, 0};
        pg8::StaticOrder S; S.init(g.M, g.N, G, opaque_bid());
        pg8::gemm_phase<EpiRes, pg8::StaticOrder>(lds, g, S, E);
        if (li != 3) {
            const int nkc = Kd == DFF ? 6 : 4;
            pg8::Gemm g2{Ap, Bp, MT, DM, Kd / nkc, 0, Kd};
            CtxSplitOrder S2{nkc, G, opaque_bid(), ML / 256};
            EpiPart E2{(float*)(ws + WS_PART)};
            pg8::gemm_phase<EpiPart, CtxSplitOrder>(lds, g2, S2, E2);
        }
    } else if constexpr (OP == OP_GUP) {
        pg8::Gemm g{HN - DM, WB + 14 * MEL + (size_t)li * 9 * MEL, 138 * 256, 6144, DM, 254, 0};
        pg8::StaticOrder S; S.init(g.M, g.N, G, opaque_bid());
        EpiUpConv E{RR + R_G, a.in[23] + (size_t)li * 3 * 6144, a.in[24] + (size_t)li * 6144, (LAS float*)(lds + 132096)};
        pg8::gemm_phase<EpiUpConv, pg8::StaticOrder>(lds, g, S, E);
    } else if constexpr (OP == OP_ATTN) {
        attn_phase(RR + R_Q, rep ? RR + R_YP : RR + R_Q, RR + R_K, RR + R_VT, a.in[11] + (size_t)j * NH * 465, lds, tid, lane, wave, G);
    } else if constexpr (OP == OP_LCONV) {
        lconv_phase(RR + R_REC, RR + R_XR, a.in[14] + (size_t)j * 4 * DM, a.in[15] + (size_t)j * DM, tid, G);
    } else if constexpr (OP == OP_LRUA) {
        lru_phase<false>(RR + R_XR, RR + R_GATE, RR + R_YP, BDW + (size_t)j * 4 * 16 * 4096, a.in[17] + (size_t)j * 2 * DM, a.in[19] + (size_t)j * 2 * DM, a.in[20] + (size_t)j * 2 * DM, SUM, lane, gw, NGW);
    } else if constexpr (OP == OP_LRUC) {
        lru_phase<true>(RR + R_XR, RR + R_GATE, RR + R_YP, BDW + (size_t)j * 4 * 16 * 4096, a.in[17] + (size_t)j * 2 * DM, a.in[19] + (size_t)j * 2 * DM, a.in[20] + (size_t)j * 2 * DM, SUM, lane, gw, NGW);
    } else if constexpr (OP == OP_FCONV) {
        const int rbeg = arg == 2 ? 0 : 16384, nrows = arg == 2 ? 16384 : (li == 3 ? 16384 : 18432);
        fconv_phase(RR + R_U, RR + R_G, a.in[23] + (size_t)li * 3 * 6144, a.in[24] + (size_t)li * 6144, rbeg, nrows, tid, G);
    }
}

#ifdef MULTI_LAUNCH
template <int OP> __global__ void __launch_bounds__(512, 2) op_kernel(Args a, int li, int arg) {
    extern __shared__ __attribute__((aligned(16))) unsigned char lds_raw[];
    run_op<OP>(a, (LAS unsigned char*)lds_raw, li, arg, 0);
}
template <int OP> static void launch_op(const Args& a, int li, int arg, int grid, hipStream_t stream) {
    static bool attr = false;
    if (!attr) { (void)hipFuncSetAttribute((const void*)op_kernel<OP>, hipFuncAttributeMaxDynamicSharedMemorySize, LDS_BYTES); attr = true; }
    hipLaunchKernelGGL(op_kernel<OP>, dim3(grid), dim3(512), LDS_BYTES, stream, a, li, arg);
}
#else
__global__ void __launch_bounds__(512, 2) fwd_kernel(Args a) {
    extern __shared__ __attribute__((aligned(16))) unsigned char lds_raw[];
    LAS unsigned char* lds = (LAS unsigned char*)lds_raw;
    cg::grid_group grid = cg::this_grid();
    volatile LAS unsigned* bst = (volatile LAS unsigned*)(lds + 131072 + 64);
    if (threadIdx.x < 4) bst[threadIdx.x] = 0u;
    __syncthreads();
    const XcdBarrier bar = xcd_barrier_post((unsigned*)(a.ws + WS_BAR), bst);
    typedef const __attribute__((address_space(4))) Args* KArgP;
    const int pc_lo = a.pc_lo, pc_hi = a.pc_hi;
    for (int pc = pc_lo; pc < pc_hi; ++pc) {
        const int op = PROG[pc][0], li = PROG[pc][1], arg = PROG[pc][2], sync = PROG[pc][3];
        KArgP kap = (KArgP)__builtin_amdgcn_kernarg_segment_ptr();
        asm volatile("" : "+s"(kap));
        const Args& a = *(const Args*)kap;
        const int rep = (op == OP_ATTN) ? arg : 0;
        switch (op) {
            case OP_PRO: run_op<OP_PRO>(a, lds, li, arg, rep); break;
            case OP_NORM: run_op<OP_NORM>(a, lds, li, arg, rep); break;
            case OP_GQK: run_op<OP_GQK>(a, lds, li, arg, rep); break;
            case OP_GST: run_op<OP_GST>(a, lds, li, arg, rep); break;
            case OP_GRES: run_op<OP_GRES>(a, lds, li, arg, rep); break;
            case OP_ATTN: run_op<OP_ATTN>(a, lds, li, arg, rep); break;
            case OP_LCONV: run_op<OP_LCONV>(a, lds, li, arg, rep); break;
            case OP_LRUA: run_op<OP_LRUA>(a, lds, li, arg, rep); break;
            case OP_LRUC: run_op<OP_LRUC>(a, lds, li, arg, rep); break;
            default: run_op<OP_GUP>(a, lds, li, arg, rep); break;
        }
        if (sync && pc + 1 < pc_hi) { if (pc == 0) grid.sync(); else xcd_barrier(bar); }
    }
}
#endif

extern "C" void kernel_launch(void* const* d_in, const int* in_sizes, int n_in, void* d_out, int out_size, void* d_ws, size_t ws_size, hipStream_t stream) {
    static int grid = 0;
    if (grid == 0) {
        if (n_in != 26 || out_size != ML * DM || ws_size < WS_END) { fprintf(stderr, "kernel_launch: unexpected shapes: n_in %d out %d ws %zu (need %zu)\n", n_in, out_size, ws_size, (size_t)WS_END); grid = -1; return; }
        int dev = 0, cus = 0, per_cu = 1;
        (void)hipGetDevice(&dev);
        (void)hipDeviceGetAttribute(&cus, hipDeviceAttributeMultiprocessorCount, dev);
#ifndef MULTI_LAUNCH
        if (hipFuncSetAttribute((const void*)fwd_kernel, hipFuncAttributeMaxDynamicSharedMemorySize, LDS_BYTES) != hipSuccess) { fprintf(stderr, "kernel_launch: hipFuncSetAttribute failed\n"); grid = -1; return; }
        if (hipOccupancyMaxActiveBlocksPerMultiprocessor(&per_cu, (const void*)fwd_kernel, 512, LDS_BYTES) != hipSuccess || per_cu < 1) { fprintf(stderr, "kernel_launch: occupancy query gave %d\n", per_cu); per_cu = 1; }
        (void)hipGetLastError();
#endif
        grid = cus * per_cu;
        fprintf(stderr, "kernel_launch: grid %d (cus %d x %d), ws %zu\n", grid, cus, per_cu, ws_size);
    }
    if (grid < 0) return;
    Args a{};
    for (int i = 0; i < 26; ++i) a.in[i] = (const float*)d_in[i];
    a.out = (float*)d_out; a.ws = (unsigned char*)d_ws;
    a.pc_lo = 0; a.pc_hi = NPROG;
#ifdef MULTI_LAUNCH
    for (int pc = 0; pc < NPROG; ++pc) {
        const int op = HOSTPROG[pc][0], li = HOSTPROG[pc][1], arg = HOSTPROG[pc][2];
        switch (op) {
            case OP_PRO: launch_op<OP_PRO>(a, li, arg, grid, stream); break;
            case OP_NORM: launch_op<OP_NORM>(a, li, arg, grid, stream); break;
            case OP_GQK: launch_op<OP_GQK>(a, li, arg, grid, stream); break;
            case OP_GST: launch_op<OP_GST>(a, li, arg, grid, stream); break;
            case OP_GRES: launch_op<OP_GRES>(a, li, arg, grid, stream); break;
            case OP_ATTN: launch_op<OP_ATTN>(a, li, arg, grid, stream); break;
            case OP_LCONV: launch_op<OP_LCONV>(a, li, arg, grid, stream); break;
            case OP_LRUA: launch_op<OP_LRUA>(a, li, arg, grid, stream); break;
            case OP_LRUC: launch_op<OP_LRUC>(a, li, arg, grid, stream); break;
            default: launch_op<OP_GUP>(a, li, arg, grid, stream); break;
        }
    }
#else
    (void)hipMemsetAsync((char*)d_ws + WS_BAR, 0, 16384, stream);
    void* args[] = {&a};
    hipError_t e = hipLaunchCooperativeKernel((const void*)fwd_kernel, dim3(grid), dim3(512), args, LDS_BYTES, stream);
    if (e != hipSuccess) fprintf(stderr, "kernel_launch: cooperative launch failed: %s (grid %d)\n", hipGetErrorString(e), grid);
#endif
}
```

```cpp
#include <hip/hip_runtime.h>
#include <hip/hip_cooperative_groups.h>
#include <cstdio>
#include <cstdint>
namespace cg = cooperative_groups;
__device__ __forceinline__ int opaque_tid() { int t; asm volatile("v_mov_b32 %0, %1" : "=v"(t) : "v"((int)threadIdx.x)); return t; }
__device__ __forceinline__ int opaque_bid() { int t; asm volatile("s_mov_b32 %0, %1" : "=s"(t) : "s"((int)blockIdx.x)); return t; }
#define LAS __attribute__((address_space(3)))
namespace pg8 {
#define PG8_LAS __attribute__((address_space(3)))
typedef unsigned short bf16_t;
typedef short bf16x8 __attribute__((ext_vector_type(8)));
typedef float f32x4 __attribute__((ext_vector_type(4)));
typedef unsigned u32x4 __attribute__((ext_vector_type(4)));
constexpr int BM = 256, BK = 64, HALF = 128, HTB = HALF * BK * 2  , STAGE_BYTES = 8 * HTB, NXCD = 8, WGM = 8;

__host__ __device__ __forceinline__ int lds_byte(int r, int c) { const int st = (r >> 4) * 2 + (c >> 5), rr = r & 15, cc = c & 31, ob = rr * 64 + cc * 2; return st * 1024 + (ob ^ (((ob >> 9) & 1) << 5)); }
__host__ __device__ __forceinline__ void stage_rc(int b, int& R, int& C) { const int st = b / 1024, sb = b % 1024, swz = sb ^ (((sb >> 9) & 1) << 5); R = (st >> 1) * 16 + swz / 64; C = (st & 1) * 32 + (swz % 64) / 2; }
__host__ __device__ __forceinline__ int perm32(int rho) { const int n = rho >> 4, i = rho & 15; return 8 * (i >> 2) + 4 * n + (i & 3); }

struct Unit { int pm, pn, kc; };
struct Gemm { const bf16_t* A; const bf16_t* Bt; int M, N, K; int a_step_rows; int ldk; };

struct StaticOrder {
    int nM, nN, nwg, G, c;
    __host__ __device__ void init(int M, int N, int G_, int c_) { nM = M / BM; nN = N / BM; nwg = nM * nN; G = G_; c = c_; }
    __host__ __device__ bool next(int i, Unit& u) const {
        const long L = (long)i * G + c; if (L >= nwg) return false;
        int wgid = (int)L; { const int q = nwg / NXCD, r = nwg % NXCD, xcd = wgid % NXCD, off = wgid / NXCD; wgid = (xcd < r ? xcd * (q + 1) : r * (q + 1) + (xcd - r) * q) + off; }
        const int nig = WGM * nN, gid = wgid / nig, fm = gid * WGM, gsz = (nM - fm) < WGM ? (nM - fm) : WGM;
        u.pm = fm + ((wgid % nig) % gsz); u.pn = (wgid % nig) / gsz; u.kc = 0; return true;
    }
    __device__ __forceinline__ void a_ready(const Unit&) const {}
    __device__ __forceinline__ void done(const Unit&) const {}
};
__device__ __forceinline__ unsigned cvt_pk_bf16(float lo, float hi) { unsigned r; asm volatile("v_cvt_pk_bf16_f32 %0, %1, %2" : "=v"(r) : "v"(lo), "v"(hi)); return r; }
template <class Epi, class Sched>
__device__ __forceinline__ void gemm_phase(PG8_LAS unsigned char* lds, const Gemm g, const Sched& S, const Epi& E) {
    const int tid = opaque_tid(), wid = __builtin_amdgcn_readfirstlane(tid >> 6), lane = tid & 63, wr = wid >> 2, wc = wid & 3, fr = lane & 15, fq = lane >> 4;
    const int K = g.K, nt = K / BK, P = g.ldk ? g.ldk : K;
    unsigned voffA[2], voffB[2];
#pragma unroll
    for (int i = 0; i < 2; ++i) { int R, C; stage_rc(tid * 16 + i * 8192, R, C); const int Rb = Epi::PERM ? ((R & ~31) + perm32(R & 31)) : R;
        voffA[i] = (unsigned)(R * P + C) * 2u; voffB[i] = (unsigned)(Rb * P + C) * 2u; }
    const size_t kstep = (size_t)(BK * 2);
    const size_t hstep = (size_t)HALF * P * 2;
    const size_t tstep = 2 * hstep; const size_t tstepA = g.a_step_rows ? (size_t)g.a_step_rows * P * 2 : tstep; const size_t cstep = (size_t)K * 2;
    const unsigned ldsw = (unsigned)wid * 1024u;
    const int aoff = lds_byte(wr * 64 + fr, fq * 8), boff = lds_byte(wc * 32 + fr, fq * 8);
#define PG8_SA(b, h) (((b) * 2 + (h)) * HTB)
#define PG8_SB(b, h) ((4 + (b) * 2 + (h)) * HTB)
#define PG8_STAGE(bufoff, gbase, voff) do { _Pragma("unroll") for (int _i = 0; _i < 2; ++_i) \
        __builtin_amdgcn_global_load_lds((const unsigned*)((const char*)(gbase) + (voff)[_i]), (PG8_LAS unsigned*)(lds + (bufoff) + ldsw + _i * 8192), 16, 0, 0); } while (0)
#define PG8_LDA(dst, b, h) do { _Pragma("unroll") for (int m = 0; m < 4; ++m) _Pragma("unroll") for (int k = 0; k < 2; ++k) dst[m][k] = *(const PG8_LAS bf16x8*)(lds + PG8_SA(b, h) + aoff + m * 2048 + k * 1024); } while (0)
#define PG8_LDB(dst, b, h) do { _Pragma("unroll") for (int n = 0; n < 2; ++n) _Pragma("unroll") for (int k = 0; k < 2; ++k) dst[n][k] = *(const PG8_LAS bf16x8*)(lds + PG8_SB(b, h) + boff + n * 2048 + k * 1024); } while (0)
#define PG8_MMA(ai, bj, At, Bt) do { __builtin_amdgcn_s_setprio(1); _Pragma("unroll") for (int m = 0; m < 4; ++m) _Pragma("unroll") for (int n = 0; n < 2; ++n) _Pragma("unroll") for (int k = 0; k < 2; ++k) \
        acc[ai][bj][m][n] = __builtin_amdgcn_mfma_f32_16x16x32_bf16(Bt[n][k], At[m][k], acc[ai][bj][m][n], 0, 0, 0); __builtin_amdgcn_s_setprio(0); } while (0)
#define PG8_WAIT_V(n) asm volatile("s_waitcnt vmcnt(" #n ")" ::: "memory")
#define PG8_WAIT_L(n) asm volatile("s_waitcnt lgkmcnt(" #n ")" ::: "memory")
#define PG8_BAR __builtin_amdgcn_s_barrier()
#define PG8_SCHED __builtin_amdgcn_sched_barrier(0)
    Unit cur, nxt; int ui = 0;
    if (!S.next(0, cur)) return;
    f32x4 acc[2][2][4][2];
#pragma unroll
    for (int a = 0; a < 2; ++a)
#pragma unroll
        for (int b = 0; b < 2; ++b)
#pragma unroll
            for (int m = 0; m < 4; ++m)
#pragma unroll
                for (int n = 0; n < 2; ++n) acc[a][b][m][n] = (f32x4){0.f, 0.f, 0.f, 0.f};
    bf16x8 At[4][2], B0[2][2], B1[2][2];
    const char* cA = (const char*)g.A + (size_t)cur.pm * tstepA + (size_t)cur.kc * cstep; const char* cB = (const char*)g.Bt + (size_t)cur.pn * tstep + (size_t)cur.kc * cstep;
    S.a_ready(cur);
    PG8_STAGE(PG8_SB(0, 0), cB, voffB); PG8_STAGE(PG8_SA(0, 0), cA, voffA); PG8_STAGE(PG8_SB(0, 1), cB + hstep, voffB); PG8_STAGE(PG8_SA(0, 1), cA + hstep, voffA);
    if (wr == 1) PG8_BAR;
    PG8_WAIT_V(4); PG8_BAR;
    PG8_STAGE(PG8_SB(1, 0), cB + kstep, voffB); PG8_STAGE(PG8_SA(1, 0), cA + kstep, voffA); PG8_STAGE(PG8_SB(1, 1), cB + hstep + kstep, voffB);
    PG8_WAIT_V(6); PG8_BAR;
    for (;;) {
        const bool has_next = S.next(ui + 1, nxt);
        const char* nA = has_next ? (const char*)g.A + (size_t)nxt.pm * tstepA + (size_t)nxt.kc * cstep : cA; const char* nB = has_next ? (const char*)g.Bt + (size_t)nxt.pn * tstep + (size_t)nxt.kc * cstep : cB;
        for (int t = 0; t < nt; t += 2) {
            const bool last = (t == nt - 2);
            const char* a1 = cA + (size_t)(t + 1) * kstep;
            const char* a2 = last ? nA : cA + (size_t)(t + 2) * kstep; const char* b2 = last ? nB : cB + (size_t)(t + 2) * kstep;
            const char* a3 = a2 + kstep; const char* b3 = b2 + kstep;
            if (last && has_next) S.a_ready(nxt);
            PG8_LDB(B0, 0, 0); PG8_SCHED; PG8_LDA(At, 0, 0); PG8_STAGE(PG8_SA(1, 1), a1 + hstep, voffA);
            PG8_WAIT_L(8); PG8_BAR; PG8_WAIT_L(0); PG8_MMA(0, 0, At, B0); PG8_BAR; PG8_SCHED;
            PG8_LDB(B1, 0, 1); PG8_STAGE(PG8_SB(0, 0), b2, voffB);
            PG8_BAR; PG8_WAIT_L(0); PG8_MMA(0, 1, At, B1); PG8_BAR;
            PG8_LDA(At, 0, 1); PG8_STAGE(PG8_SA(0, 0), a2, voffA);
            PG8_BAR; PG8_WAIT_L(0); PG8_MMA(1, 0, At, B0); PG8_BAR; PG8_SCHED;
            PG8_STAGE(PG8_SB(0, 1), b2 + hstep, voffB);
            PG8_WAIT_V(6); PG8_BAR; PG8_MMA(1, 1, At, B1); PG8_BAR;
            PG8_LDB(B0, 1, 0); PG8_SCHED; PG8_LDA(At, 1, 0); PG8_STAGE(PG8_SA(0, 1), a2 + hstep, voffA);
            PG8_WAIT_L(8); PG8_BAR; PG8_WAIT_L(0); PG8_MMA(0, 0, At, B0); PG8_BAR; PG8_SCHED;
            PG8_LDB(B1, 1, 1); PG8_STAGE(PG8_SB(1, 0), b3, voffB);
            PG8_BAR; PG8_WAIT_L(0); PG8_MMA(0, 1, At, B1); PG8_BAR;
            PG8_LDA(At, 1, 1); PG8_STAGE(PG8_SA(1, 0), a3, voffA);
            PG8_BAR; PG8_WAIT_L(0); PG8_MMA(1, 0, At, B0); PG8_BAR; PG8_SCHED;
            PG8_STAGE(PG8_SB(1, 1), b3 + hstep, voffB);
            PG8_WAIT_V(6); PG8_BAR; PG8_MMA(1, 1, At, B1); PG8_BAR;
        }
        if constexpr (!Epi::AFTER_DRAIN) { E(acc, cur, wr, wc, fr, fq); S.done(cur); }
        if (!has_next) break;
#pragma unroll
        for (int a = 0; a < 2; ++a)
#pragma unroll
            for (int b = 0; b < 2; ++b)
#pragma unroll
                for (int m = 0; m < 4; ++m)
#pragma unroll
                    for (int n = 0; n < 2; ++n) acc[a][b][m][n] = (f32x4){0.f, 0.f, 0.f, 0.f};
        cur = nxt; cA = nA; cB = nB; ++ui;
    }
    PG8_WAIT_V(0);
    if (wr == 0) PG8_BAR;
    PG8_BAR;
    if constexpr (Epi::AFTER_DRAIN) { E.fused(acc, cur, wr, wc, fr, fq, lds, wid, lane); S.done(cur); }
#undef PG8_SA
#undef PG8_SB
#undef PG8_STAGE
#undef PG8_LDA
#undef PG8_LDB
#undef PG8_MMA
#undef PG8_WAIT_V
#undef PG8_WAIT_L
#undef PG8_BAR
#undef PG8_SCHED
}
}
#define XB_TMO      128
#define XB_XCNT(j)  (256  + 64 * (j))
#define XB_XSUB(j)  (1280 + 64 * (j))
#define XB_XGEN(j)  (2304 + 64 * (j))
#define XB_TOP      3328
#define XB_TOPGEN   3392
#define XCD_BAR_WORDS 3456
#define XB_SPIN_CAP (1u << 18)

__device__ __forceinline__ unsigned xb_ld(unsigned* p)              { return __hip_atomic_load(p, __ATOMIC_RELAXED, __HIP_MEMORY_SCOPE_AGENT); }
__device__ __forceinline__ unsigned xb_add(unsigned* p, unsigned v) { return __hip_atomic_fetch_add(p, v, __ATOMIC_RELAXED, __HIP_MEMORY_SCOPE_AGENT); }
__device__ __forceinline__ unsigned xb_xcc_id() { return (unsigned)__builtin_amdgcn_s_getreg((3 << 11) | 20) & 0xFu; }
#define XB_SPIN(cond, bar) do { unsigned _sp = 0; while (cond) { __builtin_amdgcn_s_sleep(1); \
    if ((++_sp & 255u) == 0u) { if (xb_ld(&(bar)[XB_TMO])) break; if (_sp > XB_SPIN_CAP) { atomicAdd(&(bar)[XB_TMO], 1u); break; } } } } while (0)

struct XcdBarrier {
    unsigned* bar; unsigned x;
    volatile LAS unsigned* st;
};

__device__ __forceinline__ XcdBarrier xcd_barrier_post(unsigned* bar, volatile LAS unsigned* st) {
    XcdBarrier b; b.bar = bar; b.x = xb_xcc_id(); b.st = st;
    if (threadIdx.x == 0) (void)xb_add(&bar[XB_XCNT(b.x)], 1u);
    return b;
}
__device__ __forceinline__ void xcd_barrier_complete(unsigned* bar, unsigned x, unsigned& nloc, unsigned& nx) {
    const unsigned G = gridDim.x * gridDim.y * gridDim.z;
    unsigned sum, cnt, mine, sp = 0u;
    for (;;) {
        sum = 0u; cnt = 0u; mine = 0u;
#pragma unroll
        for (unsigned j = 0; j < 16; ++j) { const unsigned c = xb_ld(&bar[XB_XCNT(j)]); sum += c; cnt += (c > 0u) ? 1u : 0u; mine = (j == x) ? c : mine; }
        if (sum == G) break;
        __builtin_amdgcn_s_sleep(1);
        if ((++sp & 255u) == 0u) { if (xb_ld(&bar[XB_TMO])) break; if (sp > XB_SPIN_CAP) { atomicAdd(&bar[XB_TMO], 1u); break; } }
    }
    nloc = mine > 0u ? mine : 1u; nx = cnt > 0u ? cnt : 1u;
}

__device__ __forceinline__ void xcd_barrier(const XcdBarrier& b) {
    asm volatile("s_waitcnt vmcnt(0)" ::: "memory");
    __syncthreads();
    if (threadIdx.x == 0) {
        unsigned* bar = b.bar;
        __builtin_amdgcn_s_waitcnt(0);
        unsigned nloc = b.st[0], nx = b.st[1];
        if (nloc == 0u) { xcd_barrier_complete(bar, b.x, nloc, nx); b.st[0] = nloc; b.st[1] = nx; }
        const unsigned old = xb_add(&bar[XB_XSUB(b.x)], 1u);
        const unsigned gen = old / nloc;
        if (old + 1u == (gen + 1u) * nloc) {
            __builtin_amdgcn_fence(__ATOMIC_RELEASE, "agent");
            asm volatile("s_waitcnt vmcnt(0)" ::: "memory");
            const unsigned og = xb_add(&bar[XB_TOP], 1u);
            const unsigned tg = og / nx;
            if (og + 1u == (tg + 1u) * nx) xb_add(&bar[XB_TOPGEN], 1u);
            else XB_SPIN(xb_ld(&bar[XB_TOPGEN]) == tg, bar);
            __builtin_amdgcn_fence(__ATOMIC_ACQUIRE, "agent");
            xb_add(&bar[XB_XGEN(b.x)], 1u);
            asm volatile("s_waitcnt vmcnt(0)" ::: "memory");
        } else {
            XB_SPIN(xb_ld(&bar[XB_XGEN(b.x)]) == gen, bar);
            __builtin_amdgcn_fence(__ATOMIC_ACQUIRE, "agent");
            asm volatile("s_waitcnt vmcnt(0)" ::: "memory");
        }
    }
    __syncthreads();
}


using pg8::bf16_t; using pg8::bf16x8; using pg8::f32x4; using pg8::u32x4;
typedef float f32x16 __attribute__((ext_vector_type(16)));
typedef unsigned u32x2 __attribute__((ext_vector_type(2)));

constexpr int DM = 1024, NB = 8, SEQ = 4096, CTXL = 256, ML = NB * SEQ, MC = NB * CTXL, MT = ML + MC, NH = 16, HD = 64, DFF = 3072;
constexpr int NCHUNK = 34;
constexpr float EPSN = 1e-6f;
constexpr size_t MiB = (size_t)1 << 20, MEL = (size_t)1 << 20;
constexpr size_t WS_MODS = 0, WS_SUM = 1 * MiB, WS_BAR = 8 * MiB, WS_BDW = 9 * MiB, WS_CTXR = 10 * MiB, WS_WB = 18 * MiB, WS_HN = 118 * MiB, WS_R = 186 * MiB, WS_PART = (186 + 272) * MiB, WS_END = 510 * MiB;
constexpr size_t R_Q = 0, R_K = (size_t)MT * DM, R_VT = 2 * (size_t)MT * DM;
constexpr size_t R_GATE = 0, R_REC = (size_t)MT * DM, R_XR = 2 * (size_t)MT * DM, R_YP = 3 * (size_t)MT * DM;
constexpr size_t R_U = 0, R_G = 0;
constexpr int LDS_BYTES = 147456;

enum { OP_PRO = 0, OP_NORM, OP_GQK, OP_GST, OP_GRES, OP_ATTN, OP_LCONV, OP_LRUA, OP_LRUC, OP_FCONV, OP_GUP };
#ifndef DUP_MASK
#define DUP_MASK 0
#endif
#define DUPE(op, i, arg) DUPE_(((DUP_MASK >> op) & 1), op, i, arg)
#define DUPE_(c, op, i, arg) DUPE__(c, op, i, arg)
#define DUPE__(c, op, i, arg) DUPE_##c(op, i, arg)
#define DUPE_0(op, i, arg)
#define DUPE_1(op, i, arg) {op, i, arg, 0},
#if DUP_MASK & 2
#define DN(i, a) {OP_NORM, i, a, 0},
#else
#define DN(i, a)
#endif
#if DUP_MASK & 4
#define DQK(i) {OP_GQK, i, 0, 0},
#else
#define DQK(i)
#endif
#if DUP_MASK & 8
#define DST(i, a) {OP_GST, i, a, 0},
#else
#define DST(i, a)
#endif
#if DUP_MASK & 32
#define DAT(i) {OP_ATTN, i, 1, 0},
#else
#define DAT(i)
#endif
#if DUP_MASK & 64
#define DLC(i) {OP_LCONV, i, 0, 0},
#else
#define DLC(i)
#endif
#if DUP_MASK & 128
#define DLA(i) {OP_LRUA, i, 0, 0},
#else
#define DLA(i)
#endif
#if DUP_MASK & 256
#define DLCC(i) {OP_LRUC, i, 0, 0},
#else
#define DLCC(i)
#endif
#if DUP_MASK & 1024
#define DUP_(i) {OP_GUP, i, 0, 0},
#else
#define DUP_(i)
#endif
#if DUP_MASK & 1
#define DPRO {OP_PRO, 0, 0, 0},
#else
#define DPRO
#endif
#define FFN_OPS(i) DN(i, 1) {OP_NORM, i, 1, 1}, DUP_(i) {OP_GUP, i, 0, 1}, {OP_GRES, i, 2, 1}
#define NA_OPS(i) DN(i, 0) {OP_NORM, i, 0, 1}, DQK(i) {OP_GQK, i, 0, 0}, DST(i, 0) {OP_GST, i, 0, 1}, DAT(i) {OP_ATTN, i, 0, 1}, {OP_GRES, i, 0, 1}, FFN_OPS(i)
#define LRU_OPS(i) DN(i, 0) {OP_NORM, i, 0, 1}, DST(i, 1) {OP_GST, i, 1, 1}, DLC(i) {OP_LCONV, i, 0, 1}, DLCC(i) {OP_LRUC, i, 0, 1}, {OP_GRES, i, 0, 1}, FFN_OPS(i)
#define PROG_INIT { DPRO {OP_PRO, 0, 0, 1}, NA_OPS(0), LRU_OPS(1), NA_OPS(2), LRU_OPS(3) }
__device__ const int PROG[][4] = PROG_INIT;
static const int HOSTPROG[][4] = PROG_INIT;
constexpr int NPROG = (int)(sizeof(HOSTPROG) / sizeof(HOSTPROG[0]));

struct Args { const float* in[26]; float* out; unsigned char* ws; int pc_lo, pc_hi; };

__device__ __forceinline__ unsigned f2bf(float f) { unsigned u = __float_as_uint(f); return (u + 0x7fffu + ((u >> 16) & 1u)) >> 16; }
__device__ __forceinline__ unsigned pk2(float lo, float hi) { return f2bf(lo) | (f2bf(hi) << 16); }
__device__ __forceinline__ float bflo(unsigned w) { return __uint_as_float(w << 16); }
__device__ __forceinline__ float bfhi(unsigned w) { return __uint_as_float(w & 0xffff0000u); }
__device__ __forceinline__ float wave_sum(float v) {
#pragma unroll
    for (int o = 1; o < 64; o <<= 1) v += __shfl_xor(v, o);
    return v;
}
__device__ __forceinline__ float fexp(float x) { return __builtin_amdgcn_exp2f(x * 1.4426950408889634f); }
__device__ __forceinline__ float sigmoidf_(float x) { return __builtin_amdgcn_rcpf(1.0f + __builtin_amdgcn_exp2f(x * -1.4426950408889634f)); }
__device__ __forceinline__ f32x16 mfma32(bf16x8 a, bf16x8 b, f32x16 c) { return __builtin_amdgcn_mfma_f32_32x32x16_bf16(a, b, c, 0, 0, 0); }
__device__ __forceinline__ f32x4 mfma16(bf16x8 a, bf16x8 b, f32x4 c) { return __builtin_amdgcn_mfma_f32_16x16x32_bf16(a, b, c, 0, 0, 0); }

struct EpiStore {
    static constexpr bool PERM = true, AFTER_DRAIN = false;
    bf16_t* O; int ldc; int split_cols; size_t split_stride;
    __device__ __forceinline__ void operator()(const f32x4 (&acc)[2][2][4][2], const pg8::Unit& u, int wr, int wc, int fr, int fq) const {
        const int row0 = u.pm * 256 + wr * 64 + fr; int colt = u.pn * 256; bf16_t* base = O;
        if (split_cols) { const int t = colt / split_cols; base += (size_t)t * split_stride; colt -= t * split_cols; }
        const int col0 = colt + wc * 32 + 8 * fq;
#pragma unroll
        for (int ai = 0; ai < 2; ++ai)
#pragma unroll
            for (int m = 0; m < 4; ++m) { bf16_t* rowp = base + (size_t)(row0 + ai * 128 + m * 16) * ldc + col0;
#pragma unroll
                for (int bj = 0; bj < 2; ++bj) { const f32x4 v0 = acc[ai][bj][m][0], v1 = acc[ai][bj][m][1];
                    u32x4 w; w.x = pg8::cvt_pk_bf16(v0[0], v0[1]); w.y = pg8::cvt_pk_bf16(v0[2], v0[3]); w.z = pg8::cvt_pk_bf16(v1[0], v1[1]); w.w = pg8::cvt_pk_bf16(v1[2], v1[3]);
                    *(u32x4*)(rowp + bj * 128) = w; } }
    }
};
struct EpiQK {
    static constexpr bool PERM = true, AFTER_DRAIN = false;
    bf16_t* Q; bf16_t* K; const float* qg; const float* kg;
    __device__ __forceinline__ void operator()(const f32x4 (&acc)[2][2][4][2], const pg8::Unit& u, int wr, int wc, int fr, int fq) const {
        const int row0 = u.pm * 256 + wr * 64 + fr; const bool isk = u.pn >= 4;
        bf16_t* base = (isk ? K : Q) + (u.pn & 3) * 256 + 64 * wc + 8 * fq;
        const float* g = isk ? kg : qg; const float sc = isk ? 1.0f : 0.125f;
        f32x4 gv[2][2];
#pragma unroll
        for (int bj = 0; bj < 2; ++bj)
#pragma unroll
            for (int n = 0; n < 2; ++n) gv[bj][n] = *(const f32x4*)(g + 32 * bj + 8 * fq + 4 * n) * sc;
#pragma unroll
        for (int ai = 0; ai < 2; ++ai)
#pragma unroll
            for (int m = 0; m < 4; ++m) {
                float ss = 0.f;
#pragma unroll
                for (int bj = 0; bj < 2; ++bj)
#pragma unroll
                    for (int n = 0; n < 2; ++n) { const f32x4 x = acc[ai][bj][m][n]; ss += (x[0] * x[0] + x[1] * x[1]) + (x[2] * x[2] + x[3] * x[3]); }
                ss += __shfl_xor(ss, 16); ss += __shfl_xor(ss, 32);
                const float rs = __builtin_amdgcn_rsqf(ss * (1.0f / 64.0f) + EPSN);
                bf16_t* rowp = base + (size_t)(row0 + ai * 128 + m * 16) * DM;
#pragma unroll
                for (int bj = 0; bj < 2; ++bj) { const f32x4 v0 = acc[ai][bj][m][0] * rs * gv[bj][0], v1 = acc[ai][bj][m][1] * rs * gv[bj][1];
                    u32x4 w; w.x = pg8::cvt_pk_bf16(v0[0], v0[1]); w.y = pg8::cvt_pk_bf16(v0[2], v0[3]); w.z = pg8::cvt_pk_bf16(v1[0], v1[1]); w.w = pg8::cvt_pk_bf16(v1[2], v1[3]);
                    *(u32x4*)(rowp + 32 * bj) = w; }
            }
    }
};
struct EpiRes {
    static constexpr bool PERM = false, AFTER_DRAIN = false;
    const float* in_lat; const float* in_ctx; float* out_lat; float* out_ctx; const float* gate; int row_off;
    __device__ __forceinline__ void operator()(const f32x4 (&acc)[2][2][4][2], const pg8::Unit& u, int wr, int wc, int fr, int fq) const {
        const int R0 = row_off + u.pm * 256;
        const float* inp; float* outp; int bidx;
        if (R0 < ML) { bidx = R0 >> 12; inp = in_lat + (size_t)R0 * DM; outp = out_lat + (size_t)R0 * DM; }
        else { bidx = 8; inp = in_ctx + (size_t)(R0 - ML) * DM; outp = out_ctx + (size_t)(R0 - ML) * DM; }
        const int col0 = u.pn * 256 + wc * 32 + 4 * fq;
        const float* gp = gate + (size_t)bidx * 6144 + col0;
        f32x4 gv[2][2];
#pragma unroll
        for (int bj = 0; bj < 2; ++bj)
#pragma unroll
            for (int n = 0; n < 2; ++n) gv[bj][n] = *(const f32x4*)(gp + bj * 128 + n * 16);
#pragma unroll
        for (int ai = 0; ai < 2; ++ai)
#pragma unroll
            for (int m = 0; m < 4; ++m) { const size_t ro = (size_t)(wr * 64 + fr + ai * 128 + m * 16) * DM + col0;
#pragma unroll
                for (int bj = 0; bj < 2; ++bj)
#pragma unroll
                    for (int n = 0; n < 2; ++n) { const size_t o = ro + bj * 128 + n * 16; *(f32x4*)(outp + o) = *(const f32x4*)(inp + o) + gv[bj][n] * acc[ai][bj][m][n]; } }
    }
};


struct CtxSplitOrder {
    int nkc, G, c, pm0;
    __device__ __forceinline__ bool next(int i, pg8::Unit& u) const {
        const int L = i * G + c; if (L >= 8 * 4 * nkc) return false;
        u.kc = L % nkc; u.pn = (L / nkc) & 3; u.pm = pm0 + L / (nkc * 4); return true;
    }
    __device__ __forceinline__ void a_ready(const pg8::Unit&) const {}
    __device__ __forceinline__ void done(const pg8::Unit&) const {}
};
struct EpiPart {
    static constexpr bool PERM = false, AFTER_DRAIN = false;
    float* part;
    __device__ __forceinline__ void operator()(const f32x4 (&acc)[2][2][4][2], const pg8::Unit& u, int wr, int wc, int fr, int fq) const {
        float* outp = part + ((size_t)u.kc * MC + (size_t)(u.pm * 256 - ML)) * DM;
        const int col0 = u.pn * 256 + wc * 32 + 4 * fq;
#pragma unroll
        for (int ai = 0; ai < 2; ++ai)
#pragma unroll
            for (int m = 0; m < 4; ++m) { float* rp = outp + (size_t)(wr * 64 + fr + ai * 128 + m * 16) * DM + col0;
#pragma unroll
                for (int bj = 0; bj < 2; ++bj)
#pragma unroll
                    for (int n = 0; n < 2; ++n) *(f32x4*)(rp + bj * 128 + n * 16) = acc[ai][bj][m][n]; }
    }
};

template <int CTRL> __device__ __forceinline__ float dppf(float x) { return __int_as_float(__builtin_amdgcn_mov_dpp(__float_as_int(x), CTRL, 0xf, 0xf, true)); }
struct EpiUpConv {
    static constexpr bool PERM = true, AFTER_DRAIN = false;
    bf16_t* Gb; const float* cw; const float* cbias; LAS float* xb;
    __device__ __forceinline__ void operator()(const f32x4 (&acc)[2][2][4][2], const pg8::Unit& u, int wr, int wc, int fr, int fq) const {
        const int cl = 32 * wc + 8 * fq, cv = u.pn * 128 + cl;
#pragma unroll
        for (int ai = 0; ai < 2; ++ai) { const int s = 2 * ai + wr;
            if (fr == 0) { LAS float* p = xb + (s * 2 + 0) * 256 + cl; *(LAS f32x4*)p = acc[ai][0][0][0]; *(LAS f32x4*)(p + 4) = acc[ai][0][0][1]; *(LAS f32x4*)(p + 128) = acc[ai][1][0][0]; *(LAS f32x4*)(p + 132) = acc[ai][1][0][1]; }
            if (fr == 15) { LAS float* p = xb + (s * 2 + 1) * 256 + cl; *(LAS f32x4*)p = acc[ai][0][3][0]; *(LAS f32x4*)(p + 4) = acc[ai][0][3][1]; *(LAS f32x4*)(p + 128) = acc[ai][1][3][0]; *(LAS f32x4*)(p + 132) = acc[ai][1][3][1]; } }
        asm volatile("s_waitcnt lgkmcnt(0)\n\ts_barrier\n\ts_barrier" ::: "memory");
        const int R0 = 254 * u.pm - 1;
        bool bnd = false;
#pragma unroll
        for (int ai = 0; ai < 2; ++ai)
#pragma unroll
            for (int m = 0; m < 4; ++m) { const int row = R0 + 128 * ai + 64 * wr + 16 * m + fr;
                int pos, last; if (row < ML) { pos = row & (SEQ - 1); last = SEQ - 1; } else { pos = (row - ML) & (CTXL - 1); last = CTXL - 1; }
                bnd = bnd || pos == 0 || pos == last || row < 0 || row >= MT; }
        if (__builtin_amdgcn_ballot_w64(bnd) == 0ull) {
#pragma unroll
            for (int n = 0; n < 2; ++n) {
                f32x4 wv[3], wg[3], bv, bg;
#pragma unroll
                for (int k = 0; k < 3; ++k) { wv[k] = *(const f32x4*)(cw + k * 6144 + cv + 4 * n); wg[k] = *(const f32x4*)(cw + k * 6144 + DFF + cv + 4 * n); }
                bv = *(const f32x4*)(cbias + cv + 4 * n); bg = *(const f32x4*)(cbias + DFF + cv + 4 * n);
#pragma unroll
                for (int ai = 0; ai < 2; ++ai) { const int s = 2 * ai + wr;
#pragma unroll
                    for (int m = 0; m < 4; ++m) {
                        const int rl = 128 * ai + 64 * wr + 16 * m + fr, row = R0 + rl;
                        f32x4 xpv, xpg, xnv, xng;
                        if (m == 0) { const LAS float* p = xb + ((s > 0 ? s - 1 : 0) * 2 + 1) * 256 + cl + 4 * n; xpv = *(const LAS f32x4*)p; xpg = *(const LAS f32x4*)(p + 128); }
                        if (m == 3) { const LAS float* p = xb + ((s < 3 ? s + 1 : 3) * 2 + 0) * 256 + cl + 4 * n; xnv = *(const LAS f32x4*)p; xng = *(const LAS f32x4*)(p + 128); }
                        float o[4];
#pragma unroll
                        for (int e = 0; e < 4; ++e) {
                            const float cvv = acc[ai][0][m][n][e], cgg = acc[ai][1][m][n][e];
                            const float upv = m > 0 ? acc[ai][0][m > 0 ? m - 1 : 0][n][e] : xpv[e], upg = m > 0 ? acc[ai][1][m > 0 ? m - 1 : 0][n][e] : xpg[e];
                            const float dnv = m < 3 ? acc[ai][0][m < 3 ? m + 1 : 3][n][e] : xnv[e], dng = m < 3 ? acc[ai][1][m < 3 ? m + 1 : 3][n][e] : xng[e];
                            const float xpv_ = fr == 15 ? upv : cvv, xpg_ = fr == 15 ? upg : cgg;
                            const float xnv_ = fr == 0 ? dnv : cvv, xng_ = fr == 0 ? dng : cgg;
                            float val = bv[e] + wv[1][e] * cvv; val += wv[0][e] * dppf<0x121>(xpv_); val += wv[2][e] * dppf<0x12F>(xnv_);
                            float gt = bg[e] + wg[1][e] * cgg; gt += wg[0][e] * dppf<0x121>(xpg_); gt += wg[2][e] * dppf<0x12F>(xng_);
                            o[e] = val * gt * sigmoidf_(gt);
                        }
                        u32x2 ow; ow.x = pg8::cvt_pk_bf16(o[0], o[1]); ow.y = pg8::cvt_pk_bf16(o[2], o[3]);
                        if (rl >= 1 && rl <= 254) *(u32x2*)(Gb + (size_t)row * DFF + cv + 4 * n) = ow;
                    }
                }
            }
            return;
        }
#pragma unroll
        for (int n = 0; n < 2; ++n) {
            f32x4 wv[3], wg[3], bv, bg;
#pragma unroll
            for (int k = 0; k < 3; ++k) { wv[k] = *(const f32x4*)(cw + k * 6144 + cv + 4 * n); wg[k] = *(const f32x4*)(cw + k * 6144 + DFF + cv + 4 * n); }
            bv = *(const f32x4*)(cbias + cv + 4 * n); bg = *(const f32x4*)(cbias + DFF + cv + 4 * n);
#pragma unroll
            for (int ai = 0; ai < 2; ++ai) { const int s = 2 * ai + wr;
#pragma unroll
                for (int m = 0; m < 4; ++m) {
                    const int rl = 128 * ai + 64 * wr + 16 * m + fr, row = R0 + rl;
                    int pos, last; if (row < ML) { pos = row & (SEQ - 1); last = SEQ - 1; } else { pos = (row - ML) & (CTXL - 1); last = CTXL - 1; }
                    const bool pok = pos > 0, nok = pos < last;
                    f32x4 xpv, xpg, xnv, xng;
                    if (m == 0) { const LAS float* p = xb + ((s > 0 ? s - 1 : 0) * 2 + 1) * 256 + cl + 4 * n; xpv = *(const LAS f32x4*)p; xpg = *(const LAS f32x4*)(p + 128); }
                    if (m == 3) { const LAS float* p = xb + ((s < 3 ? s + 1 : 3) * 2 + 0) * 256 + cl + 4 * n; xnv = *(const LAS f32x4*)p; xng = *(const LAS f32x4*)(p + 128); }
                    float o[4];
#pragma unroll
                    for (int e = 0; e < 4; ++e) {
                        const float cvv = acc[ai][0][m][n][e], cgg = acc[ai][1][m][n][e];
                        const float av = dppf<0x121>(cvv), ag = dppf<0x121>(cgg);
                        float bvv, bgg;
                        if (m > 0) { bvv = dppf<0x121>(acc[ai][0][m > 0 ? m - 1 : 0][n][e]); bgg = dppf<0x121>(acc[ai][1][m > 0 ? m - 1 : 0][n][e]); } else { bvv = xpv[e]; bgg = xpg[e]; }
                        float pvv = fr == 0 ? bvv : av, pgg = fr == 0 ? bgg : ag;
                        const float a2v = dppf<0x12F>(cvv), a2g = dppf<0x12F>(cgg);
                        float b2v, b2g;
                        if (m < 3) { b2v = dppf<0x12F>(acc[ai][0][m < 3 ? m + 1 : 3][n][e]); b2g = dppf<0x12F>(acc[ai][1][m < 3 ? m + 1 : 3][n][e]); } else { b2v = xnv[e]; b2g = xng[e]; }
                        float nvv = fr == 15 ? b2v : a2v, ngg = fr == 15 ? b2g : a2g;
                        pvv = pok ? pvv : 0.f; pgg = pok ? pgg : 0.f; nvv = nok ? nvv : 0.f; ngg = nok ? ngg : 0.f;
                        const float val = bv[e] + wv[0][e] * pvv + wv[1][e] * cvv + wv[2][e] * nvv;
                        const float gt = bg[e] + wg[0][e] * pgg + wg[1][e] * cgg + wg[2][e] * ngg;
                        o[e] = val * gt * sigmoidf_(gt);
                    }
                    u32x2 ow; ow.x = pg8::cvt_pk_bf16(o[0], o[1]); ow.y = pg8::cvt_pk_bf16(o[2], o[3]);
                    if (rl >= 1 && rl <= 254 && row >= 0 && row < MT) *(u32x2*)(Gb + (size_t)row * DFF + cv + 4 * n) = ow;
                }
            }
        }
    }
};

__device__ __forceinline__ void transpose_item(const float* W, int ldw, int K, int ncol0, int ncols, bf16_t* WT, int perm, LAS float* scr, int item, int lane) {
    const int nblk = ncols / 32, kb = item / nblk, nb = item % nblk, k0 = 64 * kb, n0 = 32 * nb;
    { f32x4 v[8];
#pragma unroll
      for (int i = 0; i < 8; ++i) v[i] = *(const f32x4*)(W + (size_t)(k0 + (lane >> 3) + 8 * i) * ldw + ncol0 + n0 + 4 * (lane & 7));
#pragma unroll
      for (int i = 0; i < 8; ++i) { LAS float* d = scr + ((lane >> 3) + 8 * i) * 33 + 4 * (lane & 7); d[0] = v[i][0]; d[1] = v[i][1]; d[2] = v[i][2]; d[3] = v[i][3]; } }
    asm volatile("s_waitcnt lgkmcnt(0)" ::: "memory");
    int d0 = n0;
    if (perm == 1) { const int pn = n0 >> 8, wc = (n0 >> 6) & 3, bj = (n0 >> 5) & 1; d0 = pn * 256 + bj * 128 + wc * 32; }
    else if (perm == 2) { const int isg = n0 >= DFF, nn = isg ? n0 - DFF : n0; d0 = (nn >> 7) * 256 + isg * 128 + (nn & 127); }
    const int c = lane & 7;
#pragma unroll
    for (int j = 0; j < 4; ++j) { const int n = (lane >> 3) + 8 * j; const LAS float* s = scr + (8 * c) * 33 + n;
        u32x4 o; o.x = pk2(s[0 * 33], s[1 * 33]); o.y = pk2(s[2 * 33], s[3 * 33]); o.z = pk2(s[4 * 33], s[5 * 33]); o.w = pk2(s[6 * 33], s[7 * 33]);
        *(u32x4*)(WT + (size_t)(d0 + n) * K + k0 + 8 * c) = o; }
    asm volatile("s_waitcnt lgkmcnt(0)" ::: "memory");
}
struct TDesc { const float* src; int ldw, K, ncol0, ncols, perm; bf16_t* dst; int nitems; };
__device__ __forceinline__ TDesc get_tdesc(int m, const Args& a, bf16_t* WB) {
    TDesc t;
    if (m < 6) { const int j = m / 3, w = m % 3;
        if (w == 0) { t.src = a.in[8] + (size_t)j * DM * 3072; t.ldw = 3072; t.K = DM; t.ncol0 = 0; t.ncols = 2048; t.perm = 1; t.dst = WB + (size_t)j * 4 * MEL; }
        else if (w == 1) { t.src = a.in[8] + (size_t)j * DM * 3072; t.ldw = 3072; t.K = DM; t.ncol0 = 2048; t.ncols = 1024; t.perm = 0; t.dst = WB + (size_t)j * 4 * MEL + 2 * MEL; }
        else { t.src = a.in[12] + (size_t)j * DM * DM; t.ldw = DM; t.K = DM; t.ncol0 = 0; t.ncols = DM; t.perm = 0; t.dst = WB + (size_t)j * 4 * MEL + 3 * MEL; }
    } else if (m < 10) { const int j = (m - 6) / 2, w = (m - 6) % 2;
        if (w == 0) { t.src = a.in[13] + (size_t)j * DM * 2048; t.ldw = 2048; t.K = DM; t.ncol0 = 0; t.ncols = 2048; t.perm = 0; t.dst = WB + 8 * MEL + (size_t)j * 3 * MEL; }
        else { t.src = a.in[21] + (size_t)j * DM * DM; t.ldw = DM; t.K = DM; t.ncol0 = 0; t.ncols = DM; t.perm = 0; t.dst = WB + 8 * MEL + (size_t)j * 3 * MEL + 2 * MEL; }
    } else { const int i = (m - 10) / 2, w = (m - 10) % 2;
        if (w == 0) { t.src = a.in[22] + (size_t)i * DM * 6144; t.ldw = 6144; t.K = DM; t.ncol0 = 0; t.ncols = 6144; t.perm = 2; t.dst = WB + 14 * MEL + (size_t)i * 9 * MEL; }
        else { t.src = a.in[25] + (size_t)i * DFF * DM; t.ldw = DM; t.K = DFF; t.ncol0 = 0; t.ncols = DM; t.perm = 0; t.dst = WB + 14 * MEL + (size_t)i * 9 * MEL + 6 * MEL; }
    }
    t.nitems = (t.K / 64) * (t.ncols / 32);
    return t;
}
__device__ __forceinline__ void prologue(const Args& a, LAS unsigned char* lds, int tid, int lane, int wave, int G) {
    unsigned char* ws = a.ws;
    float* MODS = (float*)(ws + WS_MODS);
    bf16_t* WB = (bf16_t*)(ws + WS_WB);
    bf16_t* BDW = (bf16_t*)(ws + WS_BDW);
    LAS float* sl = (LAS float*)(lds + 69632);
    LAS float* red = (LAS float*)(lds + 69632 + 36864);
    for (int i = tid; i < 9 * DM; i += 512) { const int bi = i >> 10, k = i & 1023; const float v = bi < 8 ? a.in[1][bi * DM + k] : a.in[3][k]; sl[i] = v * sigmoidf_(v); }
    __syncthreads();
    for (int it = opaque_bid(); it < 4 * 96; it += G) {
        const int l = it / 96, n0 = (it % 96) * 64;
        const float* wp = a.in[4] + ((size_t)l * DM + wave * 128) * 6144 + n0 + lane;
        float acc[9];
#pragma unroll
        for (int bi = 0; bi < 9; ++bi) acc[bi] = 0.f;
        for (int k = 0; k < 128; k += 16) {
            float w[16];
#pragma unroll
            for (int kk = 0; kk < 16; ++kk) w[kk] = wp[(size_t)(k + kk) * 6144];
#pragma unroll
            for (int k4 = 0; k4 < 16; k4 += 4)
#pragma unroll
                for (int bi = 0; bi < 9; ++bi) { const f32x4 s = *(const LAS f32x4*)(sl + bi * DM + wave * 128 + k + k4); acc[bi] += (s[0] * w[k4] + s[1] * w[k4 + 1]) + (s[2] * w[k4 + 2] + s[3] * w[k4 + 3]); }
        }
#pragma unroll
        for (int bi = 0; bi < 9; ++bi) red[(wave * 9 + bi) * 64 + lane] = acc[bi];
        __syncthreads();
        for (int o = tid; o < 9 * 64; o += 512) { const int bi = o >> 6, ln = o & 63; float s = a.in[5][(size_t)l * 6144 + n0 + ln];
#pragma unroll
            for (int w = 0; w < 8; ++w) s += red[(w * 9 + bi) * 64 + ln];
            MODS[((size_t)l * 9 + bi) * 6144 + n0 + ln] = s; }
        __syncthreads();
    }
    { float* CTXR = (float*)(ws + WS_CTXR);
      for (int i = opaque_bid() * 512 + tid; i < MC * DM / 4; i += G * 512) { asm volatile("" : "+v"(i)); ((f32x4*)CTXR)[i] = ((const f32x4*)a.in[2])[i]; } }
#pragma unroll 1
    for (int idx = opaque_bid() * 512 + tid; idx < 2 * 2 * 2 * 16 * 4096; idx += G * 512) { asm volatile("" : "+v"(idx));
        const int d = idx & 63, e = (idx >> 6) & 63, n = (idx >> 12) & 15, gt = (idx >> 16) & 1, dir = (idx >> 17) & 1, j = idx >> 18;
        const float* W = gt ? a.in[18] : a.in[16];
        BDW[idx] = (bf16_t)f2bf(W[((((size_t)j * 2 + dir) * 16 + n) * 64 + d) * 64 + e]);
    }
    LAS float* scr = (LAS float*)(lds + wave * 8448);
    const int gw = opaque_bid() * 8 + wave, NGW = G * 8;
    int base = 0;
    for (int m = 0; m < 18; ++m) {
        const TDesc t = get_tdesc(m, a, WB);
        int first = (gw - base) % NGW; if (first < 0) first += NGW;
        for (int it = first; it < t.nitems; it += NGW) transpose_item(t.src, t.ldw, t.K, t.ncol0, t.ncols, t.dst, t.perm, scr, it, lane);
        base = (base + t.nitems) % NGW;
    }
}

__device__ __forceinline__ void norm_phase(const float* xl, const float* xc, bf16_t* HN, const float* gain, const float* mods_l, int sidx, int nrows, int lane, int gw, int NGW,
                                           float* ctxr_rw, const float* part, int npart, const float* pgate) {
    for (int row = gw; row < nrows; row += NGW) {
        const float* src; int bidx;
        if (row < ML) { src = xl + (size_t)row * DM; bidx = row >> 12; } else { src = xc + (size_t)(row - ML) * DM; bidx = 8; }
        const f32x4* xr = (const f32x4*)src + lane;
        f32x4 v[4]; float s = 0.f;
#pragma unroll
        for (int j = 0; j < 4; ++j) v[j] = xr[64 * j];
        if (row >= ML && npart > 0) {
            f32x4 ps[4];
#pragma unroll
            for (int j = 0; j < 4; ++j) ps[j] = (f32x4){0.f, 0.f, 0.f, 0.f};
            for (int kc = 0; kc < npart; ++kc) { const f32x4* pr = (const f32x4*)(part + ((size_t)kc * MC + (row - ML)) * DM) + lane;
#pragma unroll
                for (int j = 0; j < 4; ++j) ps[j] += pr[64 * j]; }
            f32x4* wr_ = (f32x4*)(ctxr_rw + (size_t)(row - ML) * DM) + lane;
#pragma unroll
            for (int j = 0; j < 4; ++j) { v[j] += *(const f32x4*)(pgate + 4 * (lane + 64 * j)) * ps[j]; wr_[64 * j] = v[j]; }
        }
#pragma unroll
        for (int j = 0; j < 4; ++j) s += (v[j][0] * v[j][0] + v[j][1] * v[j][1]) + (v[j][2] * v[j][2] + v[j][3] * v[j][3]);
        const float rstd = __builtin_amdgcn_rsqf(wave_sum(s) * (1.0f / DM) + EPSN);
        const float* shp = mods_l + (size_t)bidx * 6144 + sidx * DM; const float* scp = shp + DM;
        u32x2* o8 = (u32x2*)(HN + (size_t)row * DM) + lane;
#pragma unroll
        for (int j = 0; j < 4; ++j) { const int col = 4 * (lane + 64 * j);
            const f32x4 g = *(const f32x4*)(gain + col), sh = *(const f32x4*)(shp + col), sc = *(const f32x4*)(scp + col);
            const f32x4 y = v[j] * rstd * g * (sc + 1.0f) + sh;
            u32x2 w; w.x = pk2(y[0], y[1]); w.y = pk2(y[2], y[3]); o8[64 * j] = w; }
    }
}

template <bool CTXQ>
__device__ __forceinline__ void attn_task(const bf16_t* QO, bf16_t* OO, const bf16_t* Kb, const bf16_t* VT, const float* rpb, int lane, int task) {
    constexpr int G0 = CTXQ ? 8 : 0;
    const int q = lane & 15, g = lane >> 4;
    int cb, r, h, b, q0, ks, rs; size_t qrow;
    if (CTXQ) { const int qb = task & 15; h = (task >> 4) & 15; b = task >> 8; cb = 0; r = 0; q0 = 0; ks = 0; rs = 0; qrow = (size_t)ML + b * CTXL + qb * 16 + q; }
    else { cb = task & 3; r = (task >> 2) & 63; h = (task >> 8) & 15; b = task >> 12; q0 = cb * 16; ks = min(max(q0 - 8, 0), 32); rs = min(max(r - 4, 0), 56); qrow = (size_t)b * SEQ + r * 64 + q0 + q; }
    const bf16x8 qf0 = *(const bf16x8*)(QO + qrow * DM + h * 64 + 8 * g), qf1 = *(const bf16x8*)(QO + qrow * DM + h * 64 + 32 + 8 * g);
    const int qcol = q0 + q, wstart = min(max(qcol - 8, 0), 48);
    const float* rp = rpb + h * 465;
    const int koff = 8 * (q >> 2) + (q & 3);
    f32x4 S[16][2];
#pragma unroll
    for (int grp = G0; grp < 16; ++grp) {
        const size_t base = grp < 8 ? (size_t)b * SEQ + (rs + grp) * 64 + ks : (size_t)ML + b * CTXL + 32 * (grp - 8);
#pragma unroll
        for (int T = 0; T < 2; ++T) {
            const bf16_t* kp = Kb + (base + koff + 4 * T) * DM + h * 64 + 8 * g;
            const bf16x8 kf0 = *(const bf16x8*)kp, kf1 = *(const bf16x8*)(kp + 32);
            f32x4 s = {0.f, 0.f, 0.f, 0.f};
            s = mfma16(kf0, qf0, s); s = mfma16(kf1, qf1, s);
            if (grp < 8) {
                const int drow = rs + grp - r + 7;
#pragma unroll
                for (int j = 0; j < 4; ++j) { const int kcol = ks + 8 * g + 4 * T + j; const bool ok = (kcol >= wstart) && (kcol < wstart + 16);
                    const int dcol = min(max(kcol - qcol + 15, 0), 30);
                    const float bias = rp[drow * 31 + dcol];
                    s[j] = ok ? s[j] + bias : -1e30f; }
            }
            S[grp][T] = s;
        }
    }
    float mx = -1e30f;
#pragma unroll
    for (int grp = G0; grp < 16; ++grp)
#pragma unroll
        for (int T = 0; T < 2; ++T) mx = fmaxf(mx, fmaxf(fmaxf(S[grp][T][0], S[grp][T][1]), fmaxf(S[grp][T][2], S[grp][T][3])));
    mx = fmaxf(mx, __shfl_xor(mx, 16)); mx = fmaxf(mx, __shfl_xor(mx, 32));
    float sum = 0.f;
#pragma unroll
    for (int grp = G0; grp < 16; ++grp)
#pragma unroll
        for (int T = 0; T < 2; ++T) {
#pragma unroll
            for (int j = 0; j < 4; ++j) { const float p = __expf(S[grp][T][j] - mx); S[grp][T][j] = p; sum += p; } }
    sum += __shfl_xor(sum, 16); sum += __shfl_xor(sum, 32);
    f32x4 O[4];
#pragma unroll
    for (int dt = 0; dt < 4; ++dt) O[dt] = (f32x4){0.f, 0.f, 0.f, 0.f};
#pragma unroll
    for (int grp = G0; grp < 16; ++grp) {
        const size_t base = grp < 8 ? (size_t)b * SEQ + (rs + grp) * 64 + ks : (size_t)ML + b * CTXL + 32 * (grp - 8);
        u32x4 pw; pw.x = pk2(S[grp][0][0], S[grp][0][1]); pw.y = pk2(S[grp][0][2], S[grp][0][3]); pw.z = pk2(S[grp][1][0], S[grp][1][1]); pw.w = pk2(S[grp][1][2], S[grp][1][3]);
        const bf16x8 pf = __builtin_bit_cast(bf16x8, pw);
#pragma unroll
        for (int dt = 0; dt < 4; ++dt) {
            const bf16x8 vf = *(const bf16x8*)(VT + (size_t)(h * 64 + 16 * dt + q) * MT + base + 8 * g);
            O[dt] = mfma16(vf, pf, O[dt]);
        }
        if (grp & 1) __builtin_amdgcn_sched_barrier(0);
    }
    const float inv = __builtin_amdgcn_rcpf(sum);
#pragma unroll
    for (int dt = 0; dt < 4; ++dt) { u32x2 w; w.x = pk2(O[dt][0] * inv, O[dt][1] * inv); w.y = pk2(O[dt][2] * inv, O[dt][3] * inv);
        *(u32x2*)(OO + qrow * DM + h * 64 + 16 * dt + 4 * g) = w; }
}
constexpr int AT_PITCH = 144;
template <bool CTXQ>
__device__ __forceinline__ void attn_super(const bf16_t* QO, bf16_t* OO, const bf16_t* Kb, const bf16_t* VT, const float* rpb, LAS unsigned char* lds, int tid_, int lane_, int wave, int st) {
    constexpr int G0 = CTXQ ? 8 : 0, I0 = CTXQ ? 9 : 0;
    const int tid = opaque_tid(), lane = tid & 63;
    const int q = lane & 15, g = lane >> 4;
    int b, h, r = 0, q0 = 0, ks = 0, rs = 0, kbase = 0, krl0 = 0; size_t qrow;
    if (CTXQ) { const int hf = st & 1; h = (st >> 1) & 15; b = st >> 5; qrow = (size_t)ML + b * CTXL + hf * 128 + wave * 16 + q; }
    else { const int rp = st & 31; h = (st >> 5) & 15; b = st >> 9; r = 2 * rp + (wave >> 2); q0 = (wave & 3) * 16; ks = min(max(q0 - 8, 0), 32); rs = min(max(r - 4, 0), 56);
        kbase = min(min(max(2 * rp - 4, 0), 56), 55); krl0 = rs - kbase; qrow = (size_t)b * SEQ + r * 64 + q0 + q; }
    u32x4 stg[13];
#pragma unroll
    for (int i = I0; i < 13; ++i) { const int c = tid + 512 * i, t = c >> 3, cc = c & 7;
        const size_t urow = t < 576 ? (size_t)b * SEQ + kbase * 64 + t : (size_t)ML + b * CTXL + (t - 576);
        stg[i] = *(const u32x4*)(Kb + urow * DM + h * 64 + cc * 8); }
    const bf16x8 qf0 = *(const bf16x8*)(QO + qrow * DM + h * 64 + 8 * g), qf1 = *(const bf16x8*)(QO + qrow * DM + h * 64 + 32 + 8 * g);
    LAS float* rpl = (LAS float*)(lds + 832 * AT_PITCH);
    if (!CTXQ) { if (tid < 465) rpl[tid] = rpb[h * 465 + tid]; }
#pragma unroll
    for (int i = I0; i < 13; ++i) { const int c = tid + 512 * i, t = c >> 3, cc = c & 7; *(LAS u32x4*)(lds + t * AT_PITCH + cc * 16) = stg[i]; }
    __syncthreads();
    const int qcol = q0 + q, wstart = min(max(qcol - 8, 0), 48);
    const int koff = 8 * (q >> 2) + (q & 3);
    f32x4 S[16][2];
#pragma unroll
    for (int grp = G0; grp < 16; ++grp) {
        const int tb = grp < 8 ? (krl0 + grp) * 64 + ks : 576 + 32 * (grp - 8);
#pragma unroll
        for (int T = 0; T < 2; ++T) {
            const LAS unsigned char* kp = lds + (tb + koff + 4 * T) * AT_PITCH + g * 16;
            const bf16x8 kf0 = *(const LAS bf16x8*)kp, kf1 = *(const LAS bf16x8*)(kp + 64);
            f32x4 s = {0.f, 0.f, 0.f, 0.f};
            s = mfma16(kf0, qf0, s); s = mfma16(kf1, qf1, s);
            if (grp < 8) {
                const int drow = rs + grp - r + 7;
#pragma unroll
                for (int j = 0; j < 4; ++j) { const int kcol = ks + 8 * g + 4 * T + j; const bool ok = (kcol >= wstart) && (kcol < wstart + 16);
                    const int dcol = min(max(kcol - qcol + 15, 0), 30);
                    const float bias = rpl[drow * 31 + dcol];
                    s[j] = ok ? s[j] + bias : -1e30f; }
            }
            S[grp][T] = s;
        }
        __builtin_amdgcn_sched_barrier(0);
    }
    __syncthreads();
    float mx = -1e30f;
#pragma unroll
    for (int grp = G0; grp < 16; ++grp)
#pragma unroll
        for (int T = 0; T < 2; ++T) mx = fmaxf(mx, fmaxf(fmaxf(S[grp][T][0], S[grp][T][1]), fmaxf(S[grp][T][2], S[grp][T][3])));
    mx = fmaxf(mx, __shfl_xor(mx, 16)); mx = fmaxf(mx, __shfl_xor(mx, 32));
    float sum = 0.f;
    u32x4 P[16];
#pragma unroll
    for (int grp = G0; grp < 16; ++grp) {
        float p[8];
#pragma unroll
        for (int T = 0; T < 2; ++T)
#pragma unroll
            for (int j = 0; j < 4; ++j) { p[4 * T + j] = __builtin_amdgcn_exp2f((S[grp][T][j] - mx) * 1.4426950408889634f); sum += p[4 * T + j]; }
        P[grp].x = pk2(p[0], p[1]); P[grp].y = pk2(p[2], p[3]); P[grp].z = pk2(p[4], p[5]); P[grp].w = pk2(p[6], p[7]);
        __builtin_amdgcn_sched_barrier(0);
    }
    sum += __shfl_xor(sum, 16); sum += __shfl_xor(sum, 32);
#pragma unroll
    for (int i = I0; i < 13; ++i) { const int d = (tid >> 3) & 63, cc = tid & 7;
        const size_t tokb = i < 9 ? (size_t)b * SEQ + (kbase + i) * 64 : (size_t)ML + b * CTXL + (i - 9) * 64;
        stg[i] = *(const u32x4*)(VT + (size_t)(h * 64 + d) * MT + tokb + cc * 8); }
#pragma unroll
    for (int i = I0; i < 13; ++i) { const int d = (tid >> 3) & 63, cc = tid & 7; *(LAS u32x4*)(lds + (i * 64 + d) * AT_PITCH + cc * 16) = stg[i]; }
    __syncthreads();
    f32x4 O[4];
#pragma unroll
    for (int dt = 0; dt < 4; ++dt) O[dt] = (f32x4){0.f, 0.f, 0.f, 0.f};
#pragma unroll
    for (int grp = G0; grp < 16; ++grp) {
        const int blk = grp < 8 ? krl0 + grp : 9 + ((grp - 8) >> 1), col = grp < 8 ? ks : 32 * ((grp - 8) & 1);
        const bf16x8 pf = __builtin_bit_cast(bf16x8, P[grp]);
#pragma unroll
        for (int dt = 0; dt < 4; ++dt) {
            const bf16x8 vf = *(const LAS bf16x8*)(lds + (blk * 64 + 16 * dt + q) * AT_PITCH + (col + 8 * g) * 2);
            O[dt] = mfma16(vf, pf, O[dt]);
        }
        if (grp & 1) __builtin_amdgcn_sched_barrier(0);
    }
    const float inv = __builtin_amdgcn_rcpf(sum);
#pragma unroll
    for (int dt = 0; dt < 4; ++dt) { u32x2 w; w.x = pk2(O[dt][0] * inv, O[dt][1] * inv); w.y = pk2(O[dt][2] * inv, O[dt][3] * inv);
        *(u32x2*)(OO + qrow * DM + h * 64 + 16 * dt + 4 * g) = w; }
    __syncthreads();
}
__device__ __forceinline__ void attn_phase(const bf16_t* QO, bf16_t* OO, const bf16_t* Kb, const bf16_t* VT, const float* rpb, LAS unsigned char* lds, int tid, int lane, int wave, int G) {
    const int bid = opaque_bid();
    if (G == 256) {
        const int x = bid & 7, c = bid >> 3;
        for (int it = 0; it < 16; ++it) attn_super<false>(QO, OO, Kb, VT, rpb, lds, tid, lane, wave, ((it * 8 + x) << 5) | c);
        attn_super<true>(QO, OO, Kb, VT, rpb, lds, tid, lane, wave, ((((c >> 1) * 8) + x) << 1) | (c & 1));
    } else {
        for (int st = bid; st < 4096; st += G) attn_super<false>(QO, OO, Kb, VT, rpb, lds, tid, lane, wave, st);
        for (int st = bid; st < 256; st += G) attn_super<true>(QO, OO, Kb, VT, rpb, lds, tid, lane, wave, st);
    }
}

__device__ __forceinline__ void lconv_phase(const bf16_t* REC, bf16_t* XR, const float* cw, const float* cbias, int tid, int G) {
#pragma unroll 1
    for (int it = opaque_bid() * 512 + tid; it < MT * 128; it += G * 512) { asm volatile("" : "+v"(it));
        const int row = it >> 7, ch = (it & 127) * 8;
        int pos, len; if (row < ML) { pos = row & (SEQ - 1); len = SEQ; } else { pos = (row - ML) & (CTXL - 1); len = CTXL; }
        float acc[8];
        { const f32x4 b0 = *(const f32x4*)(cbias + ch), b1 = *(const f32x4*)(cbias + ch + 4);
#pragma unroll
          for (int e = 0; e < 4; ++e) { acc[e] = b0[e]; acc[4 + e] = b1[e]; } }
#pragma unroll
        for (int k = 0; k < 4; ++k) { const int t = pos + k - 2;
            if (t >= 0 && t < len) {
                const u32x4 v = *(const u32x4*)(REC + (size_t)(row + k - 2) * DM + ch);
                const f32x4 w0 = *(const f32x4*)(cw + k * DM + ch), w1 = *(const f32x4*)(cw + k * DM + ch + 4);
                acc[0] += w0[0] * bflo(v.x); acc[1] += w0[1] * bfhi(v.x); acc[2] += w0[2] * bflo(v.y); acc[3] += w0[3] * bfhi(v.y);
                acc[4] += w1[0] * bflo(v.z); acc[5] += w1[1] * bfhi(v.z); acc[6] += w1[2] * bflo(v.w); acc[7] += w1[3] * bfhi(v.w);
            } }
        u32x4 o; o.x = pk2(acc[0], acc[1]); o.y = pk2(acc[2], acc[3]); o.z = pk2(acc[4], acc[5]); o.w = pk2(acc[6], acc[7]);
        *(u32x4*)(XR + (size_t)row * DM + ch) = o;
    }
}

template <int DIR, bool APPLY>
__device__ __forceinline__ void lru_sweep(const bf16_t* XR, const bf16_t* GATE, bf16_t* YP, const bf16_t* bdw_dir, float bias_r, float bias_i, float sp,
                                          int row0, int n, int half, int lane, float& hcar, float& ptot, unsigned (&hsf)[4][8]) {
    const int e = lane & 31, hh = lane >> 5;
    const int tau = 16 * ((e >> 2) & 1) + (e & 3) + 4 * (e >> 3);
    bf16x8 Br[4], Bi[4];
    const bf16_t* wrp = bdw_dir + (size_t)n * 4096 + (half * 32 + e) * 64 + 8 * hh;
    const bf16_t* wip = wrp + 16 * 4096;
#pragma unroll
    for (int kk = 0; kk < 4; ++kk) { Br[kk] = *(const bf16x8*)(wrp + 16 * kk); Bi[kk] = *(const bf16x8*)(wip + 16 * kk); }
    bf16x8 I0, I1;
#pragma unroll
    for (int jj = 0; jj < 8; ++jj) { I0[jj] = (8 * hh + jj == e) ? (short)0x3F80 : (short)0; I1[jj] = (16 + 8 * hh + jj == e) ? (short)0x3F80 : (short)0; }
    const bool first = (hh == DIR);
    const int chcol = n * 64 + half * 32;
    const float spm = -8.0f * 1.4426950408889634f * sp;
#pragma unroll
    for (int tt = 0; tt < 4; ++tt) {
        const int tile = DIR == 0 ? tt : 3 - tt; const int trow = row0 + tile * 32;
        const bf16_t* ap = XR + (size_t)(trow + tau) * DM + n * 64 + 8 * hh;
        bf16x8 A[4];
#pragma unroll
        for (int kk = 0; kk < 4; ++kk) A[kk] = *(const bf16x8*)(ap + 16 * kk);
        f32x16 ar, ai, xv;
#pragma unroll
        for (int r = 0; r < 16; ++r) { ar[r] = 0.f; ai[r] = 0.f; xv[r] = 0.f; }
#pragma unroll
        for (int kk = 0; kk < 4; ++kk) { ar = mfma32(A[kk], Br[kk], ar); ai = mfma32(A[kk], Bi[kk], ai); }
        const bf16x8 Ax0 = half ? A[2] : A[0], Ax1 = half ? A[3] : A[1];
        xv = mfma32(Ax0, I0, xv); xv = mfma32(Ax1, I1, xv);
        f32x16 av, bv;
#pragma unroll
        for (int r = 0; r < 16; ++r) {
            const float rg = sigmoidf_(ar[r] + bias_r), ig = sigmoidf_(ai[r] + bias_i);
            const float aa = __builtin_amdgcn_exp2f(rg * spm);
            av[r] = aa; bv[r] = __builtin_amdgcn_sqrtf(fmaxf(1.0f - aa * aa, 0.f)) * ig * xv[r];
        }
        float Hl = 0.f, Pl = 1.f;
#pragma unroll
        for (int rr = 0; rr < 16; ++rr) { const int r = DIR == 0 ? rr : 15 - rr; Hl = av[r] * Hl + bv[r]; Pl *= av[r]; }
        const float val = Hl + Pl * hcar, got = __shfl_xor(val, 32);
        const float start = first ? hcar : got;
        float endv;
        f32x16 hs;
        if (APPLY) {
            float hcur = start;
#pragma unroll
            for (int rr = 0; rr < 16; ++rr) { const int r = DIR == 0 ? rr : 15 - rr; hcur = av[r] * hcur + bv[r]; hs[r] = hcur; }
            endv = hcur;
        } else { endv = Hl + Pl * start; }
        const float got2 = __shfl_xor(endv, 32);
        hcar = first ? got2 : endv;
        if (!APPLY) ptot *= Pl * __shfl_xor(Pl, 32);
        if (APPLY) {
            if (DIR == 0) {
#pragma unroll
                for (int r2 = 0; r2 < 8; ++r2) hsf[tile][r2] = pk2(hs[2 * r2], hs[2 * r2 + 1]);
            }
            else {
                const bf16_t* gp = GATE + (size_t)(trow + tau) * DM + chcol + 8 * hh;
                const bf16x8 G0 = *(const bf16x8*)gp, G1 = *(const bf16x8*)(gp + 16);
                f32x16 gv;
#pragma unroll
                for (int r = 0; r < 16; ++r) gv[r] = 0.f;
                gv = mfma32(G0, I0, gv); gv = mfma32(G1, I1, gv);
                bf16_t* yp = YP + (size_t)(trow + 16 * hh) * DM + chcol + e;
#pragma unroll
                for (int r = 0; r < 16; ++r) { const float x = gv[r], u2 = 1.5957691216f * (x + 0.044715f * x * x * x);
                    const float hf = (r & 1) ? bfhi(hsf[tile][r >> 1]) : bflo(hsf[tile][r >> 1]);
                    const float y = (hf + hs[r]) * x * sigmoidf_(u2);
                    yp[(size_t)r * DM] = (bf16_t)f2bf(y); }
            }
        }
    }
}
template <bool APPLY>
__device__ __forceinline__ void lru_phase(const bf16_t* XR, const bf16_t* GATE, bf16_t* YP, const bf16_t* bdw_j, const float* ga_b, const float* gx_b, const float* lam, float* SUM,
                                          int lane, int gw, int NGW) {
    for (int task = gw; task < NB * NCHUNK * 32; task += NGW) {
        const int n2 = task & 31, c = (task >> 5) % NCHUNK, b = task / (32 * NCHUNK);
        const int row0 = c < 2 ? ML + b * CTXL + c * 128 : b * SEQ + (c - 2) * 128;
        const int n = n2 >> 1, half = n2 & 1, ch = n2 * 32 + (lane & 31);
        unsigned hsf[4][8];
#pragma unroll
        for (int dir = 0; dir < 2; ++dir) {
            const float bias_r = ga_b[dir * DM + ch], bias_i = gx_b[dir * DM + ch];
            const float sp = log1pf(__expf(-lam[dir * DM + ch]));
            const int p = dir == 0 ? c : (c < 2 ? 1 - c : 35 - c);
            float* sump = SUM + ((size_t)(dir * NB + b) * NCHUNK) * DM * 2 + (size_t)ch * 2;
            float hcar = 0.f, ptot = 1.f;
            if (APPLY) { for (int pp = 0; pp < p; ++pp) { const float2 ph = *(const float2*)(sump + (size_t)pp * DM * 2); hcar = ph.x * hcar + ph.y; } }
            if (dir == 0) lru_sweep<0, APPLY>(XR, GATE, YP, bdw_j, bias_r, bias_i, sp, row0, n, half, lane, hcar, ptot, hsf);
            else lru_sweep<1, APPLY>(XR, GATE, YP, bdw_j + 2 * 16 * 4096, bias_r, bias_i, sp, row0, n, half, lane, hcar, ptot, hsf);
            if (!APPLY) { if (lane < 32) *(float2*)(sump + (size_t)p * DM * 2) = make_float2(ptot, hcar); }
        }
    }
}

template <int DIR>
__device__ __forceinline__ void lru_dir(const bf16_t* XR, const bf16_t* GATE, bf16_t* YP, u32x4* HSF, const bf16_t* bdw_dir, float bias_r, float bias_i, float sp,
                                        int b, int n2, int lane, int wave, LAS float* xl) {
    const int e = lane & 31, hh = lane >> 5, n = n2 >> 1, half = n2 & 1;
    const int tau = 16 * ((e >> 2) & 1) + (e & 3) + 4 * (e >> 3);
    bf16x8 Br[4], Bi[4];
    const bf16_t* wrp = bdw_dir + (size_t)n * 4096 + (half * 32 + e) * 64 + 8 * hh;
    const bf16_t* wip = wrp + 16 * 4096;
#pragma unroll
    for (int kk = 0; kk < 4; ++kk) { Br[kk] = *(const bf16x8*)(wrp + 16 * kk); Bi[kk] = *(const bf16x8*)(wip + 16 * kk); }
    bf16x8 I0, I1;
#pragma unroll
    for (int jj = 0; jj < 8; ++jj) { I0[jj] = (8 * hh + jj == e) ? (short)0x3F80 : (short)0; I1[jj] = (16 + 8 * hh + jj == e) ? (short)0x3F80 : (short)0; }
    const bool first = (hh == DIR);
    const int chcol = n * 64 + half * 32;
    const float spm = -8.0f * 1.4426950408889634f * sp;
    float segcar = 0.f;
#pragma unroll 1
    for (int seg = 0; seg < 9; ++seg) {
        f32x16 av[2], bv[2]; float Hl[2], Pl[2]; int trow[2]; bool valid[2];
        float hloc = 0.f, ploc = 1.f;
#pragma unroll
        for (int k = 0; k < 2; ++k) {
            const int q = seg * 16 + wave * 2 + k; valid[k] = q < 136;
            const int T = DIR == 0 ? q : (q < 8 ? 7 - q : 143 - q);
            trow[k] = T < 8 ? ML + b * CTXL + 32 * T : b * SEQ + 32 * (T - 8);
            if (valid[k]) {
                const bf16_t* ap = XR + (size_t)(trow[k] + tau) * DM + n * 64 + 8 * hh;
                bf16x8 A[4];
#pragma unroll
                for (int kk = 0; kk < 4; ++kk) A[kk] = *(const bf16x8*)(ap + 16 * kk);
                f32x16 ar, ai, xv;
#pragma unroll
                for (int r = 0; r < 16; ++r) { ar[r] = 0.f; ai[r] = 0.f; xv[r] = 0.f; }
#pragma unroll
                for (int kk = 0; kk < 4; ++kk) { ar = mfma32(A[kk], Br[kk], ar); ai = mfma32(A[kk], Bi[kk], ai); }
                const bf16x8 Ax0 = half ? A[2] : A[0], Ax1 = half ? A[3] : A[1];
                xv = mfma32(Ax0, I0, xv); xv = mfma32(Ax1, I1, xv);
#pragma unroll
                for (int r = 0; r < 16; ++r) {
                    const float rg = sigmoidf_(ar[r] + bias_r), ig = sigmoidf_(ai[r] + bias_i);
                    const float aa = __builtin_amdgcn_exp2f(rg * spm);
                    av[k][r] = aa; bv[k][r] = __builtin_amdgcn_sqrtf(fmaxf(1.0f - aa * aa, 0.f)) * ig * xv[r];
                }
            } else {
#pragma unroll
                for (int r = 0; r < 16; ++r) { av[k][r] = 1.0f; bv[k][r] = 0.0f; }
            }
            float H = 0.f, P = 1.f;
#pragma unroll
            for (int rr = 0; rr < 16; ++rr) { const int r = DIR == 0 ? rr : 15 - rr; H = av[k][r] * H + bv[k][r]; P *= av[k][r]; }
            Hl[k] = H; Pl[k] = P;
            const float val = H + P * hloc, got = __shfl_xor(val, 32);
            const float st2 = first ? hloc : got;
            const float endv = H + P * st2, got2 = __shfl_xor(endv, 32);
            hloc = first ? got2 : endv;
            ploc *= P * __shfl_xor(P, 32);
        }
        LAS float* slot = xl + ((seg & 1) * 8 + wave) * 64 + e * 2;
        if (lane < 32) { slot[0] = ploc; slot[1] = hloc; }
        __syncthreads();
        float c = segcar, hcar = segcar;
#pragma unroll
        for (int w = 0; w < 8; ++w) { const LAS float* sp_ = xl + ((seg & 1) * 8 + w) * 64 + e * 2; const float P = sp_[0], H = sp_[1]; if (w == wave) hcar = c; c = P * c + H; }
        segcar = c;
#pragma unroll
        for (int k = 0; k < 2; ++k) {
            if (valid[k]) {
                const float val = Hl[k] + Pl[k] * hcar, got = __shfl_xor(val, 32);
                float hcur = first ? hcar : got;
                f32x16 hs;
#pragma unroll
                for (int rr = 0; rr < 16; ++rr) { const int r = DIR == 0 ? rr : 15 - rr; hcur = av[k][r] * hcur + bv[k][r]; hs[r] = hcur; }
                const float got2 = __shfl_xor(hcur, 32);
                hcar = first ? got2 : hcur;
                const int tg = trow[k] < ML ? (trow[k] >> 12) * 136 + 8 + ((trow[k] & (SEQ - 1)) >> 5) : b * 136 + ((trow[k] - ML - b * CTXL) >> 5);
                u32x4* hp = HSF + (((size_t)tg * 32 + n2) * 64 + lane) * 2;
                if (DIR == 0) {
                    u32x4 w0, w1;
                    w0.x = pk2(hs[0], hs[1]); w0.y = pk2(hs[2], hs[3]); w0.z = pk2(hs[4], hs[5]); w0.w = pk2(hs[6], hs[7]);
                    w1.x = pk2(hs[8], hs[9]); w1.y = pk2(hs[10], hs[11]); w1.z = pk2(hs[12], hs[13]); w1.w = pk2(hs[14], hs[15]);
                    hp[0] = w0; hp[1] = w1;
                } else {
                    const u32x4 w0 = hp[0], w1 = hp[1];
                    const unsigned hw[8] = {w0.x, w0.y, w0.z, w0.w, w1.x, w1.y, w1.z, w1.w};
                    const bf16_t* gp = GATE + (size_t)(trow[k] + tau) * DM + chcol + 8 * hh;
                    const bf16x8 G0 = *(const bf16x8*)gp, G1 = *(const bf16x8*)(gp + 16);
                    f32x16 gv;
#pragma unroll
                    for (int r = 0; r < 16; ++r) gv[r] = 0.f;
                    gv = mfma32(G0, I0, gv); gv = mfma32(G1, I1, gv);
                    bf16_t* yp = YP + (size_t)(trow[k] + 16 * hh) * DM + chcol + e;
#pragma unroll
                    for (int r = 0; r < 16; ++r) { const float x = gv[r], u2 = 1.5957691216f * (x + 0.044715f * x * x * x);
                        const float hf = (r & 1) ? bfhi(hw[r >> 1]) : bflo(hw[r >> 1]);
                        const float y = (hf + hs[r]) * x * sigmoidf_(u2);
                        yp[(size_t)r * DM] = (bf16_t)f2bf(y); }
                }
            }
        }
    }
}
__device__ __forceinline__ void lru_block_phase(const bf16_t* XR, const bf16_t* GATE, bf16_t* YP, u32x4* HSF, const bf16_t* bdw_j, const float* ga_b, const float* gx_b, const float* lam,
                                                LAS unsigned char* lds, int lane, int wave, int G) {
    LAS float* xl = (LAS float*)lds;
    for (int item = opaque_bid(); item < NB * 32; item += G) {
        const int b = item >> 5, n2 = item & 31, ch = n2 * 32 + (lane & 31);
        { const float bias_r = ga_b[ch], bias_i = gx_b[ch], sp = log1pf(__expf(-lam[ch]));
          lru_dir<0>(XR, GATE, YP, HSF, bdw_j, bias_r, bias_i, sp, b, n2, lane, wave, xl); }
        __syncthreads();
        { const float bias_r = ga_b[DM + ch], bias_i = gx_b[DM + ch], sp = log1pf(__expf(-lam[DM + ch]));
          lru_dir<1>(XR, GATE, YP, HSF, bdw_j + 2 * 16 * 4096, bias_r, bias_i, sp, b, n2, lane, wave, xl); }
        __syncthreads();
    }
}

__device__ __forceinline__ void fconv_phase(const bf16_t* U, bf16_t* Gb, const float* cw, const float* cbias, int rbeg, int nrows, int tid, int G) {
    const int total = nrows * 384;
#pragma unroll 1
    for (int it = opaque_bid() * 512 + tid; it < total; it += G * 512) { asm volatile("" : "+v"(it));
        const int r = it / 384, ch = (it % 384) * 8, row = rbeg + r;
        int pos, len; if (row < ML) { pos = row & (SEQ - 1); len = SEQ; } else { pos = (row - ML) & (CTXL - 1); len = CTXL; }
        float va[8], ga[8];
        { const f32x4 b0 = *(const f32x4*)(cbias + ch), b1 = *(const f32x4*)(cbias + ch + 4), c0 = *(const f32x4*)(cbias + DFF + ch), c1 = *(const f32x4*)(cbias + DFF + ch + 4);
#pragma unroll
          for (int e = 0; e < 4; ++e) { va[e] = b0[e]; va[4 + e] = b1[e]; ga[e] = c0[e]; ga[4 + e] = c1[e]; } }
#pragma unroll
        for (int k = 0; k < 3; ++k) { const int t = pos + k - 1;
            if (t >= 0 && t < len) {
                const bf16_t* up = U + (size_t)(r + k - 1) * 6144 + ch;
                const u32x4 v = *(const u32x4*)up, gq = *(const u32x4*)(up + DFF);
                const float* wp = cw + (size_t)k * 6144 + ch;
                const f32x4 w0 = *(const f32x4*)wp, w1 = *(const f32x4*)(wp + 4), x0 = *(const f32x4*)(wp + DFF), x1 = *(const f32x4*)(wp + DFF + 4);
                va[0] += w0[0] * bflo(v.x); va[1] += w0[1] * bfhi(v.x); va[2] += w0[2] * bflo(v.y); va[3] += w0[3] * bfhi(v.y);
                va[4] += w1[0] * bflo(v.z); va[5] += w1[1] * bfhi(v.z); va[6] += w1[2] * bflo(v.w); va[7] += w1[3] * bfhi(v.w);
                ga[0] += x0[0] * bflo(gq.x); ga[1] += x0[1] * bfhi(gq.x); ga[2] += x0[2] * bflo(gq.y); ga[3] += x0[3] * bfhi(gq.y);
                ga[4] += x1[0] * bflo(gq.z); ga[5] += x1[1] * bfhi(gq.z); ga[6] += x1[2] * bflo(gq.w); ga[7] += x1[3] * bfhi(gq.w);
            } }
        float o[8];
#pragma unroll
        for (int e = 0; e < 8; ++e) o[e] = va[e] * ga[e] * sigmoidf_(ga[e]);
        u32x4 w; w.x = pk2(o[0], o[1]); w.y = pk2(o[2], o[3]); w.z = pk2(o[4], o[5]); w.w = pk2(o[6], o[7]);
        *(u32x4*)(Gb + (size_t)r * DFF + ch) = w;
    }
}

template <int OP>
__device__ __forceinline__ void run_op(const Args& a, LAS unsigned char* lds, const int li, const int arg, const int rep) {
    const int tid = opaque_tid(), lane = tid & 63, wave = __builtin_amdgcn_readfirstlane(tid >> 6), G = gridDim.x;
    const int gw = opaque_bid() * 8 + wave, NGW = G * 8;
    unsigned char* ws = a.ws;
    float* MODS = (float*)(ws + WS_MODS);
    float* SUM = (float*)(ws + WS_SUM);
    bf16_t* BDW = (bf16_t*)(ws + WS_BDW);
    float* CTXR = (float*)(ws + WS_CTXR);
    bf16_t* WB = (bf16_t*)(ws + WS_WB);
    bf16_t* HN = (bf16_t*)(ws + WS_HN);
    bf16_t* RR = (bf16_t*)(ws + WS_R);
    const int j = li >> 1;
    const float* mods_l = MODS + (size_t)li * 9 * 6144;
    if constexpr (OP == OP_PRO) {
        prologue(a, lds, tid, lane, wave, G);
    } else if constexpr (OP == OP_NORM) {
        const bool first = (li == 0 && arg == 0);
        const float* gain = (arg ? a.in[7] : a.in[6]) + (size_t)li * DM;
        const int nrows = (arg == 1 && li == 3) ? ML : MT;
        const int npart = first ? 0 : (arg == 1 ? (li == 3 ? 0 : 4) : 6);
        const float* pgate = arg == 1 ? mods_l + 8 * 6144 + 2 * DM : MODS + (size_t)(li - 1) * 9 * 6144 + 8 * 6144 + 5 * DM;
        norm_phase(first ? a.in[0] : a.out, CTXR, HN, gain, mods_l, arg * 3, nrows, lane, gw, NGW, CTXR, (const float*)(ws + WS_PART), npart, pgate);
    } else if constexpr (OP == OP_GQK) {
        pg8::Gemm g{HN, WB + (size_t)j * 4 * MEL, MT, 2048, DM, 0, 0};
        pg8::StaticOrder S; S.init(g.M, g.N, G, opaque_bid());
        EpiQK E{RR + R_Q, RR + R_K, a.in[9] + j * HD, a.in[10] + j * HD};
        pg8::gemm_phase<EpiQK, pg8::StaticOrder>(lds, g, S, E);
    } else if constexpr (OP == OP_GST) {
        pg8::Gemm g; EpiStore E; int c = opaque_bid();
        if (arg == 0) { g = pg8::Gemm{WB + (size_t)j * 4 * MEL + 2 * MEL, HN, DM, MT, DM, 0, 0}; E = EpiStore{RR + R_VT, MT, 0, 0}; c = (c + G - (64 % G)) % G; }
        else if (arg == 1) { g = pg8::Gemm{HN, WB + 8 * MEL + (size_t)j * 3 * MEL, MT, 2048, DM, 0, 0}; E = EpiStore{RR + R_GATE, DM, DM, (size_t)MT * DM}; }
        else { const int rbeg = arg == 2 ? 0 : 16384, nrows = arg == 2 ? 16384 : (li == 3 ? 16384 : 18432);
            g = pg8::Gemm{HN + (size_t)rbeg * DM, WB + 14 * MEL + (size_t)li * 9 * MEL, nrows, 6144, DM, 0, 0}; E = EpiStore{RR + R_U, 6144, 0, 0}; }
        pg8::StaticOrder S; S.init(g.M, g.N, G, c);
        pg8::gemm_phase<EpiStore, pg8::StaticOrder>(lds, g, S, E);
    } else if constexpr (OP == OP_GRES) {
        pg8::Gemm g; EpiRes E;
        const bool l0 = (li == 0 && arg == 0);
        E.in_lat = l0 ? a.in[0] : a.out; E.in_ctx = CTXR; E.out_lat = a.out; E.out_ctx = CTXR; E.row_off = 0;
        const bf16_t* Ap; const bf16_t* Bp; int Kd, gidx;
        if (arg == 0) { gidx = 2; Kd = DM;
            if (li & 1) { Ap = RR + R_YP; Bp = WB + 8 * MEL + (size_t)j * 3 * MEL + 2 * MEL; } else { Ap = RR + R_Q; Bp = WB + (size_t)j * 4 * MEL + 3 * MEL; }
        } else { gidx = 5; Kd = DFF; Ap = RR + R_G; Bp = WB + 14 * MEL + (size_t)li * 9 * MEL + 6 * MEL; }
        E.gate = mods_l + gidx * DM;
        g = pg8::Gemm{Ap, Bp, ML, DM, Kd, 0, 0};
        pg8::StaticOrder S; S.init(g.M, g.N, G, opaque_bid());
        pg8::gemm_phase<EpiRes, pg8::StaticOrder>(lds, g, S, E);
        if (li != 3) {
            const int nkc = Kd == DFF ? 6 : 4;
            pg8::Gemm g2{Ap, Bp, MT, DM, Kd / nkc, 0, Kd};
            CtxSplitOrder S2{nkc, G, opaque_bid(), ML / 256};
            EpiPart E2{(float*)(ws + WS_PART)};
            pg8::gemm_phase<EpiPart, CtxSplitOrder>(lds, g2, S2, E2);
        }
    } else if constexpr (OP == OP_GUP) {
        pg8::Gemm g{HN - DM, WB + 14 * MEL + (size_t)li * 9 * MEL, 138 * 256, 6144, DM, 254, 0};
        pg8::StaticOrder S; S.init(g.M, g.N, G, opaque_bid());
        EpiUpConv E{RR + R_G, a.in[23] + (size_t)li * 3 * 6144, a.in[24] + (size_t)li * 6144, (LAS float*)(lds + 132096)};
        pg8::gemm_phase<EpiUpConv, pg8::StaticOrder>(lds, g, S, E);
    } else if constexpr (OP == OP_ATTN) {
        attn_phase(RR + R_Q, rep ? RR + R_YP : RR + R_Q, RR + R_K, RR + R_VT, a.in[11] + (size_t)j * NH * 465, lds, tid, lane, wave, G);
    } else if constexpr (OP == OP_LCONV) {
        lconv_phase(RR + R_REC, RR + R_XR, a.in[14] + (size_t)j * 4 * DM, a.in[15] + (size_t)j * DM, tid, G);
    } else if constexpr (OP == OP_LRUA) {
    } else if constexpr (OP == OP_LRUC) {
        lru_block_phase(RR + R_XR, RR + R_GATE, RR + R_YP, (u32x4*)HN, BDW + (size_t)j * 4 * 16 * 4096, a.in[17] + (size_t)j * 2 * DM, a.in[19] + (size_t)j * 2 * DM, a.in[20] + (size_t)j * 2 * DM, lds, lane, wave, G);
    } else if constexpr (OP == OP_FCONV) {
        const int rbeg = arg == 2 ? 0 : 16384, nrows = arg == 2 ? 16384 : (li == 3 ? 16384 : 18432);
        fconv_phase(RR + R_U, RR + R_G, a.in[23] + (size_t)li * 3 * 6144, a.in[24] + (size_t)li * 6144, rbeg, nrows, tid, G);
    }
}

#ifdef MULTI_LAUNCH
template <int OP> __global__ void __launch_bounds__(512, 2) op_kernel(Args a, int li, int arg) {
    extern __shared__ __attribute__((aligned(16))) unsigned char lds_raw[];
    run_op<OP>(a, (LAS unsigned char*)lds_raw, li, arg, 0);
}
template <int OP> static void launch_op(const Args& a, int li, int arg, int grid, hipStream_t stream) {
    static bool attr = false;
    if (!attr) { (void)hipFuncSetAttribute((const void*)op_kernel<OP>, hipFuncAttributeMaxDynamicSharedMemorySize, LDS_BYTES); attr = true; }
    hipLaunchKernelGGL(op_kernel<OP>, dim3(grid), dim3(512), LDS_BYTES, stream, a, li, arg);
}
#else
__global__ void __launch_bounds__(512, 2) fwd_kernel(Args a) {
    extern __shared__ __attribute__((aligned(16))) unsigned char lds_raw[];
    LAS unsigned char* lds = (LAS unsigned char*)lds_raw;
    cg::grid_group grid = cg::this_grid();
    volatile LAS unsigned* bst = (volatile LAS unsigned*)(lds + 131072 + 64);
    if (threadIdx.x < 4) bst[threadIdx.x] = 0u;
    __syncthreads();
    const XcdBarrier bar = xcd_barrier_post((unsigned*)(a.ws + WS_BAR), bst);
    typedef const __attribute__((address_space(4))) Args* KArgP;
    const int pc_lo = a.pc_lo, pc_hi = a.pc_hi;
    for (int pc = pc_lo; pc < pc_hi; ++pc) {
        const int op = PROG[pc][0], li = PROG[pc][1], arg = PROG[pc][2], sync = PROG[pc][3];
        KArgP kap = (KArgP)__builtin_amdgcn_kernarg_segment_ptr();
        asm volatile("" : "+s"(kap));
        const Args& a = *(const Args*)kap;
        const int rep = (op == OP_ATTN) ? arg : 0;
        switch (op) {
            case OP_PRO: run_op<OP_PRO>(a, lds, li, arg, rep); break;
            case OP_NORM: run_op<OP_NORM>(a, lds, li, arg, rep); break;
            case OP_GQK: run_op<OP_GQK>(a, lds, li, arg, rep); break;
            case OP_GST: run_op<OP_GST>(a, lds, li, arg, rep); break;
            case OP_GRES: run_op<OP_GRES>(a, lds, li, arg, rep); break;
            case OP_ATTN: run_op<OP_ATTN>(a, lds, li, arg, rep); break;
            case OP_LCONV: run_op<OP_LCONV>(a, lds, li, arg, rep); break;
            case OP_LRUA: run_op<OP_LRUA>(a, lds, li, arg, rep); break;
            case OP_LRUC: run_op<OP_LRUC>(a, lds, li, arg, rep); break;
            default: run_op<OP_GUP>(a, lds, li, arg, rep); break;
        }
        if (sync && pc + 1 < pc_hi) { if (pc == 0) grid.sync(); else xcd_barrier(bar); }
    }
}
#endif

extern "C" void kernel_launch(void* const* d_in, const int* in_sizes, int n_in, void* d_out, int out_size, void* d_ws, size_t ws_size, hipStream_t stream) {
    static int grid = 0;
    if (grid == 0) {
        if (n_in != 26 || out_size != ML * DM || ws_size < WS_END) { fprintf(stderr, "kernel_launch: unexpected shapes: n_in %d out %d ws %zu (need %zu)\n", n_in, out_size, ws_size, (size_t)WS_END); grid = -1; return; }
        int dev = 0, cus = 0, per_cu = 1;
        (void)hipGetDevice(&dev);
        (void)hipDeviceGetAttribute(&cus, hipDeviceAttributeMultiprocessorCount, dev);
#ifndef MULTI_LAUNCH
        if (hipFuncSetAttribute((const void*)fwd_kernel, hipFuncAttributeMaxDynamicSharedMemorySize, LDS_BYTES) != hipSuccess) { fprintf(stderr, "kernel_launch: hipFuncSetAttribute failed\n"); grid = -1; return; }
        if (hipOccupancyMaxActiveBlocksPerMultiprocessor(&per_cu, (const void*)fwd_kernel, 512, LDS_BYTES) != hipSuccess || per_cu < 1) { fprintf(stderr, "kernel_launch: occupancy query gave %d\n", per_cu); per_cu = 1; }
        (void)hipGetLastError();
#endif
        grid = cus * per_cu;
        fprintf(stderr, "kernel_launch: grid %d (cus %d x %d), ws %zu\n", grid, cus, per_cu, ws_size);
    }
    if (grid < 0) return;
    Args a{};
    for (int i = 0; i < 26; ++i) a.in[i] = (const float*)d_in[i];
    a.out = (float*)d_out; a.ws = (unsigned char*)d_ws;
    a.pc_lo = 0; a.pc_hi = NPROG;
#ifdef MULTI_LAUNCH
    for (int pc = 0; pc < NPROG; ++pc) {
        const int op = HOSTPROG[pc][0], li = HOSTPROG[pc][1], arg = HOSTPROG[pc][2];
        switch (op) {
            case OP_PRO: launch_op<OP_PRO>(a, li, arg, grid, stream); break;
            case OP_NORM: launch_op<OP_NORM>(a, li, arg, grid, stream); break;
            case OP_GQK: launch_op<OP_GQK>(a, li, arg, grid, stream); break;
            case OP_GST: launch_op<OP_GST>(a, li, arg, grid, stream); break;
            case OP_GRES: launch_op<OP_GRES>(a, li, arg, grid, stream); break;
            case OP_ATTN: launch_op<OP_ATTN>(a, li, arg, grid, stream); break;
            case OP_LCONV: launch_op<OP_LCONV>(a, li, arg, grid, stream); break;
            case OP_LRUA: launch_op<OP_LRUA>(a, li, arg, grid, stream); break;
            case OP_LRUC: launch_op<OP_LRUC>(a, li, arg, grid, stream); break;
            default: launch_op<OP_GUP>(a, li, arg, grid, stream); break;
        }
    }
#else
    (void)hipMemsetAsync((char*)d_ws + WS_BAR, 0, 16384, stream);
    void* args[] = {&a};
    hipError_t e = hipLaunchCooperativeKernel((const void*)fwd_kernel, dim3(grid), dim3(512), args, LDS_BYTES, stream);
    if (e != hipSuccess) fprintf(stderr, "kernel_launch: cooperative launch failed: %s (grid %d)\n", hipGetErrorString(e), grid);
#endif
}
```

```cpp
#include <hip/hip_runtime.h>
#include <hip/hip_cooperative_groups.h>
#include <cstdio>
#include <cstdint>
namespace cg = cooperative_groups;
__device__ __forceinline__ int opaque_tid() { int t; asm volatile("v_mov_b32 %0, %1" : "=v"(t) : "v"((int)threadIdx.x)); return t; }
__device__ __forceinline__ int opaque_bid() { int t; asm volatile("s_mov_b32 %0, %1" : "=s"(t) : "s"((int)blockIdx.x)); return t; }
#define LAS __attribute__((address_space(3)))
namespace pg8 {
#define PG8_LAS __attribute__((address_space(3)))
typedef unsigned short bf16_t;
typedef short bf16x8 __attribute__((ext_vector_type(8)));
typedef float f32x4 __attribute__((ext_vector_type(4)));
typedef unsigned u32x4 __attribute__((ext_vector_type(4)));
constexpr int BM = 256, BK = 64, HALF = 128, HTB = HALF * BK * 2  , STAGE_BYTES = 8 * HTB, NXCD = 8, WGM = 8;

__host__ __device__ __forceinline__ int lds_byte(int r, int c) { const int st = (r >> 4) * 2 + (c >> 5), rr = r & 15, cc = c & 31, ob = rr * 64 + cc * 2; return st * 1024 + (ob ^ (((ob >> 9) & 1) << 5)); }
__host__ __device__ __forceinline__ void stage_rc(int b, int& R, int& C) { const int st = b / 1024, sb = b % 1024, swz = sb ^ (((sb >> 9) & 1) << 5); R = (st >> 1) * 16 + swz / 64; C = (st & 1) * 32 + (swz % 64) / 2; }
__host__ __device__ __forceinline__ int perm32(int rho) { const int n = rho >> 4, i = rho & 15; return 8 * (i >> 2) + 4 * n + (i & 3); }

struct Unit { int pm, pn, kc; };
struct Gemm { const bf16_t* A; const bf16_t* Bt; int M, N, K; int a_step_rows; int ldk; };

struct StaticOrder {
    int nM, nN, nwg, G, c;
    __host__ __device__ void init(int M, int N, int G_, int c_) { nM = M / BM; nN = N / BM; nwg = nM * nN; G = G_; c = c_; }
    __host__ __device__ bool next(int i, Unit& u) const {
        const long L = (long)i * G + c; if (L >= nwg) return false;
        int wgid = (int)L; { const int q = nwg / NXCD, r = nwg % NXCD, xcd = wgid % NXCD, off = wgid / NXCD; wgid = (xcd < r ? xcd * (q + 1) : r * (q + 1) + (xcd - r) * q) + off; }
        const int nig = WGM * nN, gid = wgid / nig, fm = gid * WGM, gsz = (nM - fm) < WGM ? (nM - fm) : WGM;
        u.pm = fm + ((wgid % nig) % gsz); u.pn = (wgid % nig) / gsz; u.kc = 0; return true;
    }
    __device__ __forceinline__ void a_ready(const Unit&) const {}
    __device__ __forceinline__ void done(const Unit&) const {}
};
__device__ __forceinline__ unsigned cvt_pk_bf16(float lo, float hi) { unsigned r; asm volatile("v_cvt_pk_bf16_f32 %0, %1, %2" : "=v"(r) : "v"(lo), "v"(hi)); return r; }
template <class Epi, class Sched>
__device__ __forceinline__ void gemm_phase(PG8_LAS unsigned char* lds, const Gemm g, const Sched& S, const Epi& E) {
    const int tid = opaque_tid(), wid = __builtin_amdgcn_readfirstlane(tid >> 6), lane = tid & 63, wr = wid >> 2, wc = wid & 3, fr = lane & 15, fq = lane >> 4;
    const int K = g.K, nt = K / BK, P = g.ldk ? g.ldk : K;
    unsigned voffA[2], voffB[2];
#pragma unroll
    for (int i = 0; i < 2; ++i) { int R, C; stage_rc(tid * 16 + i * 8192, R, C); const int Rb = Epi::PERM ? ((R & ~31) + perm32(R & 31)) : R;
        voffA[i] = (unsigned)(R * P + C) * 2u; voffB[i] = (unsigned)(Rb * P + C) * 2u; }
    const size_t kstep = (size_t)(BK * 2);
    const size_t hstep = (size_t)HALF * P * 2;
    const size_t tstep = 2 * hstep; const size_t tstepA = g.a_step_rows ? (size_t)g.a_step_rows * P * 2 : tstep; const size_t cstep = (size_t)K * 2;
    const unsigned ldsw = (unsigned)wid * 1024u;
    const int aoff = lds_byte(wr * 64 + fr, fq * 8), boff = lds_byte(wc * 32 + fr, fq * 8);
#define PG8_SA(b, h) (((b) * 2 + (h)) * HTB)
#define PG8_SB(b, h) ((4 + (b) * 2 + (h)) * HTB)
#define PG8_STAGE(bufoff, gbase, voff) do { _Pragma("unroll") for (int _i = 0; _i < 2; ++_i) \
        __builtin_amdgcn_global_load_lds((const unsigned*)((const char*)(gbase) + (voff)[_i]), (PG8_LAS unsigned*)(lds + (bufoff) + ldsw + _i * 8192), 16, 0, 0); } while (0)
#define PG8_LDA(dst, b, h) do { _Pragma("unroll") for (int m = 0; m < 4; ++m) _Pragma("unroll") for (int k = 0; k < 2; ++k) dst[m][k] = *(const PG8_LAS bf16x8*)(lds + PG8_SA(b, h) + aoff + m * 2048 + k * 1024); } while (0)
#define PG8_LDB(dst, b, h) do { _Pragma("unroll") for (int n = 0; n < 2; ++n) _Pragma("unroll") for (int k = 0; k < 2; ++k) dst[n][k] = *(const PG8_LAS bf16x8*)(lds + PG8_SB(b, h) + boff + n * 2048 + k * 1024); } while (0)
#define PG8_MMA(ai, bj, At, Bt) do { __builtin_amdgcn_s_setprio(1); _Pragma("unroll") for (int m = 0; m < 4; ++m) _Pragma("unroll") for (int n = 0; n < 2; ++n) _Pragma("unroll") for (int k = 0; k < 2; ++k) \
        acc[ai][bj][m][n] = __builtin_amdgcn_mfma_f32_16x16x32_bf16(Bt[n][k], At[m][k], acc[ai][bj][m][n], 0, 0, 0); __builtin_amdgcn_s_setprio(0); } while (0)
#define PG8_WAIT_V(n) asm volatile("s_waitcnt vmcnt(" #n ")" ::: "memory")
#define PG8_WAIT_L(n) asm volatile("s_waitcnt lgkmcnt(" #n ")" ::: "memory")
#define PG8_BAR __builtin_amdgcn_s_barrier()
#define PG8_SCHED __builtin_amdgcn_sched_barrier(0)
    Unit cur, nxt; int ui = 0;
    if (!S.next(0, cur)) return;
    f32x4 acc[2][2][4][2];
#pragma unroll
    for (int a = 0; a < 2; ++a)
#pragma unroll
        for (int b = 0; b < 2; ++b)
#pragma unroll
            for (int m = 0; m < 4; ++m)
#pragma unroll
                for (int n = 0; n < 2; ++n) acc[a][b][m][n] = (f32x4){0.f, 0.f, 0.f, 0.f};
    bf16x8 At[4][2], B0[2][2], B1[2][2];
    const char* cA = (const char*)g.A + (size_t)cur.pm * tstepA + (size_t)cur.kc * cstep; const char* cB = (const char*)g.Bt + (size_t)cur.pn * tstep + (size_t)cur.kc * cstep;
    S.a_ready(cur);
    PG8_STAGE(PG8_SB(0, 0), cB, voffB); PG8_STAGE(PG8_SA(0, 0), cA, voffA); PG8_STAGE(PG8_SB(0, 1), cB + hstep, voffB); PG8_STAGE(PG8_SA(0, 1), cA + hstep, voffA);
    if (wr == 1) PG8_BAR;
    PG8_WAIT_V(4); PG8_BAR;
    PG8_STAGE(PG8_SB(1, 0), cB + kstep, voffB); PG8_STAGE(PG8_SA(1, 0), cA + kstep, voffA); PG8_STAGE(PG8_SB(1, 1), cB + hstep + kstep, voffB);
    PG8_WAIT_V(6); PG8_BAR;
    for (;;) {
        const bool has_next = S.next(ui + 1, nxt);
        const char* nA = has_next ? (const char*)g.A + (size_t)nxt.pm * tstepA + (size_t)nxt.kc * cstep : cA; const char* nB = has_next ? (const char*)g.Bt + (size_t)nxt.pn * tstep + (size_t)nxt.kc * cstep : cB;
        for (int t = 0; t < nt; t += 2) {
            const bool last = (t == nt - 2);
            const char* a1 = cA + (size_t)(t + 1) * kstep;
            const char* a2 = last ? nA : cA + (size_t)(t + 2) * kstep; const char* b2 = last ? nB : cB + (size_t)(t + 2) * kstep;
            const char* a3 = a2 + kstep; const char* b3 = b2 + kstep;
            if (last && has_next) S.a_ready(nxt);
            PG8_LDB(B0, 0, 0); PG8_SCHED; PG8_LDA(At, 0, 0); PG8_STAGE(PG8_SA(1, 1), a1 + hstep, voffA);
            PG8_WAIT_L(8); PG8_BAR; PG8_WAIT_L(0); PG8_MMA(0, 0, At, B0); PG8_BAR; PG8_SCHED;
            PG8_LDB(B1, 0, 1); PG8_STAGE(PG8_SB(0, 0), b2, voffB);
            PG8_BAR; PG8_WAIT_L(0); PG8_MMA(0, 1, At, B1); PG8_BAR;
            PG8_LDA(At, 0, 1); PG8_STAGE(PG8_SA(0, 0), a2, voffA);
            PG8_BAR; PG8_WAIT_L(0); PG8_MMA(1, 0, At, B0); PG8_BAR; PG8_SCHED;
            PG8_STAGE(PG8_SB(0, 1), b2 + hstep, voffB);
            PG8_WAIT_V(6); PG8_BAR; PG8_MMA(1, 1, At, B1); PG8_BAR;
            PG8_LDB(B0, 1, 0); PG8_SCHED; PG8_LDA(At, 1, 0); PG8_STAGE(PG8_SA(0, 1), a2 + hstep, voffA);
            PG8_WAIT_L(8); PG8_BAR; PG8_WAIT_L(0); PG8_MMA(0, 0, At, B0); PG8_BAR; PG8_SCHED;
            PG8_LDB(B1, 1, 1); PG8_STAGE(PG8_SB(1, 0), b3, voffB);
            PG8_BAR; PG8_WAIT_L(0); PG8_MMA(0, 1, At, B1); PG8_BAR;
            PG8_LDA(At, 1, 1); PG8_STAGE(PG8_SA(1, 0), a3, voffA);
            PG8_BAR; PG8_WAIT_L(0); PG8_MMA(1, 0, At, B0); PG8_BAR; PG8_SCHED;
            PG8_STAGE(PG8_SB(1, 1), b3 + hstep, voffB);
            PG8_WAIT_V(6); PG8_BAR; PG8_MMA(1, 1, At, B1); PG8_BAR;
        }
        if constexpr (!Epi::AFTER_DRAIN) { E(acc, cur, wr, wc, fr, fq); S.done(cur); }
        if (!has_next) break;
#pragma unroll
        for (int a = 0; a < 2; ++a)
#pragma unroll
            for (int b = 0; b < 2; ++b)
#pragma unroll
                for (int m = 0; m < 4; ++m)
#pragma unroll
                    for (int n = 0; n < 2; ++n) acc[a][b][m][n] = (f32x4){0.f, 0.f, 0.f, 0.f};
        cur = nxt; cA = nA; cB = nB; ++ui;
    }
    PG8_WAIT_V(0);
    if (wr == 0) PG8_BAR;
    PG8_BAR;
    if constexpr (Epi::AFTER_DRAIN) { E.fused(acc, cur, wr, wc, fr, fq, lds, wid, lane); S.done(cur); }
#undef PG8_SA
#undef PG8_SB
#undef PG8_STAGE
#undef PG8_LDA
#undef PG8_LDB
#undef PG8_MMA
#undef PG8_WAIT_V
#undef PG8_WAIT_L
#undef PG8_BAR
#undef PG8_SCHED
}
}
#define XB_TMO      128
#define XB_XCNT(j)  (256  + 64 * (j))
#define XB_XSUB(j)  (1280 + 64 * (j))
#define XB_XGEN(j)  (2304 + 64 * (j))
#define XB_TOP      3328
#define XB_TOPGEN   3392
#define XCD_BAR_WORDS 3456
#define XB_SPIN_CAP (1u << 18)

__device__ __forceinline__ unsigned xb_ld(unsigned* p)              { return __hip_atomic_load(p, __ATOMIC_RELAXED, __HIP_MEMORY_SCOPE_AGENT); }
__device__ __forceinline__ unsigned xb_add(unsigned* p, unsigned v) { return __hip_atomic_fetch_add(p, v, __ATOMIC_RELAXED, __HIP_MEMORY_SCOPE_AGENT); }
__device__ __forceinline__ unsigned xb_xcc_id() { return (unsigned)__builtin_amdgcn_s_getreg((3 << 11) | 20) & 0xFu; }
#define XB_SPIN(cond, bar) do { unsigned _sp = 0; while (cond) { __builtin_amdgcn_s_sleep(1); \
    if ((++_sp & 255u) == 0u) { if (xb_ld(&(bar)[XB_TMO])) break; if (_sp > XB_SPIN_CAP) { atomicAdd(&(bar)[XB_TMO], 1u); break; } } } } while (0)

struct XcdBarrier {
    unsigned* bar; unsigned x;
    volatile LAS unsigned* st;
};

__device__ __forceinline__ XcdBarrier xcd_barrier_post(unsigned* bar, volatile LAS unsigned* st) {
    XcdBarrier b; b.bar = bar; b.x = xb_xcc_id(); b.st = st;
    if (threadIdx.x == 0) (void)xb_add(&bar[XB_XCNT(b.x)], 1u);
    return b;
}
__device__ __forceinline__ void xcd_barrier_complete(unsigned* bar, unsigned x, unsigned& nloc, unsigned& nx) {
    const unsigned G = gridDim.x * gridDim.y * gridDim.z;
    unsigned sum, cnt, mine, sp = 0u;
    for (;;) {
        sum = 0u; cnt = 0u; mine = 0u;
#pragma unroll
        for (unsigned j = 0; j < 16; ++j) { const unsigned c = xb_ld(&bar[XB_XCNT(j)]); sum += c; cnt += (c > 0u) ? 1u : 0u; mine = (j == x) ? c : mine; }
        if (sum == G) break;
        __builtin_amdgcn_s_sleep(1);
        if ((++sp & 255u) == 0u) { if (xb_ld(&bar[XB_TMO])) break; if (sp > XB_SPIN_CAP) { atomicAdd(&bar[XB_TMO], 1u); break; } }
    }
    nloc = mine > 0u ? mine : 1u; nx = cnt > 0u ? cnt : 1u;
}

__device__ __forceinline__ void xcd_barrier(const XcdBarrier& b) {
    asm volatile("s_waitcnt vmcnt(0)" ::: "memory");
    __syncthreads();
    if (threadIdx.x == 0) {
        unsigned* bar = b.bar;
        __builtin_amdgcn_s_waitcnt(0);
        unsigned nloc = b.st[0], nx = b.st[1];
        if (nloc == 0u) { xcd_barrier_complete(bar, b.x, nloc, nx); b.st[0] = nloc; b.st[1] = nx; }
        const unsigned old = xb_add(&bar[XB_XSUB(b.x)], 1u);
        const unsigned gen = old / nloc;
        if (old + 1u == (gen + 1u) * nloc) {
            __builtin_amdgcn_fence(__ATOMIC_RELEASE, "agent");
            asm volatile("s_waitcnt vmcnt(0)" ::: "memory");
            const unsigned og = xb_add(&bar[XB_TOP], 1u);
            const unsigned tg = og / nx;
            if (og + 1u == (tg + 1u) * nx) xb_add(&bar[XB_TOPGEN], 1u);
            else XB_SPIN(xb_ld(&bar[XB_TOPGEN]) == tg, bar);
            __builtin_amdgcn_fence(__ATOMIC_ACQUIRE, "agent");
            xb_add(&bar[XB_XGEN(b.x)], 1u);
            asm volatile("s_waitcnt vmcnt(0)" ::: "memory");
        } else {
            XB_SPIN(xb_ld(&bar[XB_XGEN(b.x)]) == gen, bar);
            __builtin_amdgcn_fence(__ATOMIC_ACQUIRE, "agent");
            asm volatile("s_waitcnt vmcnt(0)" ::: "memory");
        }
    }
    __syncthreads();
}


using pg8::bf16_t; using pg8::bf16x8; using pg8::f32x4; using pg8::u32x4;
typedef float f32x16 __attribute__((ext_vector_type(16)));
typedef unsigned u32x2 __attribute__((ext_vector_type(2)));

constexpr int DM = 1024, NB = 8, SEQ = 4096, CTXL = 256, ML = NB * SEQ, MC = NB * CTXL, MT = ML + MC, NH = 16, HD = 64, DFF = 3072;
constexpr int NCHUNK = 34;
constexpr float EPSN = 1e-6f;
constexpr size_t MiB = (size_t)1 << 20, MEL = (size_t)1 << 20;
constexpr size_t WS_MODS = 0, WS_SUM = 1 * MiB, WS_BAR = 8 * MiB, WS_BDW = 9 * MiB, WS_CTXR = 10 * MiB, WS_WB = 18 * MiB, WS_HN = 118 * MiB, WS_R = 186 * MiB, WS_PART = (186 + 272) * MiB, WS_END = 510 * MiB;
constexpr size_t R_Q = 0, R_K = (size_t)MT * DM, R_VT = 2 * (size_t)MT * DM;
constexpr size_t R_GATE = 0, R_REC = (size_t)MT * DM, R_XR = 2 * (size_t)MT * DM, R_YP = 3 * (size_t)MT * DM;
constexpr size_t R_U = 0, R_G = 0;
constexpr int LDS_BYTES = 147456;

enum { OP_PRO = 0, OP_NORM, OP_GQK, OP_GST, OP_GRES, OP_ATTN, OP_LCONV, OP_LRUA, OP_LRUC, OP_FCONV, OP_GUP };
#ifndef DUP_MASK
#define DUP_MASK 0
#endif
#define DUPE(op, i, arg) DUPE_(((DUP_MASK >> op) & 1), op, i, arg)
#define DUPE_(c, op, i, arg) DUPE__(c, op, i, arg)
#define DUPE__(c, op, i, arg) DUPE_##c(op, i, arg)
#define DUPE_0(op, i, arg)
#define DUPE_1(op, i, arg) {op, i, arg, 0},
#if DUP_MASK & 2
#define DN(i, a) {OP_NORM, i, a, 0},
#else
#define DN(i, a)
#endif
#if DUP_MASK & 4
#define DQK(i) {OP_GQK, i, 0, 0},
#else
#define DQK(i)
#endif
#if DUP_MASK & 8
#define DST(i, a) {OP_GST, i, a, 0},
#else
#define DST(i, a)
#endif
#if DUP_MASK & 32
#define DAT(i) {OP_ATTN, i, 1, 0},
#else
#define DAT(i)
#endif
#if DUP_MASK & 64
#define DLC(i) {OP_LCONV, i, 0, 0},
#else
#define DLC(i)
#endif
#if DUP_MASK & 128
#define DLA(i) {OP_LRUA, i, 0, 0},
#else
#define DLA(i)
#endif
#if DUP_MASK & 256
#define DLCC(i) {OP_LRUC, i, 0, 0},
#else
#define DLCC(i)
#endif
#if DUP_MASK & 1024
#define DUP_(i) {OP_GUP, i, 0, 0},
#else
#define DUP_(i)
#endif
#if DUP_MASK & 1
#define DPRO {OP_PRO, 0, 0, 0},
#else
#define DPRO
#endif
#define FFN_OPS(i) DN(i, 1) {OP_NORM, i, 1, 1}, DUP_(i) {OP_GUP, i, 0, 1}, {OP_GRES, i, 2, 1}
#define NA_OPS(i) DN(i, 0) {OP_NORM, i, 0, 1}, DQK(i) {OP_GQK, i, 0, 0}, DST(i, 0) {OP_GST, i, 0, 1}, DAT(i) {OP_ATTN, i, 0, 1}, {OP_GRES, i, 0, 1}, FFN_OPS(i)
#define LRU_OPS(i) DN(i, 0) {OP_NORM, i, 0, 1}, DST(i, 1) {OP_GST, i, 1, 1}, DLC(i) {OP_LCONV, i, 0, 1}, DLCC(i) {OP_LRUC, i, 0, 1}, {OP_GRES, i, 0, 1}, FFN_OPS(i)
#define PROG_INIT { DPRO {OP_PRO, 0, 0, 1}, NA_OPS(0), LRU_OPS(1), NA_OPS(2), LRU_OPS(3) }
__device__ const int PROG[][4] = PROG_INIT;
static const int HOSTPROG[][4] = PROG_INIT;
constexpr int NPROG = (int)(sizeof(HOSTPROG) / sizeof(HOSTPROG[0]));

struct Args { const float* in[26]; float* out; unsigned char* ws; int pc_lo, pc_hi; };

__device__ __forceinline__ unsigned f2bf(float f) { unsigned u = __float_as_uint(f); return (u + 0x7fffu + ((u >> 16) & 1u)) >> 16; }
__device__ __forceinline__ unsigned pk2(float lo, float hi) { return f2bf(lo) | (f2bf(hi) << 16); }
__device__ __forceinline__ float bflo(unsigned w) { return __uint_as_float(w << 16); }
__device__ __forceinline__ float bfhi(unsigned w) { return __uint_as_float(w & 0xffff0000u); }
__device__ __forceinline__ float wave_sum(float v) {
#pragma unroll
    for (int o = 1; o < 64; o <<= 1) v += __shfl_xor(v, o);
    return v;
}
__device__ __forceinline__ float fexp(float x) { return __builtin_amdgcn_exp2f(x * 1.4426950408889634f); }
__device__ __forceinline__ float sigmoidf_(float x) { return __builtin_amdgcn_rcpf(1.0f + __builtin_amdgcn_exp2f(x * -1.4426950408889634f)); }
__device__ __forceinline__ f32x16 mfma32(bf16x8 a, bf16x8 b, f32x16 c) { return __builtin_amdgcn_mfma_f32_32x32x16_bf16(a, b, c, 0, 0, 0); }
__device__ __forceinline__ f32x4 mfma16(bf16x8 a, bf16x8 b, f32x4 c) { return __builtin_amdgcn_mfma_f32_16x16x32_bf16(a, b, c, 0, 0, 0); }

struct EpiStore {
    static constexpr bool PERM = true, AFTER_DRAIN = false;
    bf16_t* O; int ldc; int split_cols; size_t split_stride;
    __device__ __forceinline__ void operator()(const f32x4 (&acc)[2][2][4][2], const pg8::Unit& u, int wr, int wc, int fr, int fq) const {
        const int row0 = u.pm * 256 + wr * 64 + fr; int colt = u.pn * 256; bf16_t* base = O;
        if (split_cols) { const int t = colt / split_cols; base += (size_t)t * split_stride; colt -= t * split_cols; }
        const int col0 = colt + wc * 32 + 8 * fq;
#pragma unroll
        for (int ai = 0; ai < 2; ++ai)
#pragma unroll
            for (int m = 0; m < 4; ++m) { bf16_t* rowp = base + (size_t)(row0 + ai * 128 + m * 16) * ldc + col0;
#pragma unroll
                for (int bj = 0; bj < 2; ++bj) { const f32x4 v0 = acc[ai][bj][m][0], v1 = acc[ai][bj][m][1];
                    u32x4 w; w.x = pg8::cvt_pk_bf16(v0[0], v0[1]); w.y = pg8::cvt_pk_bf16(v0[2], v0[3]); w.z = pg8::cvt_pk_bf16(v1[0], v1[1]); w.w = pg8::cvt_pk_bf16(v1[2], v1[3]);
                    *(u32x4*)(rowp + bj * 128) = w; } }
    }
};
struct EpiQK {
    static constexpr bool PERM = true, AFTER_DRAIN = false;
    bf16_t* Q; bf16_t* K; const float* qg; const float* kg;
    __device__ __forceinline__ void operator()(const f32x4 (&acc)[2][2][4][2], const pg8::Unit& u, int wr, int wc, int fr, int fq) const {
        const int row0 = u.pm * 256 + wr * 64 + fr; const bool isk = u.pn >= 4;
        bf16_t* base = (isk ? K : Q) + (u.pn & 3) * 256 + 64 * wc + 8 * fq;
        const float* g = isk ? kg : qg; const float sc = isk ? 1.0f : 0.125f;
        f32x4 gv[2][2];
#pragma unroll
        for (int bj = 0; bj < 2; ++bj)
#pragma unroll
            for (int n = 0; n < 2; ++n) gv[bj][n] = *(const f32x4*)(g + 32 * bj + 8 * fq + 4 * n) * sc;
#pragma unroll
        for (int ai = 0; ai < 2; ++ai)
#pragma unroll
            for (int m = 0; m < 4; ++m) {
                float ss = 0.f;
#pragma unroll
                for (int bj = 0; bj < 2; ++bj)
#pragma unroll
                    for (int n = 0; n < 2; ++n) { const f32x4 x = acc[ai][bj][m][n]; ss += (x[0] * x[0] + x[1] * x[1]) + (x[2] * x[2] + x[3] * x[3]); }
                ss += __shfl_xor(ss, 16); ss += __shfl_xor(ss, 32);
                const float rs = __builtin_amdgcn_rsqf(ss * (1.0f / 64.0f) + EPSN);
                bf16_t* rowp = base + (size_t)(row0 + ai * 128 + m * 16) * DM;
#pragma unroll
                for (int bj = 0; bj < 2; ++bj) { const f32x4 v0 = acc[ai][bj][m][0] * rs * gv[bj][0], v1 = acc[ai][bj][m][1] * rs * gv[bj][1];
                    u32x4 w; w.x = pg8::cvt_pk_bf16(v0[0], v0[1]); w.y = pg8::cvt_pk_bf16(v0[2], v0[3]); w.z = pg8::cvt_pk_bf16(v1[0], v1[1]); w.w = pg8::cvt_pk_bf16(v1[2], v1[3]);
                    *(u32x4*)(rowp + 32 * bj) = w; }
            }
    }
};
struct EpiRes {
    static constexpr bool PERM = false, AFTER_DRAIN = false;
    const float* in_lat; const float* in_ctx; float* out_lat; float* out_ctx; const float* gate; int row_off;
    __device__ __forceinline__ void operator()(const f32x4 (&acc)[2][2][4][2], const pg8::Unit& u, int wr, int wc, int fr, int fq) const {
        const int R0 = row_off + u.pm * 256;
        const float* inp; float* outp; int bidx;
        if (R0 < ML) { bidx = R0 >> 12; inp = in_lat + (size_t)R0 * DM; outp = out_lat + (size_t)R0 * DM; }
        else { bidx = 8; inp = in_ctx + (size_t)(R0 - ML) * DM; outp = out_ctx + (size_t)(R0 - ML) * DM; }
        const int col0 = u.pn * 256 + wc * 32 + 4 * fq;
        const float* gp = gate + (size_t)bidx * 6144 + col0;
        f32x4 gv[2][2];
#pragma unroll
        for (int bj = 0; bj < 2; ++bj)
#pragma unroll
            for (int n = 0; n < 2; ++n) gv[bj][n] = *(const f32x4*)(gp + bj * 128 + n * 16);
#pragma unroll
        for (int ai = 0; ai < 2; ++ai)
#pragma unroll
            for (int m = 0; m < 4; ++m) { const size_t ro = (size_t)(wr * 64 + fr + ai * 128 + m * 16) * DM + col0;
#pragma unroll
                for (int bj = 0; bj < 2; ++bj)
#pragma unroll
                    for (int n = 0; n < 2; ++n) { const size_t o = ro + bj * 128 + n * 16; *(f32x4*)(outp + o) = *(const f32x4*)(inp + o) + gv[bj][n] * acc[ai][bj][m][n]; } }
    }
};


struct CtxSplitOrder {
    int nkc, G, c, pm0;
    __device__ __forceinline__ bool next(int i, pg8::Unit& u) const {
        const int L = i * G + c; if (L >= 8 * 4 * nkc) return false;
        u.kc = L % nkc; u.pn = (L / nkc) & 3; u.pm = pm0 + L / (nkc * 4); return true;
    }
    __device__ __forceinline__ void a_ready(const pg8::Unit&) const {}
    __device__ __forceinline__ void done(const pg8::Unit&) const {}
};
struct EpiPart {
    static constexpr bool PERM = false, AFTER_DRAIN = false;
    float* part;
    __device__ __forceinline__ void operator()(const f32x4 (&acc)[2][2][4][2], const pg8::Unit& u, int wr, int wc, int fr, int fq) const {
        float* outp = part + ((size_t)u.kc * MC + (size_t)(u.pm * 256 - ML)) * DM;
        const int col0 = u.pn * 256 + wc * 32 + 4 * fq;
#pragma unroll
        for (int ai = 0; ai < 2; ++ai)
#pragma unroll
            for (int m = 0; m < 4; ++m) { float* rp = outp + (size_t)(wr * 64 + fr + ai * 128 + m * 16) * DM + col0;
#pragma unroll
                for (int bj = 0; bj < 2; ++bj)
#pragma unroll
                    for (int n = 0; n < 2; ++n) *(f32x4*)(rp + bj * 128 + n * 16) = acc[ai][bj][m][n]; }
    }
};

template <int CTRL> __device__ __forceinline__ float dppf(float x) { return __int_as_float(__builtin_amdgcn_mov_dpp(__float_as_int(x), CTRL, 0xf, 0xf, true)); }
struct EpiUpConv {
    static constexpr bool PERM = true, AFTER_DRAIN = false;
    bf16_t* Gb; const float* cw; const float* cbias; LAS float* xb;
    __device__ __forceinline__ void operator()(const f32x4 (&acc)[2][2][4][2], const pg8::Unit& u, int wr, int wc, int fr, int fq) const {
        const int cl = 32 * wc + 8 * fq, cv = u.pn * 128 + cl;
#pragma unroll
        for (int ai = 0; ai < 2; ++ai) { const int s = 2 * ai + wr;
            if (fr == 0) { LAS float* p = xb + (s * 2 + 0) * 256 + cl; *(LAS f32x4*)p = acc[ai][0][0][0]; *(LAS f32x4*)(p + 4) = acc[ai][0][0][1]; *(LAS f32x4*)(p + 128) = acc[ai][1][0][0]; *(LAS f32x4*)(p + 132) = acc[ai][1][0][1]; }
            if (fr == 15) { LAS float* p = xb + (s * 2 + 1) * 256 + cl; *(LAS f32x4*)p = acc[ai][0][3][0]; *(LAS f32x4*)(p + 4) = acc[ai][0][3][1]; *(LAS f32x4*)(p + 128) = acc[ai][1][3][0]; *(LAS f32x4*)(p + 132) = acc[ai][1][3][1]; } }
        asm volatile("s_waitcnt lgkmcnt(0)\n\ts_barrier\n\ts_barrier" ::: "memory");
        const int R0 = 254 * u.pm - 1;
        bool bnd = false;
#pragma unroll
        for (int ai = 0; ai < 2; ++ai)
#pragma unroll
            for (int m = 0; m < 4; ++m) { const int row = R0 + 128 * ai + 64 * wr + 16 * m + fr;
                int pos, last; if (row < ML) { pos = row & (SEQ - 1); last = SEQ - 1; } else { pos = (row - ML) & (CTXL - 1); last = CTXL - 1; }
                bnd = bnd || pos == 0 || pos == last || row < 0 || row >= MT; }
        if (__builtin_amdgcn_ballot_w64(bnd) == 0ull) {
#pragma unroll
            for (int n = 0; n < 2; ++n) {
                f32x4 wv[3], wg[3], bv, bg;
#pragma unroll
                for (int k = 0; k < 3; ++k) { wv[k] = *(const f32x4*)(cw + k * 6144 + cv + 4 * n); wg[k] = *(const f32x4*)(cw + k * 6144 + DFF + cv + 4 * n); }
                bv = *(const f32x4*)(cbias + cv + 4 * n); bg = *(const f32x4*)(cbias + DFF + cv + 4 * n);
#pragma unroll
                for (int ai = 0; ai < 2; ++ai) { const int s = 2 * ai + wr;
#pragma unroll
                    for (int m = 0; m < 4; ++m) {
                        const int rl = 128 * ai + 64 * wr + 16 * m + fr, row = R0 + rl;
                        f32x4 xpv, xpg, xnv, xng;
                        if (m == 0) { const LAS float* p = xb + ((s > 0 ? s - 1 : 0) * 2 + 1) * 256 + cl + 4 * n; xpv = *(const LAS f32x4*)p; xpg = *(const LAS f32x4*)(p + 128); }
                        if (m == 3) { const LAS float* p = xb + ((s < 3 ? s + 1 : 3) * 2 + 0) * 256 + cl + 4 * n; xnv = *(const LAS f32x4*)p; xng = *(const LAS f32x4*)(p + 128); }
                        float o[4];
#pragma unroll
                        for (int e = 0; e < 4; ++e) {
                            const float cvv = acc[ai][0][m][n][e], cgg = acc[ai][1][m][n][e];
                            const float upv = m > 0 ? acc[ai][0][m > 0 ? m - 1 : 0][n][e] : xpv[e], upg = m > 0 ? acc[ai][1][m > 0 ? m - 1 : 0][n][e] : xpg[e];
                            const float dnv = m < 3 ? acc[ai][0][m < 3 ? m + 1 : 3][n][e] : xnv[e], dng = m < 3 ? acc[ai][1][m < 3 ? m + 1 : 3][n][e] : xng[e];
                            const float xpv_ = fr == 15 ? upv : cvv, xpg_ = fr == 15 ? upg : cgg;
                            const float xnv_ = fr == 0 ? dnv : cvv, xng_ = fr == 0 ? dng : cgg;
                            float val = bv[e] + wv[1][e] * cvv; val += wv[0][e] * dppf<0x121>(xpv_); val += wv[2][e] * dppf<0x12F>(xnv_);
                            float gt = bg[e] + wg[1][e] * cgg; gt += wg[0][e] * dppf<0x121>(xpg_); gt += wg[2][e] * dppf<0x12F>(xng_);
                            o[e] = val * gt * sigmoidf_(gt);
                        }
                        u32x2 ow; ow.x = pg8::cvt_pk_bf16(o[0], o[1]); ow.y = pg8::cvt_pk_bf16(o[2], o[3]);
                        if (rl >= 1 && rl <= 254) *(u32x2*)(Gb + (size_t)row * DFF + cv + 4 * n) = ow;
                    }
                }
            }
            return;
        }
#pragma unroll
        for (int n = 0; n < 2; ++n) {
            f32x4 wv[3], wg[3], bv, bg;
#pragma unroll
            for (int k = 0; k < 3; ++k) { wv[k] = *(const f32x4*)(cw + k * 6144 + cv + 4 * n); wg[k] = *(const f32x4*)(cw + k * 6144 + DFF + cv + 4 * n); }
            bv = *(const f32x4*)(cbias + cv + 4 * n); bg = *(const f32x4*)(cbias + DFF + cv + 4 * n);
#pragma unroll
            for (int ai = 0; ai < 2; ++ai) { const int s = 2 * ai + wr;
#pragma unroll
                for (int m = 0; m < 4; ++m) {
                    const int rl = 128 * ai + 64 * wr + 16 * m + fr, row = R0 + rl;
                    int pos, last; if (row < ML) { pos = row & (SEQ - 1); last = SEQ - 1; } else { pos = (row - ML) & (CTXL - 1); last = CTXL - 1; }
                    const bool pok = pos > 0, nok = pos < last;
                    f32x4 xpv, xpg, xnv, xng;
                    if (m == 0) { const LAS float* p = xb + ((s > 0 ? s - 1 : 0) * 2 + 1) * 256 + cl + 4 * n; xpv = *(const LAS f32x4*)p; xpg = *(const LAS f32x4*)(p + 128); }
                    if (m == 3) { const LAS float* p = xb + ((s < 3 ? s + 1 : 3) * 2 + 0) * 256 + cl + 4 * n; xnv = *(const LAS f32x4*)p; xng = *(const LAS f32x4*)(p + 128); }
                    float o[4];
#pragma unroll
                    for (int e = 0; e < 4; ++e) {
                        const float cvv = acc[ai][0][m][n][e], cgg = acc[ai][1][m][n][e];
                        const float av = dppf<0x121>(cvv), ag = dppf<0x121>(cgg);
                        float bvv, bgg;
                        if (m > 0) { bvv = dppf<0x121>(acc[ai][0][m > 0 ? m - 1 : 0][n][e]); bgg = dppf<0x121>(acc[ai][1][m > 0 ? m - 1 : 0][n][e]); } else { bvv = xpv[e]; bgg = xpg[e]; }
                        float pvv = fr == 0 ? bvv : av, pgg = fr == 0 ? bgg : ag;
                        const float a2v = dppf<0x12F>(cvv), a2g = dppf<0x12F>(cgg);
                        float b2v, b2g;
                        if (m < 3) { b2v = dppf<0x12F>(acc[ai][0][m < 3 ? m + 1 : 3][n][e]); b2g = dppf<0x12F>(acc[ai][1][m < 3 ? m + 1 : 3][n][e]); } else { b2v = xnv[e]; b2g = xng[e]; }
                        float nvv = fr == 15 ? b2v : a2v, ngg = fr == 15 ? b2g : a2g;
                        pvv = pok ? pvv : 0.f; pgg = pok ? pgg : 0.f; nvv = nok ? nvv : 0.f; ngg = nok ? ngg : 0.f;
                        const float val = bv[e] + wv[0][e] * pvv + wv[1][e] * cvv + wv[2][e] * nvv;
                        const float gt = bg[e] + wg[0][e] * pgg + wg[1][e] * cgg + wg[2][e] * ngg;
                        o[e] = val * gt * sigmoidf_(gt);
                    }
                    u32x2 ow; ow.x = pg8::cvt_pk_bf16(o[0], o[1]); ow.y = pg8::cvt_pk_bf16(o[2], o[3]);
                    if (rl >= 1 && rl <= 254 && row >= 0 && row < MT) *(u32x2*)(Gb + (size_t)row * DFF + cv + 4 * n) = ow;
                }
            }
        }
    }
};

__device__ __forceinline__ void transpose_item(const float* W, int ldw, int K, int ncol0, int ncols, bf16_t* WT, int perm, LAS float* scr, int item, int lane) {
    const int nblk = ncols / 32, kb = item / nblk, nb = item % nblk, k0 = 64 * kb, n0 = 32 * nb;
    { f32x4 v[8];
#pragma unroll
      for (int i = 0; i < 8; ++i) v[i] = *(const f32x4*)(W + (size_t)(k0 + (lane >> 3) + 8 * i) * ldw + ncol0 + n0 + 4 * (lane & 7));
#pragma unroll
      for (int i = 0; i < 8; ++i) { LAS float* d = scr + ((lane >> 3) + 8 * i) * 33 + 4 * (lane & 7); d[0] = v[i][0]; d[1] = v[i][1]; d[2] = v[i][2]; d[3] = v[i][3]; } }
    asm volatile("s_waitcnt lgkmcnt(0)" ::: "memory");
    int d0 = n0;
    if (perm == 1) { const int pn = n0 >> 8, wc = (n0 >> 6) & 3, bj = (n0 >> 5) & 1; d0 = pn * 256 + bj * 128 + wc * 32; }
    else if (perm == 2) { const int isg = n0 >= DFF, nn = isg ? n0 - DFF : n0; d0 = (nn >> 7) * 256 + isg * 128 + (nn & 127); }
    const int c = lane & 7;
#pragma unroll
    for (int j = 0; j < 4; ++j) { const int n = (lane >> 3) + 8 * j; const LAS float* s = scr + (8 * c) * 33 + n;
        u32x4 o; o.x = pk2(s[0 * 33], s[1 * 33]); o.y = pk2(s[2 * 33], s[3 * 33]); o.z = pk2(s[4 * 33], s[5 * 33]); o.w = pk2(s[6 * 33], s[7 * 33]);
        *(u32x4*)(WT + (size_t)(d0 + n) * K + k0 + 8 * c) = o; }
    asm volatile("s_waitcnt lgkmcnt(0)" ::: "memory");
}
struct TDesc { const float* src; int ldw, K, ncol0, ncols, perm; bf16_t* dst; int nitems; };
__device__ __forceinline__ TDesc get_tdesc(int m, const Args& a, bf16_t* WB) {
    TDesc t;
    if (m < 6) { const int j = m / 3, w = m % 3;
        if (w == 0) { t.src = a.in[8] + (size_t)j * DM * 3072; t.ldw = 3072; t.K = DM; t.ncol0 = 0; t.ncols = 2048; t.perm = 1; t.dst = WB + (size_t)j * 4 * MEL; }
        else if (w == 1) { t.src = a.in[8] + (size_t)j * DM * 3072; t.ldw = 3072; t.K = DM; t.ncol0 = 2048; t.ncols = 1024; t.perm = 0; t.dst = WB + (size_t)j * 4 * MEL + 2 * MEL; }
        else { t.src = a.in[12] + (size_t)j * DM * DM; t.ldw = DM; t.K = DM; t.ncol0 = 0; t.ncols = DM; t.perm = 0; t.dst = WB + (size_t)j * 4 * MEL + 3 * MEL; }
    } else if (m < 10) { const int j = (m - 6) / 2, w = (m - 6) % 2;
        if (w == 0) { t.src = a.in[13] + (size_t)j * DM * 2048; t.ldw = 2048; t.K = DM; t.ncol0 = 0; t.ncols = 2048; t.perm = 0; t.dst = WB + 8 * MEL + (size_t)j * 3 * MEL; }
        else { t.src = a.in[21] + (size_t)j * DM * DM; t.ldw = DM; t.K = DM; t.ncol0 = 0; t.ncols = DM; t.perm = 0; t.dst = WB + 8 * MEL + (size_t)j * 3 * MEL + 2 * MEL; }
    } else { const int i = (m - 10) / 2, w = (m - 10) % 2;
        if (w == 0) { t.src = a.in[22] + (size_t)i * DM * 6144; t.ldw = 6144; t.K = DM; t.ncol0 = 0; t.ncols = 6144; t.perm = 2; t.dst = WB + 14 * MEL + (size_t)i * 9 * MEL; }
        else { t.src = a.in[25] + (size_t)i * DFF * DM; t.ldw = DM; t.K = DFF; t.ncol0 = 0; t.ncols = DM; t.perm = 0; t.dst = WB + 14 * MEL + (size_t)i * 9 * MEL + 6 * MEL; }
    }
    t.nitems = (t.K / 64) * (t.ncols / 32);
    return t;
}
__device__ __forceinline__ void prologue(const Args& a, LAS unsigned char* lds, int tid, int lane, int wave, int G) {
    unsigned char* ws = a.ws;
    float* MODS = (float*)(ws + WS_MODS);
    bf16_t* WB = (bf16_t*)(ws + WS_WB);
    bf16_t* BDW = (bf16_t*)(ws + WS_BDW);
    LAS float* sl = (LAS float*)(lds + 69632);
    LAS float* red = (LAS float*)(lds + 69632 + 36864);
    for (int i = tid; i < 9 * DM; i += 512) { const int bi = i >> 10, k = i & 1023; const float v = bi < 8 ? a.in[1][bi * DM + k] : a.in[3][k]; sl[i] = v * sigmoidf_(v); }
    __syncthreads();
    for (int it = opaque_bid(); it < 4 * 96; it += G) {
        const int l = it / 96, n0 = (it % 96) * 64;
        const float* wp = a.in[4] + ((size_t)l * DM + wave * 128) * 6144 + n0 + lane;
        float acc[9];
#pragma unroll
        for (int bi = 0; bi < 9; ++bi) acc[bi] = 0.f;
        for (int k = 0; k < 128; k += 16) {
            float w[16];
#pragma unroll
            for (int kk = 0; kk < 16; ++kk) w[kk] = wp[(size_t)(k + kk) * 6144];
#pragma unroll
            for (int k4 = 0; k4 < 16; k4 += 4)
#pragma unroll
                for (int bi = 0; bi < 9; ++bi) { const f32x4 s = *(const LAS f32x4*)(sl + bi * DM + wave * 128 + k + k4); acc[bi] += (s[0] * w[k4] + s[1] * w[k4 + 1]) + (s[2] * w[k4 + 2] + s[3] * w[k4 + 3]); }
        }
#pragma unroll
        for (int bi = 0; bi < 9; ++bi) red[(wave * 9 + bi) * 64 + lane] = acc[bi];
        __syncthreads();
        for (int o = tid; o < 9 * 64; o += 512) { const int bi = o >> 6, ln = o & 63; float s = a.in[5][(size_t)l * 6144 + n0 + ln];
#pragma unroll
            for (int w = 0; w < 8; ++w) s += red[(w * 9 + bi) * 64 + ln];
            MODS[((size_t)l * 9 + bi) * 6144 + n0 + ln] = s; }
        __syncthreads();
    }
    { float* CTXR = (float*)(ws + WS_CTXR);
      for (int i = opaque_bid() * 512 + tid; i < MC * DM / 4; i += G * 512) { asm volatile("" : "+v"(i)); ((f32x4*)CTXR)[i] = ((const f32x4*)a.in[2])[i]; } }
#pragma unroll 1
    for (int idx = opaque_bid() * 512 + tid; idx < 2 * 2 * 2 * 16 * 4096; idx += G * 512) { asm volatile("" : "+v"(idx));
        const int d = idx & 63, e = (idx >> 6) & 63, n = (idx >> 12) & 15, gt = (idx >> 16) & 1, dir = (idx >> 17) & 1, j = idx >> 18;
        const float* W = gt ? a.in[18] : a.in[16];
        BDW[idx] = (bf16_t)f2bf(W[((((size_t)j * 2 + dir) * 16 + n) * 64 + d) * 64 + e]);
    }
    LAS float* scr = (LAS float*)(lds + wave * 8448);
    const int gw = opaque_bid() * 8 + wave, NGW = G * 8;
    int base = 0;
    for (int m = 0; m < 18; ++m) {
        const TDesc t = get_tdesc(m, a, WB);
        int first = (gw - base) % NGW; if (first < 0) first += NGW;
        for (int it = first; it < t.nitems; it += NGW) transpose_item(t.src, t.ldw, t.K, t.ncol0, t.ncols, t.dst, t.perm, scr, it, lane);
        base = (base + t.nitems) % NGW;
    }
}

__device__ __forceinline__ void norm_phase(const float* xl, const float* xc, bf16_t* HN, const float* gain, const float* mods_l, int sidx, int nrows, int lane, int gw, int NGW,
                                           float* ctxr_rw, const float* part, int npart, const float* pgate) {
    const bool blocked = (ML % NGW) == 0;
    const int rpw = blocked ? ML / NGW : (ML + NGW - 1) / NGW;
    const int nctx = nrows > ML ? (nrows - ML + NGW - 1) / NGW : 0;
    int curb = -1; f32x4 gm[4], shv[4];
#pragma unroll
    for (int j = 0; j < 4; ++j) { gm[j] = (f32x4){0.f, 0.f, 0.f, 0.f}; shv[j] = gm[j]; }
    for (int idx = 0; idx < rpw + nctx; ++idx) {
        int row;
        if (idx < rpw) { row = blocked ? gw * rpw + idx : gw + idx * NGW; if (row >= ML) continue; }
        else { row = ML + gw + (idx - rpw) * NGW; if (row >= nrows) continue; }
        const float* src; int bidx;
        if (row < ML) { src = xl + (size_t)row * DM; bidx = row >> 12; } else { src = xc + (size_t)(row - ML) * DM; bidx = 8; }
        const f32x4* xr = (const f32x4*)src + lane;
        f32x4 v[4]; float s = 0.f;
#pragma unroll
        for (int j = 0; j < 4; ++j) v[j] = xr[64 * j];
        if (bidx != curb) { curb = bidx;
            const float* shp = mods_l + (size_t)bidx * 6144 + sidx * DM; const float* scp = shp + DM;
#pragma unroll
            for (int j = 0; j < 4; ++j) { const int col = 4 * (lane + 64 * j); gm[j] = *(const f32x4*)(gain + col) * (*(const f32x4*)(scp + col) + 1.0f); shv[j] = *(const f32x4*)(shp + col); } }
        if (row >= ML && npart > 0) {
            f32x4 ps[4];
#pragma unroll
            for (int j = 0; j < 4; ++j) ps[j] = (f32x4){0.f, 0.f, 0.f, 0.f};
            for (int kc = 0; kc < npart; ++kc) { const f32x4* pr = (const f32x4*)(part + ((size_t)kc * MC + (row - ML)) * DM) + lane;
#pragma unroll
                for (int j = 0; j < 4; ++j) ps[j] += pr[64 * j]; }
            f32x4* wr_ = (f32x4*)(ctxr_rw + (size_t)(row - ML) * DM) + lane;
#pragma unroll
            for (int j = 0; j < 4; ++j) { v[j] += *(const f32x4*)(pgate + 4 * (lane + 64 * j)) * ps[j]; wr_[64 * j] = v[j]; }
        }
#pragma unroll
        for (int j = 0; j < 4; ++j) s += (v[j][0] * v[j][0] + v[j][1] * v[j][1]) + (v[j][2] * v[j][2] + v[j][3] * v[j][3]);
        const float rstd = __builtin_amdgcn_rsqf(wave_sum(s) * (1.0f / DM) + EPSN);
        u32x2* o8 = (u32x2*)(HN + (size_t)row * DM) + lane;
#pragma unroll
        for (int j = 0; j < 4; ++j) { const f32x4 y = v[j] * rstd * gm[j] + shv[j];
            u32x2 w; w.x = pk2(y[0], y[1]); w.y = pk2(y[2], y[3]); o8[64 * j] = w; }
    }
}

template <bool CTXQ>
__device__ __forceinline__ void attn_task(const bf16_t* QO, bf16_t* OO, const bf16_t* Kb, const bf16_t* VT, const float* rpb, int lane, int task) {
    constexpr int G0 = CTXQ ? 8 : 0;
    const int q = lane & 15, g = lane >> 4;
    int cb, r, h, b, q0, ks, rs; size_t qrow;
    if (CTXQ) { const int qb = task & 15; h = (task >> 4) & 15; b = task >> 8; cb = 0; r = 0; q0 = 0; ks = 0; rs = 0; qrow = (size_t)ML + b * CTXL + qb * 16 + q; }
    else { cb = task & 3; r = (task >> 2) & 63; h = (task >> 8) & 15; b = task >> 12; q0 = cb * 16; ks = min(max(q0 - 8, 0), 32); rs = min(max(r - 4, 0), 56); qrow = (size_t)b * SEQ + r * 64 + q0 + q; }
    const bf16x8 qf0 = *(const bf16x8*)(QO + qrow * DM + h * 64 + 8 * g), qf1 = *(const bf16x8*)(QO + qrow * DM + h * 64 + 32 + 8 * g);
    const int qcol = q0 + q, wstart = min(max(qcol - 8, 0), 48);
    const float* rp = rpb + h * 465;
    const int koff = 8 * (q >> 2) + (q & 3);
    f32x4 S[16][2];
#pragma unroll
    for (int grp = G0; grp < 16; ++grp) {
        const size_t base = grp < 8 ? (size_t)b * SEQ + (rs + grp) * 64 + ks : (size_t)ML + b * CTXL + 32 * (grp - 8);
#pragma unroll
        for (int T = 0; T < 2; ++T) {
            const bf16_t* kp = Kb + (base + koff + 4 * T) * DM + h * 64 + 8 * g;
            const bf16x8 kf0 = *(const bf16x8*)kp, kf1 = *(const bf16x8*)(kp + 32);
            f32x4 s = {0.f, 0.f, 0.f, 0.f};
            s = mfma16(kf0, qf0, s); s = mfma16(kf1, qf1, s);
            if (grp < 8) {
                const int drow = rs + grp - r + 7;
#pragma unroll
                for (int j = 0; j < 4; ++j) { const int kcol = ks + 8 * g + 4 * T + j; const bool ok = (kcol >= wstart) && (kcol < wstart + 16);
                    const int dcol = min(max(kcol - qcol + 15, 0), 30);
                    const float bias = rp[drow * 31 + dcol];
                    s[j] = ok ? s[j] + bias : -1e30f; }
            }
            S[grp][T] = s;
        }
    }
    float mx = -1e30f;
#pragma unroll
    for (int grp = G0; grp < 16; ++grp)
#pragma unroll
        for (int T = 0; T < 2; ++T) mx = fmaxf(mx, fmaxf(fmaxf(S[grp][T][0], S[grp][T][1]), fmaxf(S[grp][T][2], S[grp][T][3])));
    mx = fmaxf(mx, __shfl_xor(mx, 16)); mx = fmaxf(mx, __shfl_xor(mx, 32));
    float sum = 0.f;
#pragma unroll
    for (int grp = G0; grp < 16; ++grp)
#pragma unroll
        for (int T = 0; T < 2; ++T) {
#pragma unroll
            for (int j = 0; j < 4; ++j) { const float p = __expf(S[grp][T][j] - mx); S[grp][T][j] = p; sum += p; } }
    sum += __shfl_xor(sum, 16); sum += __shfl_xor(sum, 32);
    f32x4 O[4];
#pragma unroll
    for (int dt = 0; dt < 4; ++dt) O[dt] = (f32x4){0.f, 0.f, 0.f, 0.f};
#pragma unroll
    for (int grp = G0; grp < 16; ++grp) {
        const size_t base = grp < 8 ? (size_t)b * SEQ + (rs + grp) * 64 + ks : (size_t)ML + b * CTXL + 32 * (grp - 8);
        u32x4 pw; pw.x = pk2(S[grp][0][0], S[grp][0][1]); pw.y = pk2(S[grp][0][2], S[grp][0][3]); pw.z = pk2(S[grp][1][0], S[grp][1][1]); pw.w = pk2(S[grp][1][2], S[grp][1][3]);
        const bf16x8 pf = __builtin_bit_cast(bf16x8, pw);
#pragma unroll
        for (int dt = 0; dt < 4; ++dt) {
            const bf16x8 vf = *(const bf16x8*)(VT + (size_t)(h * 64 + 16 * dt + q) * MT + base + 8 * g);
            O[dt] = mfma16(vf, pf, O[dt]);
        }
        if (grp & 1) __builtin_amdgcn_sched_barrier(0);
    }
    const float inv = __builtin_amdgcn_rcpf(sum);
#pragma unroll
    for (int dt = 0; dt < 4; ++dt) { u32x2 w; w.x = pk2(O[dt][0] * inv, O[dt][1] * inv); w.y = pk2(O[dt][2] * inv, O[dt][3] * inv);
        *(u32x2*)(OO + qrow * DM + h * 64 + 16 * dt + 4 * g) = w; }
}
constexpr int AT_PITCH = 144;
template <bool CTXQ>
__device__ __forceinline__ void attn_super(const bf16_t* QO, bf16_t* OO, const bf16_t* Kb, const bf16_t* VT, const float* rpb, LAS unsigned char* lds, int tid_, int lane_, int wave, int st) {
    constexpr int G0 = CTXQ ? 8 : 0, I0 = CTXQ ? 9 : 0;
    const int tid = opaque_tid(), lane = tid & 63;
    const int q = lane & 15, g = lane >> 4;
    int b, h, r = 0, q0 = 0, ks = 0, rs = 0, kbase = 0, krl0 = 0; size_t qrow;
    if (CTXQ) { const int hf = st & 1; h = (st >> 1) & 15; b = st >> 5; qrow = (size_t)ML + b * CTXL + hf * 128 + wave * 16 + q; }
    else { const int rp = st & 31; h = (st >> 5) & 15; b = st >> 9; r = 2 * rp + (wave >> 2); q0 = (wave & 3) * 16; ks = min(max(q0 - 8, 0), 32); rs = min(max(r - 4, 0), 56);
        kbase = min(min(max(2 * rp - 4, 0), 56), 55); krl0 = rs - kbase; qrow = (size_t)b * SEQ + r * 64 + q0 + q; }
    u32x4 stg[13];
#pragma unroll
    for (int i = I0; i < 13; ++i) { const int c = tid + 512 * i, t = c >> 3, cc = c & 7;
        const size_t urow = t < 576 ? (size_t)b * SEQ + kbase * 64 + t : (size_t)ML + b * CTXL + (t - 576);
        stg[i] = *(const u32x4*)(Kb + urow * DM + h * 64 + cc * 8); }
    const bf16x8 qf0 = *(const bf16x8*)(QO + qrow * DM + h * 64 + 8 * g), qf1 = *(const bf16x8*)(QO + qrow * DM + h * 64 + 32 + 8 * g);
    LAS float* rpl = (LAS float*)(lds + 832 * AT_PITCH);
    if (!CTXQ) { if (tid < 465) rpl[tid] = rpb[h * 465 + tid]; }
#pragma unroll
    for (int i = I0; i < 13; ++i) { const int c = tid + 512 * i, t = c >> 3, cc = c & 7; *(LAS u32x4*)(lds + t * AT_PITCH + cc * 16) = stg[i]; }
    __syncthreads();
    const int qcol = q0 + q, wstart = min(max(qcol - 8, 0), 48);
    const int koff = 8 * (q >> 2) + (q & 3);
    f32x4 S[16][2];
#pragma unroll
    for (int grp = G0; grp < 16; ++grp) {
        const int tb = grp < 8 ? (krl0 + grp) * 64 + ks : 576 + 32 * (grp - 8);
#pragma unroll
        for (int T = 0; T < 2; ++T) {
            const LAS unsigned char* kp = lds + (tb + koff + 4 * T) * AT_PITCH + g * 16;
            const bf16x8 kf0 = *(const LAS bf16x8*)kp, kf1 = *(const LAS bf16x8*)(kp + 64);
            f32x4 s = {0.f, 0.f, 0.f, 0.f};
            s = mfma16(kf0, qf0, s); s = mfma16(kf1, qf1, s);
            if (grp < 8) {
                const int drow = rs + grp - r + 7;
#pragma unroll
                for (int j = 0; j < 4; ++j) { const int kcol = ks + 8 * g + 4 * T + j; const bool ok = (kcol >= wstart) && (kcol < wstart + 16);
                    const int dcol = min(max(kcol - qcol + 15, 0), 30);
                    const float bias = rpl[drow * 31 + dcol];
                    s[j] = ok ? s[j] + bias : -1e30f; }
            }
            S[grp][T] = s;
        }
        __builtin_amdgcn_sched_barrier(0);
    }
    __syncthreads();
    float mx = -1e30f;
#pragma unroll
    for (int grp = G0; grp < 16; ++grp)
#pragma unroll
        for (int T = 0; T < 2; ++T) mx = fmaxf(mx, fmaxf(fmaxf(S[grp][T][0], S[grp][T][1]), fmaxf(S[grp][T][2], S[grp][T][3])));
    mx = fmaxf(mx, __shfl_xor(mx, 16)); mx = fmaxf(mx, __shfl_xor(mx, 32));
    float sum = 0.f;
    u32x4 P[16];
#pragma unroll
    for (int grp = G0; grp < 16; ++grp) {
        float p[8];
#pragma unroll
        for (int T = 0; T < 2; ++T)
#pragma unroll
            for (int j = 0; j < 4; ++j) { p[4 * T + j] = __builtin_amdgcn_exp2f((S[grp][T][j] - mx) * 1.4426950408889634f); sum += p[4 * T + j]; }
        P[grp].x = pk2(p[0], p[1]); P[grp].y = pk2(p[2], p[3]); P[grp].z = pk2(p[4], p[5]); P[grp].w = pk2(p[6], p[7]);
        __builtin_amdgcn_sched_barrier(0);
    }
    sum += __shfl_xor(sum, 16); sum += __shfl_xor(sum, 32);
#pragma unroll
    for (int i = I0; i < 13; ++i) { const int d = (tid >> 3) & 63, cc = tid & 7;
        const size_t tokb = i < 9 ? (size_t)b * SEQ + (kbase + i) * 64 : (size_t)ML + b * CTXL + (i - 9) * 64;
        stg[i] = *(const u32x4*)(VT + (size_t)(h * 64 + d) * MT + tokb + cc * 8); }
#pragma unroll
    for (int i = I0; i < 13; ++i) { const int d = (tid >> 3) & 63, cc = tid & 7; *(LAS u32x4*)(lds + (i * 64 + d) * AT_PITCH + cc * 16) = stg[i]; }
    __syncthreads();
    f32x4 O[4];
#pragma unroll
    for (int dt = 0; dt < 4; ++dt) O[dt] = (f32x4){0.f, 0.f, 0.f, 0.f};
#pragma unroll
    for (int grp = G0; grp < 16; ++grp) {
        const int blk = grp < 8 ? krl0 + grp : 9 + ((grp - 8) >> 1), col = grp < 8 ? ks : 32 * ((grp - 8) & 1);
        const bf16x8 pf = __builtin_bit_cast(bf16x8, P[grp]);
#pragma unroll
        for (int dt = 0; dt < 4; ++dt) {
            const bf16x8 vf = *(const LAS bf16x8*)(lds + (blk * 64 + 16 * dt + q) * AT_PITCH + (col + 8 * g) * 2);
            O[dt] = mfma16(vf, pf, O[dt]);
        }
        if (grp & 1) __builtin_amdgcn_sched_barrier(0);
    }
    const float inv = __builtin_amdgcn_rcpf(sum);
#pragma unroll
    for (int dt = 0; dt < 4; ++dt) { u32x2 w; w.x = pk2(O[dt][0] * inv, O[dt][1] * inv); w.y = pk2(O[dt][2] * inv, O[dt][3] * inv);
        *(u32x2*)(OO + qrow * DM + h * 64 + 16 * dt + 4 * g) = w; }
    __syncthreads();
}
__device__ __forceinline__ void attn_phase(const bf16_t* QO, bf16_t* OO, const bf16_t* Kb, const bf16_t* VT, const float* rpb, LAS unsigned char* lds, int tid, int lane, int wave, int G) {
    const int bid = opaque_bid();
    if (G == 256) {
        const int x = bid & 7, c = bid >> 3;
        for (int it = 0; it < 16; ++it) attn_super<false>(QO, OO, Kb, VT, rpb, lds, tid, lane, wave, ((it * 8 + x) << 5) | c);
        attn_super<true>(QO, OO, Kb, VT, rpb, lds, tid, lane, wave, ((((c >> 1) * 8) + x) << 1) | (c & 1));
    } else {
        for (int st = bid; st < 4096; st += G) attn_super<false>(QO, OO, Kb, VT, rpb, lds, tid, lane, wave, st);
        for (int st = bid; st < 256; st += G) attn_super<true>(QO, OO, Kb, VT, rpb, lds, tid, lane, wave, st);
    }
}

__device__ __forceinline__ void lconv_phase(const bf16_t* REC, bf16_t* XR, const float* cw, const float* cbias, int tid, int G) {
#pragma unroll 1
    for (int it = opaque_bid() * 512 + tid; it < MT * 128; it += G * 512) { asm volatile("" : "+v"(it));
        const int row = it >> 7, ch = (it & 127) * 8;
        int pos, len; if (row < ML) { pos = row & (SEQ - 1); len = SEQ; } else { pos = (row - ML) & (CTXL - 1); len = CTXL; }
        float acc[8];
        { const f32x4 b0 = *(const f32x4*)(cbias + ch), b1 = *(const f32x4*)(cbias + ch + 4);
#pragma unroll
          for (int e = 0; e < 4; ++e) { acc[e] = b0[e]; acc[4 + e] = b1[e]; } }
#pragma unroll
        for (int k = 0; k < 4; ++k) { const int t = pos + k - 2;
            if (t >= 0 && t < len) {
                const u32x4 v = *(const u32x4*)(REC + (size_t)(row + k - 2) * DM + ch);
                const f32x4 w0 = *(const f32x4*)(cw + k * DM + ch), w1 = *(const f32x4*)(cw + k * DM + ch + 4);
                acc[0] += w0[0] * bflo(v.x); acc[1] += w0[1] * bfhi(v.x); acc[2] += w0[2] * bflo(v.y); acc[3] += w0[3] * bfhi(v.y);
                acc[4] += w1[0] * bflo(v.z); acc[5] += w1[1] * bfhi(v.z); acc[6] += w1[2] * bflo(v.w); acc[7] += w1[3] * bfhi(v.w);
            } }
        u32x4 o; o.x = pk2(acc[0], acc[1]); o.y = pk2(acc[2], acc[3]); o.z = pk2(acc[4], acc[5]); o.w = pk2(acc[6], acc[7]);
        *(u32x4*)(XR + (size_t)row * DM + ch) = o;
    }
}

template <int DIR, bool APPLY>
__device__ __forceinline__ void lru_sweep(const bf16_t* XR, const bf16_t* GATE, bf16_t* YP, const bf16_t* bdw_dir, float bias_r, float bias_i, float sp,
                                          int row0, int n, int half, int lane, float& hcar, float& ptot, unsigned (&hsf)[4][8]) {
    const int e = lane & 31, hh = lane >> 5;
    const int tau = 16 * ((e >> 2) & 1) + (e & 3) + 4 * (e >> 3);
    bf16x8 Br[4], Bi[4];
    const bf16_t* wrp = bdw_dir + (size_t)n * 4096 + (half * 32 + e) * 64 + 8 * hh;
    const bf16_t* wip = wrp + 16 * 4096;
#pragma unroll
    for (int kk = 0; kk < 4; ++kk) { Br[kk] = *(const bf16x8*)(wrp + 16 * kk); Bi[kk] = *(const bf16x8*)(wip + 16 * kk); }
    bf16x8 I0, I1;
#pragma unroll
    for (int jj = 0; jj < 8; ++jj) { I0[jj] = (8 * hh + jj == e) ? (short)0x3F80 : (short)0; I1[jj] = (16 + 8 * hh + jj == e) ? (short)0x3F80 : (short)0; }
    const bool first = (hh == DIR);
    const int chcol = n * 64 + half * 32;
    const float spm = -8.0f * 1.4426950408889634f * sp;
#pragma unroll
    for (int tt = 0; tt < 4; ++tt) {
        const int tile = DIR == 0 ? tt : 3 - tt; const int trow = row0 + tile * 32;
        const bf16_t* ap = XR + (size_t)(trow + tau) * DM + n * 64 + 8 * hh;
        bf16x8 A[4];
#pragma unroll
        for (int kk = 0; kk < 4; ++kk) A[kk] = *(const bf16x8*)(ap + 16 * kk);
        f32x16 ar, ai, xv;
#pragma unroll
        for (int r = 0; r < 16; ++r) { ar[r] = 0.f; ai[r] = 0.f; xv[r] = 0.f; }
#pragma unroll
        for (int kk = 0; kk < 4; ++kk) { ar = mfma32(A[kk], Br[kk], ar); ai = mfma32(A[kk], Bi[kk], ai); }
        const bf16x8 Ax0 = half ? A[2] : A[0], Ax1 = half ? A[3] : A[1];
        xv = mfma32(Ax0, I0, xv); xv = mfma32(Ax1, I1, xv);
        f32x16 av, bv;
#pragma unroll
        for (int r = 0; r < 16; ++r) {
            const float rg = sigmoidf_(ar[r] + bias_r), ig = sigmoidf_(ai[r] + bias_i);
            const float aa = __builtin_amdgcn_exp2f(rg * spm);
            av[r] = aa; bv[r] = __builtin_amdgcn_sqrtf(fmaxf(1.0f - aa * aa, 0.f)) * ig * xv[r];
        }
        float Hl = 0.f, Pl = 1.f;
#pragma unroll
        for (int rr = 0; rr < 16; ++rr) { const int r = DIR == 0 ? rr : 15 - rr; Hl = av[r] * Hl + bv[r]; Pl *= av[r]; }
        const float val = Hl + Pl * hcar, got = __shfl_xor(val, 32);
        const float start = first ? hcar : got;
        float endv;
        f32x16 hs;
        if (APPLY) {
            float hcur = start;
#pragma unroll
            for (int rr = 0; rr < 16; ++rr) { const int r = DIR == 0 ? rr : 15 - rr; hcur = av[r] * hcur + bv[r]; hs[r] = hcur; }
            endv = hcur;
        } else { endv = Hl + Pl * start; }
        const float got2 = __shfl_xor(endv, 32);
        hcar = first ? got2 : endv;
        if (!APPLY) ptot *= Pl * __shfl_xor(Pl, 32);
        if (APPLY) {
            if (DIR == 0) {
#pragma unroll
                for (int r2 = 0; r2 < 8; ++r2) hsf[tile][r2] = pk2(hs[2 * r2], hs[2 * r2 + 1]);
            }
            else {
                const bf16_t* gp = GATE + (size_t)(trow + tau) * DM + chcol + 8 * hh;
                const bf16x8 G0 = *(const bf16x8*)gp, G1 = *(const bf16x8*)(gp + 16);
                f32x16 gv;
#pragma unroll
                for (int r = 0; r < 16; ++r) gv[r] = 0.f;
                gv = mfma32(G0, I0, gv); gv = mfma32(G1, I1, gv);
                bf16_t* yp = YP + (size_t)(trow + 16 * hh) * DM + chcol + e;
#pragma unroll
                for (int r = 0; r < 16; ++r) { const float x = gv[r], u2 = 1.5957691216f * (x + 0.044715f * x * x * x);
                    const float hf = (r & 1) ? bfhi(hsf[tile][r >> 1]) : bflo(hsf[tile][r >> 1]);
                    const float y = (hf + hs[r]) * x * sigmoidf_(u2);
                    yp[(size_t)r * DM] = (bf16_t)f2bf(y); }
            }
        }
    }
}
template <bool APPLY>
__device__ __forceinline__ void lru_phase(const bf16_t* XR, const bf16_t* GATE, bf16_t* YP, const bf16_t* bdw_j, const float* ga_b, const float* gx_b, const float* lam, float* SUM,
                                          int lane, int gw, int NGW) {
    for (int task = gw; task < NB * NCHUNK * 32; task += NGW) {
        const int n2 = task & 31, c = (task >> 5) % NCHUNK, b = task / (32 * NCHUNK);
        const int row0 = c < 2 ? ML + b * CTXL + c * 128 : b * SEQ + (c - 2) * 128;
        const int n = n2 >> 1, half = n2 & 1, ch = n2 * 32 + (lane & 31);
        unsigned hsf[4][8];
#pragma unroll
        for (int dir = 0; dir < 2; ++dir) {
            const float bias_r = ga_b[dir * DM + ch], bias_i = gx_b[dir * DM + ch];
            const float sp = log1pf(__expf(-lam[dir * DM + ch]));
            const int p = dir == 0 ? c : (c < 2 ? 1 - c : 35 - c);
            float* sump = SUM + ((size_t)(dir * NB + b) * NCHUNK) * DM * 2 + (size_t)ch * 2;
            float hcar = 0.f, ptot = 1.f;
            if (APPLY) { for (int pp = 0; pp < p; ++pp) { const float2 ph = *(const float2*)(sump + (size_t)pp * DM * 2); hcar = ph.x * hcar + ph.y; } }
            if (dir == 0) lru_sweep<0, APPLY>(XR, GATE, YP, bdw_j, bias_r, bias_i, sp, row0, n, half, lane, hcar, ptot, hsf);
            else lru_sweep<1, APPLY>(XR, GATE, YP, bdw_j + 2 * 16 * 4096, bias_r, bias_i, sp, row0, n, half, lane, hcar, ptot, hsf);
            if (!APPLY) { if (lane < 32) *(float2*)(sump + (size_t)p * DM * 2) = make_float2(ptot, hcar); }
        }
    }
}

template <int DIR>
__device__ __forceinline__ void lru_dir(const bf16_t* XR, const bf16_t* GATE, bf16_t* YP, u32x4* HSF, const bf16_t* bdw_dir, float bias_r, float bias_i, float sp,
                                        int b, int n2, int lane, int wave, LAS float* xl) {
    const int e = lane & 31, hh = lane >> 5, n = n2 >> 1, half = n2 & 1;
    const int tau = 16 * ((e >> 2) & 1) + (e & 3) + 4 * (e >> 3);
    bf16x8 Br[4], Bi[4];
    const bf16_t* wrp = bdw_dir + (size_t)n * 4096 + (half * 32 + e) * 64 + 8 * hh;
    const bf16_t* wip = wrp + 16 * 4096;
#pragma unroll
    for (int kk = 0; kk < 4; ++kk) { Br[kk] = *(const bf16x8*)(wrp + 16 * kk); Bi[kk] = *(const bf16x8*)(wip + 16 * kk); }
    bf16x8 I0, I1;
#pragma unroll
    for (int jj = 0; jj < 8; ++jj) { I0[jj] = (8 * hh + jj == e) ? (short)0x3F80 : (short)0; I1[jj] = (16 + 8 * hh + jj == e) ? (short)0x3F80 : (short)0; }
    const bool first = (hh == DIR);
    const int chcol = n * 64 + half * 32;
    const float spm = -8.0f * 1.4426950408889634f * sp;
    float segcar = 0.f;
#pragma unroll 1
    for (int seg = 0; seg < 9; ++seg) {
        f32x16 av[2], bv[2]; float Hl[2], Pl[2]; int trow[2]; bool valid[2];
        float hloc = 0.f, ploc = 1.f;
#pragma unroll
        for (int k = 0; k < 2; ++k) {
            const int q = seg * 16 + wave * 2 + k; valid[k] = q < 136;
            const int T = DIR == 0 ? q : (q < 8 ? 7 - q : 143 - q);
            trow[k] = T < 8 ? ML + b * CTXL + 32 * T : b * SEQ + 32 * (T - 8);
            if (valid[k]) {
                const bf16_t* ap = XR + (size_t)(trow[k] + tau) * DM + n * 64 + 8 * hh;
                bf16x8 A[4];
#pragma unroll
                for (int kk = 0; kk < 4; ++kk) A[kk] = *(const bf16x8*)(ap + 16 * kk);
                f32x16 ar, ai, xv;
#pragma unroll
                for (int r = 0; r < 16; ++r) { ar[r] = 0.f; ai[r] = 0.f; xv[r] = 0.f; }
#pragma unroll
                for (int kk = 0; kk < 4; ++kk) { ar = mfma32(A[kk], Br[kk], ar); ai = mfma32(A[kk], Bi[kk], ai); }
                const bf16x8 Ax0 = half ? A[2] : A[0], Ax1 = half ? A[3] : A[1];
                xv = mfma32(Ax0, I0, xv); xv = mfma32(Ax1, I1, xv);
#pragma unroll
                for (int r = 0; r < 16; ++r) {
                    const float rg = sigmoidf_(ar[r] + bias_r), ig = sigmoidf_(ai[r] + bias_i);
                    const float aa = __builtin_amdgcn_exp2f(rg * spm);
                    av[k][r] = aa; bv[k][r] = __builtin_amdgcn_sqrtf(fmaxf(1.0f - aa * aa, 0.f)) * ig * xv[r];
                }
            } else {
#pragma unroll
                for (int r = 0; r < 16; ++r) { av[k][r] = 1.0f; bv[k][r] = 0.0f; }
            }
            float H = 0.f, P = 1.f;
#pragma unroll
            for (int rr = 0; rr < 16; ++rr) { const int r = DIR == 0 ? rr : 15 - rr; H = av[k][r] * H + bv[k][r]; P *= av[k][r]; }
            Hl[k] = H; Pl[k] = P;
            const float val = H + P * hloc, got = __shfl_xor(val, 32);
            const float st2 = first ? hloc : got;
            const float endv = H + P * st2, got2 = __shfl_xor(endv, 32);
            hloc = first ? got2 : endv;
            ploc *= P * __shfl_xor(P, 32);
        }
        LAS float* slot = xl + ((seg & 1) * 8 + wave) * 64 + e * 2;
        if (lane < 32) { slot[0] = ploc; slot[1] = hloc; }
        __syncthreads();
        float c = segcar, hcar = segcar;
#pragma unroll
        for (int w = 0; w < 8; ++w) { const LAS float* sp_ = xl + ((seg & 1) * 8 + w) * 64 + e * 2; const float P = sp_[0], H = sp_[1]; if (w == wave) hcar = c; c = P * c + H; }
        segcar = c;
#pragma unroll
        for (int k = 0; k < 2; ++k) {
            if (valid[k]) {
                const float val = Hl[k] + Pl[k] * hcar, got = __shfl_xor(val, 32);
                float hcur = first ? hcar : got;
                f32x16 hs;
#pragma unroll
                for (int rr = 0; rr < 16; ++rr) { const int r = DIR == 0 ? rr : 15 - rr; hcur = av[k][r] * hcur + bv[k][r]; hs[r] = hcur; }
                const float got2 = __shfl_xor(hcur, 32);
                hcar = first ? got2 : hcur;
                const int tg = trow[k] < ML ? (trow[k] >> 12) * 136 + 8 + ((trow[k] & (SEQ - 1)) >> 5) : b * 136 + ((trow[k] - ML - b * CTXL) >> 5);
                u32x4* hp = HSF + (((size_t)tg * 32 + n2) * 64 + lane) * 2;
                if (DIR == 0) {
                    u32x4 w0, w1;
                    w0.x = pk2(hs[0], hs[1]); w0.y = pk2(hs[2], hs[3]); w0.z = pk2(hs[4], hs[5]); w0.w = pk2(hs[6], hs[7]);
                    w1.x = pk2(hs[8], hs[9]); w1.y = pk2(hs[10], hs[11]); w1.z = pk2(hs[12], hs[13]); w1.w = pk2(hs[14], hs[15]);
                    hp[0] = w0; hp[1] = w1;
                } else {
                    const u32x4 w0 = hp[0], w1 = hp[1];
                    const unsigned hw[8] = {w0.x, w0.y, w0.z, w0.w, w1.x, w1.y, w1.z, w1.w};
                    const bf16_t* gp = GATE + (size_t)(trow[k] + tau) * DM + chcol + 8 * hh;
                    const bf16x8 G0 = *(const bf16x8*)gp, G1 = *(const bf16x8*)(gp + 16);
                    f32x16 gv;
#pragma unroll
                    for (int r = 0; r < 16; ++r) gv[r] = 0.f;
                    gv = mfma32(G0, I0, gv); gv = mfma32(G1, I1, gv);
                    bf16_t* yp = YP + (size_t)(trow[k] + 16 * hh) * DM + chcol + e;
#pragma unroll
                    for (int r = 0; r < 16; ++r) { const float x = gv[r], u2 = 1.5957691216f * (x + 0.044715f * x * x * x);
                        const float hf = (r & 1) ? bfhi(hw[r >> 1]) : bflo(hw[r >> 1]);
                        const float y = (hf + hs[r]) * x * sigmoidf_(u2);
                        yp[(size_t)r * DM] = (bf16_t)f2bf(y); }
                }
            }
        }
    }
}
__device__ __forceinline__ void lru_block_phase(const bf16_t* XR, const bf16_t* GATE, bf16_t* YP, u32x4* HSF, const bf16_t* bdw_j, const float* ga_b, const float* gx_b, const float* lam,
                                                LAS unsigned char* lds, int lane, int wave, int G) {
    LAS float* xl = (LAS float*)lds;
    for (int item = opaque_bid(); item < NB * 32; item += G) {
        const int b = item >> 5, n2 = item & 31, ch = n2 * 32 + (lane & 31);
        { const float bias_r = ga_b[ch], bias_i = gx_b[ch], sp = log1pf(__expf(-lam[ch]));
          lru_dir<0>(XR, GATE, YP, HSF, bdw_j, bias_r, bias_i, sp, b, n2, lane, wave, xl); }
        __syncthreads();
        { const float bias_r = ga_b[DM + ch], bias_i = gx_b[DM + ch], sp = log1pf(__expf(-lam[DM + ch]));
          lru_dir<1>(XR, GATE, YP, HSF, bdw_j + 2 * 16 * 4096, bias_r, bias_i, sp, b, n2, lane, wave, xl); }
        __syncthreads();
    }
}

__device__ __forceinline__ void fconv_phase(const bf16_t* U, bf16_t* Gb, const float* cw, const float* cbias, int rbeg, int nrows, int tid, int G) {
    const int total = nrows * 384;
#pragma unroll 1
    for (int it = opaque_bid() * 512 + tid; it < total; it += G * 512) { asm volatile("" : "+v"(it));
        const int r = it / 384, ch = (it % 384) * 8, row = rbeg + r;
        int pos, len; if (row < ML) { pos = row & (SEQ - 1); len = SEQ; } else { pos = (row - ML) & (CTXL - 1); len = CTXL; }
        float va[8], ga[8];
        { const f32x4 b0 = *(const f32x4*)(cbias + ch), b1 = *(const f32x4*)(cbias + ch + 4), c0 = *(const f32x4*)(cbias + DFF + ch), c1 = *(const f32x4*)(cbias + DFF + ch + 4);
#pragma unroll
          for (int e = 0; e < 4; ++e) { va[e] = b0[e]; va[4 + e] = b1[e]; ga[e] = c0[e]; ga[4 + e] = c1[e]; } }
#pragma unroll
        for (int k = 0; k < 3; ++k) { const int t = pos + k - 1;
            if (t >= 0 && t < len) {
                const bf16_t* up = U + (size_t)(r + k - 1) * 6144 + ch;
                const u32x4 v = *(const u32x4*)up, gq = *(const u32x4*)(up + DFF);
                const float* wp = cw + (size_t)k * 6144 + ch;
                const f32x4 w0 = *(const f32x4*)wp, w1 = *(const f32x4*)(wp + 4), x0 = *(const f32x4*)(wp + DFF), x1 = *(const f32x4*)(wp + DFF + 4);
                va[0] += w0[0] * bflo(v.x); va[1] += w0[1] * bfhi(v.x); va[2] += w0[2] * bflo(v.y); va[3] += w0[3] * bfhi(v.y);
                va[4] += w1[0] * bflo(v.z); va[5] += w1[1] * bfhi(v.z); va[6] += w1[2] * bflo(v.w); va[7] += w1[3] * bfhi(v.w);
                ga[0] += x0[0] * bflo(gq.x); ga[1] += x0[1] * bfhi(gq.x); ga[2] += x0[2] * bflo(gq.y); ga[3] += x0[3] * bfhi(gq.y);
                ga[4] += x1[0] * bflo(gq.z); ga[5] += x1[1] * bfhi(gq.z); ga[6] += x1[2] * bflo(gq.w); ga[7] += x1[3] * bfhi(gq.w);
            } }
        float o[8];
#pragma unroll
        for (int e = 0; e < 8; ++e) o[e] = va[e] * ga[e] * sigmoidf_(ga[e]);
        u32x4 w; w.x = pk2(o[0], o[1]); w.y = pk2(o[2], o[3]); w.z = pk2(o[4], o[5]); w.w = pk2(o[6], o[7]);
        *(u32x4*)(Gb + (size_t)r * DFF + ch) = w;
    }
}

template <int OP>
__device__ __forceinline__ void run_op(const Args& a, LAS unsigned char* lds, const int li, const int arg, const int rep) {
    const int tid = opaque_tid(), lane = tid & 63, wave = __builtin_amdgcn_readfirstlane(tid >> 6), G = gridDim.x;
    const int gw = opaque_bid() * 8 + wave, NGW = G * 8;
    unsigned char* ws = a.ws;
    float* MODS = (float*)(ws + WS_MODS);
    float* SUM = (float*)(ws + WS_SUM);
    bf16_t* BDW = (bf16_t*)(ws + WS_BDW);
    float* CTXR = (float*)(ws + WS_CTXR);
    bf16_t* WB = (bf16_t*)(ws + WS_WB);
    bf16_t* HN = (bf16_t*)(ws + WS_HN);
    bf16_t* RR = (bf16_t*)(ws + WS_R);
    const int j = li >> 1;
    const float* mods_l = MODS + (size_t)li * 9 * 6144;
    if constexpr (OP == OP_PRO) {
        prologue(a, lds, tid, lane, wave, G);
    } else if constexpr (OP == OP_NORM) {
        const bool first = (li == 0 && arg == 0);
        const float* gain = (arg ? a.in[7] : a.in[6]) + (size_t)li * DM;
        const int nrows = (arg == 1 && li == 3) ? ML : MT;
        const int npart = first ? 0 : (arg == 1 ? (li == 3 ? 0 : 4) : 6);
        const float* pgate = arg == 1 ? mods_l + 8 * 6144 + 2 * DM : MODS + (size_t)(li - 1) * 9 * 6144 + 8 * 6144 + 5 * DM;
        norm_phase(first ? a.in[0] : a.out, CTXR, HN, gain, mods_l, arg * 3, nrows, lane, gw, NGW, CTXR, (const float*)(ws + WS_PART), npart, pgate);
    } else if constexpr (OP == OP_GQK) {
        pg8::Gemm g{HN, WB + (size_t)j * 4 * MEL, MT, 2048, DM, 0, 0};
        pg8::StaticOrder S; S.init(g.M, g.N, G, opaque_bid());
        EpiQK E{RR + R_Q, RR + R_K, a.in[9] + j * HD, a.in[10] + j * HD};
        pg8::gemm_phase<EpiQK, pg8::StaticOrder>(lds, g, S, E);
    } else if constexpr (OP == OP_GST) {
        pg8::Gemm g; EpiStore E; int c = opaque_bid();
        if (arg == 0) { g = pg8::Gemm{WB + (size_t)j * 4 * MEL + 2 * MEL, HN, DM, MT, DM, 0, 0}; E = EpiStore{RR + R_VT, MT, 0, 0}; c = (c + G - (64 % G)) % G; }
        else if (arg == 1) { g = pg8::Gemm{HN, WB + 8 * MEL + (size_t)j * 3 * MEL, MT, 2048, DM, 0, 0}; E = EpiStore{RR + R_GATE, DM, DM, (size_t)MT * DM}; }
        else { const int rbeg = arg == 2 ? 0 : 16384, nrows = arg == 2 ? 16384 : (li == 3 ? 16384 : 18432);
            g = pg8::Gemm{HN + (size_t)rbeg * DM, WB + 14 * MEL + (size_t)li * 9 * MEL, nrows, 6144, DM, 0, 0}; E = EpiStore{RR + R_U, 6144, 0, 0}; }
        pg8::StaticOrder S; S.init(g.M, g.N, G, c);
        pg8::gemm_phase<EpiStore, pg8::StaticOrder>(lds, g, S, E);
    } else if constexpr (OP == OP_GRES) {
        pg8::Gemm g; EpiRes E;
        const bool l0 = (li == 0 && arg == 0);
        E.in_lat = l0 ? a.in[0] : a.out; E.in_ctx = CTXR; E.out_lat = a.out; E.out_ctx = CTXR; E.row_off = 0;
        const bf16_t* Ap; const bf16_t* Bp; int Kd, gidx;
        if (arg == 0) { gidx = 2; Kd = DM;
            if (li & 1) { Ap = RR + R_YP; Bp = WB + 8 * MEL + (size_t)j * 3 * MEL + 2 * MEL; } else { Ap = RR + R_Q; Bp = WB + (size_t)j * 4 * MEL + 3 * MEL; }
        } else { gidx = 5; Kd = DFF; Ap = RR + R_G; Bp = WB + 14 * MEL + (size_t)li * 9 * MEL + 6 * MEL; }
        E.gate = mods_l + gidx * DM;
        g = pg8::Gemm{Ap, Bp, ML, DM, Kd, 0, 0};
        pg8::StaticOrder S; S.init(g.M, g.N, G, opaque_bid());
        pg8::gemm_phase<EpiRes, pg8::StaticOrder>(lds, g, S, E);
        if (li != 3) {
            const int nkc = Kd == DFF ? 6 : 4;
            pg8::Gemm g2{Ap, Bp, MT, DM, Kd / nkc, 0, Kd};
            CtxSplitOrder S2{nkc, G, opaque_bid(), ML / 256};
            EpiPart E2{(float*)(ws + WS_PART)};
            pg8::gemm_phase<EpiPart, CtxSplitOrder>(lds, g2, S2, E2);
        }
    } else if constexpr (OP == OP_GUP) {
        pg8::Gemm g{HN - DM, WB + 14 * MEL + (size_t)li * 9 * MEL, 138 * 256, 6144, DM, 254, 0};
        pg8::StaticOrder S; S.init(g.M, g.N, G, opaque_bid());
        EpiUpConv E{RR + R_G, a.in[23] + (size_t)li * 3 * 6144, a.in[24] + (size_t)li * 6144, (LAS float*)(lds + 132096)};
        pg8::gemm_phase<EpiUpConv, pg8::StaticOrder>(lds, g, S, E);
    } else if constexpr (OP == OP_ATTN) {
        attn_phase(RR + R_Q, rep ? RR + R_YP : RR + R_Q, RR + R_K, RR + R_VT, a.in[11] + (size_t)j * NH * 465, lds, tid, lane, wave, G);
    } else if constexpr (OP == OP_LCONV) {
        lconv_phase(RR + R_REC, RR + R_XR, a.in[14] + (size_t)j * 4 * DM, a.in[15] + (size_t)j * DM, tid, G);
    } else if constexpr (OP == OP_LRUA) {
    } else if constexpr (OP == OP_LRUC) {
        lru_block_phase(RR + R_XR, RR + R_GATE, RR + R_YP, (u32x4*)HN, BDW + (size_t)j * 4 * 16 * 4096, a.in[17] + (size_t)j * 2 * DM, a.in[19] + (size_t)j * 2 * DM, a.in[20] + (size_t)j * 2 * DM, lds, lane, wave, G);
    } else if constexpr (OP == OP_FCONV) {
        const int rbeg = arg == 2 ? 0 : 16384, nrows = arg == 2 ? 16384 : (li == 3 ? 16384 : 18432);
        fconv_phase(RR + R_U, RR + R_G, a.in[23] + (size_t)li * 3 * 6144, a.in[24] + (size_t)li * 6144, rbeg, nrows, tid, G);
    }
}

#ifdef MULTI_LAUNCH
template <int OP> __global__ void __launch_bounds__(512, 2) op_kernel(Args a, int li, int arg) {
    extern __shared__ __attribute__((aligned(16))) unsigned char lds_raw[];
    run_op<OP>(a, (LAS unsigned char*)lds_raw, li, arg, 0);
}
template <int OP> static void launch_op(const Args& a, int li, int arg, int grid, hipStream_t stream) {
    static bool attr = false;
    if (!attr) { (void)hipFuncSetAttribute((const void*)op_kernel<OP>, hipFuncAttributeMaxDynamicSharedMemorySize, LDS_BYTES); attr = true; }
    hipLaunchKernelGGL(op_kernel<OP>, dim3(grid), dim3(512), LDS_BYTES, stream, a, li, arg);
}
#else
__global__ void __launch_bounds__(512, 2) fwd_kernel(Args a) {
    extern __shared__ __attribute__((aligned(16))) unsigned char lds_raw[];
    LAS unsigned char* lds = (LAS unsigned char*)lds_raw;
    cg::grid_group grid = cg::this_grid();
    volatile LAS unsigned* bst = (volatile LAS unsigned*)(lds + 131072 + 64);
    if (threadIdx.x < 4) bst[threadIdx.x] = 0u;
    __syncthreads();
    const XcdBarrier bar = xcd_barrier_post((unsigned*)(a.ws + WS_BAR), bst);
    typedef const __attribute__((address_space(4))) Args* KArgP;
    const int pc_lo = a.pc_lo, pc_hi = a.pc_hi;
    for (int pc = pc_lo; pc < pc_hi; ++pc) {
        const int op = PROG[pc][0], li = PROG[pc][1], arg = PROG[pc][2], sync = PROG[pc][3];
        KArgP kap = (KArgP)__builtin_amdgcn_kernarg_segment_ptr();
        asm volatile("" : "+s"(kap));
        const Args& a = *(const Args*)kap;
        const int rep = (op == OP_ATTN) ? arg : 0;
        switch (op) {
            case OP_PRO: run_op<OP_PRO>(a, lds, li, arg, rep); break;
            case OP_NORM: run_op<OP_NORM>(a, lds, li, arg, rep); break;
            case OP_GQK: run_op<OP_GQK>(a, lds, li, arg, rep); break;
            case OP_GST: run_op<OP_GST>(a, lds, li, arg, rep); break;
            case OP_GRES: run_op<OP_GRES>(a, lds, li, arg, rep); break;
            case OP_ATTN: run_op<OP_ATTN>(a, lds, li, arg, rep); break;
            case OP_LCONV: run_op<OP_LCONV>(a, lds, li, arg, rep); break;
            case OP_LRUA: run_op<OP_LRUA>(a, lds, li, arg, rep); break;
            case OP_LRUC: run_op<OP_LRUC>(a, lds, li, arg, rep); break;
            default: run_op<OP_GUP>(a, lds, li, arg, rep); break;
        }
        if (sync && pc + 1 < pc_hi) { if (pc == 0) grid.sync(); else xcd_barrier(bar); }
    }
}
#endif

extern "C" void kernel_launch(void* const* d_in, const int* in_sizes, int n_in, void* d_out, int out_size, void* d_ws, size_t ws_size, hipStream_t stream) {
    static int grid = 0;
    if (grid == 0) {
        if (n_in != 26 || out_size != ML * DM || ws_size < WS_END) { fprintf(stderr, "kernel_launch: unexpected shapes: n_in %d out %d ws %zu (need %zu)\n", n_in, out_size, ws_size, (size_t)WS_END); grid = -1; return; }
        int dev = 0, cus = 0, per_cu = 1;
        (void)hipGetDevice(&dev);
        (void)hipDeviceGetAttribute(&cus, hipDeviceAttributeMultiprocessorCount, dev);
#ifndef MULTI_LAUNCH
        if (hipFuncSetAttribute((const void*)fwd_kernel, hipFuncAttributeMaxDynamicSharedMemorySize, LDS_BYTES) != hipSuccess) { fprintf(stderr, "kernel_launch: hipFuncSetAttribute failed\n"); grid = -1; return; }
        if (hipOccupancyMaxActiveBlocksPerMultiprocessor(&per_cu, (const void*)fwd_kernel, 512, LDS_BYTES) != hipSuccess || per_cu < 1) { fprintf(stderr, "kernel_launch: occupancy query gave %d\n", per_cu); per_cu = 1; }
        (void)hipGetLastError();
#endif
        grid = cus * per_cu;
        fprintf(stderr, "kernel_launch: grid %d (cus %d x %d), ws %zu\n", grid, cus, per_cu, ws_size);
    }
    if (grid < 0) return;
    Args a{};
    for (int i = 0; i < 26; ++i) a.in[i] = (const float*)d_in[i];
    a.out = (float*)d_out; a.ws = (unsigned char*)d_ws;
    a.pc_lo = 0; a.pc_hi = NPROG;
#ifdef MULTI_LAUNCH
    for (int pc = 0; pc < NPROG; ++pc) {
        const int op = HOSTPROG[pc][0], li = HOSTPROG[pc][1], arg = HOSTPROG[pc][2];
        switch (op) {
            case OP_PRO: launch_op<OP_PRO>(a, li, arg, grid, stream); break;
            case OP_NORM: launch_op<OP_NORM>(a, li, arg, grid, stream); break;
            case OP_GQK: launch_op<OP_GQK>(a, li, arg, grid, stream); break;
            case OP_GST: launch_op<OP_GST>(a, li, arg, grid, stream); break;
            case OP_GRES: launch_op<OP_GRES>(a, li, arg, grid, stream); break;
            case OP_ATTN: launch_op<OP_ATTN>(a, li, arg, grid, stream); break;
            case OP_LCONV: launch_op<OP_LCONV>(a, li, arg, grid, stream); break;
            case OP_LRUA: launch_op<OP_LRUA>(a, li, arg, grid, stream); break;
            case OP_LRUC: launch_op<OP_LRUC>(a, li, arg, grid, stream); break;
            default: launch_op<OP_GUP>(a, li, arg, grid, stream); break;
        }
    }
#else
    (void)hipMemsetAsync((char*)d_ws + WS_BAR, 0, 16384, stream);
    void* args[] = {&a};
    hipError_t e = hipLaunchCooperativeKernel((const void*)fwd_kernel, dim3(grid), dim3(512), args, LDS_BYTES, stream);
    if (e != hipSuccess) fprintf(stderr, "kernel_launch: cooperative launch failed: %s (grid %d)\n", hipGetErrorString(e), grid);
#endif
}
```

```cpp
#include <hip/hip_runtime.h>
#include <hip/hip_cooperative_groups.h>
#include <cstdio>
#include <cstdint>
namespace cg = cooperative_groups;
__device__ __forceinline__ int opaque_tid() { int t; asm volatile("v_mov_b32 %0, %1" : "=v"(t) : "v"((int)threadIdx.x)); return t; }
__device__ __forceinline__ int opaque_bid() { int t; asm volatile("s_mov_b32 %0, %1" : "=s"(t) : "s"((int)blockIdx.x)); return t; }
#define LAS __attribute__((address_space(3)))
namespace pg8 {
#define PG8_LAS __attribute__((address_space(3)))
typedef unsigned short bf16_t;
typedef short bf16x8 __attribute__((ext_vector_type(8)));
typedef float f32x4 __attribute__((ext_vector_type(4)));
typedef unsigned u32x4 __attribute__((ext_vector_type(4)));
constexpr int BM = 256, BK = 64, HALF = 128, HTB = HALF * BK * 2  , STAGE_BYTES = 8 * HTB, NXCD = 8, WGM = 8;

__host__ __device__ __forceinline__ int lds_byte(int r, int c) { const int st = (r >> 4) * 2 + (c >> 5), rr = r & 15, cc = c & 31, ob = rr * 64 + cc * 2; return st * 1024 + (ob ^ (((ob >> 9) & 1) << 5)); }
__host__ __device__ __forceinline__ void stage_rc(int b, int& R, int& C) { const int st = b / 1024, sb = b % 1024, swz = sb ^ (((sb >> 9) & 1) << 5); R = (st >> 1) * 16 + swz / 64; C = (st & 1) * 32 + (swz % 64) / 2; }
__host__ __device__ __forceinline__ int perm32(int rho) { const int n = rho >> 4, i = rho & 15; return 8 * (i >> 2) + 4 * n + (i & 3); }

struct Unit { int pm, pn, kc; };
struct Gemm { const bf16_t* A; const bf16_t* Bt; int M, N, K; int a_step_rows; int ldk; };

struct StaticOrder {
    int nM, nN, nwg, G, c;
    __host__ __device__ void init(int M, int N, int G_, int c_) { nM = M / BM; nN = N / BM; nwg = nM * nN; G = G_; c = c_; }
    __host__ __device__ bool next(int i, Unit& u) const {
        const long L = (long)i * G + c; if (L >= nwg) return false;
        int wgid = (int)L; { const int q = nwg / NXCD, r = nwg % NXCD, xcd = wgid % NXCD, off = wgid / NXCD; wgid = (xcd < r ? xcd * (q + 1) : r * (q + 1) + (xcd - r) * q) + off; }
        const int nig = WGM * nN, gid = wgid / nig, fm = gid * WGM, gsz = (nM - fm) < WGM ? (nM - fm) : WGM;
        u.pm = fm + ((wgid % nig) % gsz); u.pn = (wgid % nig) / gsz; u.kc = 0; return true;
    }
    __device__ __forceinline__ void a_ready(const Unit&) const {}
    __device__ __forceinline__ void done(const Unit&) const {}
};
__device__ __forceinline__ unsigned cvt_pk_bf16(float lo, float hi) { unsigned r; asm volatile("v_cvt_pk_bf16_f32 %0, %1, %2" : "=v"(r) : "v"(lo), "v"(hi)); return r; }
template <class Epi, class Sched>
__device__ __forceinline__ void gemm_phase(PG8_LAS unsigned char* lds, const Gemm g, const Sched& S, const Epi& E) {
    const int tid = opaque_tid(), wid = __builtin_amdgcn_readfirstlane(tid >> 6), lane = tid & 63, wr = wid >> 2, wc = wid & 3, fr = lane & 15, fq = lane >> 4;
    const int K = g.K, nt = K / BK, P = g.ldk ? g.ldk : K;
    unsigned voffA[2], voffB[2];
#pragma unroll
    for (int i = 0; i < 2; ++i) { int R, C; stage_rc(tid * 16 + i * 8192, R, C); const int Rb = Epi::PERM ? ((R & ~31) + perm32(R & 31)) : R;
        voffA[i] = (unsigned)(R * P + C) * 2u; voffB[i] = (unsigned)(Rb * P + C) * 2u; }
    const size_t kstep = (size_t)(BK * 2);
    const size_t hstep = (size_t)HALF * P * 2;
    const size_t tstep = 2 * hstep; const size_t tstepA = g.a_step_rows ? (size_t)g.a_step_rows * P * 2 : tstep; const size_t cstep = (size_t)K * 2;
    const unsigned ldsw = (unsigned)wid * 1024u;
    const int aoff = lds_byte(wr * 64 + fr, fq * 8), boff = lds_byte(wc * 32 + fr, fq * 8);
#define PG8_SA(b, h) (((b) * 2 + (h)) * HTB)
#define PG8_SB(b, h) ((4 + (b) * 2 + (h)) * HTB)
#define PG8_STAGE(bufoff, gbase, voff) do { _Pragma("unroll") for (int _i = 0; _i < 2; ++_i) \
        __builtin_amdgcn_global_load_lds((const unsigned*)((const char*)(gbase) + (voff)[_i]), (PG8_LAS unsigned*)(lds + (bufoff) + ldsw + _i * 8192), 16, 0, 0); } while (0)
#define PG8_LDA(dst, b, h) do { _Pragma("unroll") for (int m = 0; m < 4; ++m) _Pragma("unroll") for (int k = 0; k < 2; ++k) dst[m][k] = *(const PG8_LAS bf16x8*)(lds + PG8_SA(b, h) + aoff + m * 2048 + k * 1024); } while (0)
#define PG8_LDB(dst, b, h) do { _Pragma("unroll") for (int n = 0; n < 2; ++n) _Pragma("unroll") for (int k = 0; k < 2; ++k) dst[n][k] = *(const PG8_LAS bf16x8*)(lds + PG8_SB(b, h) + boff + n * 2048 + k * 1024); } while (0)
#define PG8_MMA(ai, bj, At, Bt) do { __builtin_amdgcn_s_setprio(1); _Pragma("unroll") for (int m = 0; m < 4; ++m) _Pragma("unroll") for (int n = 0; n < 2; ++n) _Pragma("unroll") for (int k = 0; k < 2; ++k) \
        acc[ai][bj][m][n] = __builtin_amdgcn_mfma_f32_16x16x32_bf16(Bt[n][k], At[m][k], acc[ai][bj][m][n], 0, 0, 0); __builtin_amdgcn_s_setprio(0); } while (0)
#define PG8_WAIT_V(n) asm volatile("s_waitcnt vmcnt(" #n ")" ::: "memory")
#define PG8_WAIT_L(n) asm volatile("s_waitcnt lgkmcnt(" #n ")" ::: "memory")
#define PG8_BAR __builtin_amdgcn_s_barrier()
#define PG8_SCHED __builtin_amdgcn_sched_barrier(0)
    Unit cur, nxt; int ui = 0;
    if (!S.next(0, cur)) return;
    f32x4 acc[2][2][4][2];
#pragma unroll
    for (int a = 0; a < 2; ++a)
#pragma unroll
        for (int b = 0; b < 2; ++b)
#pragma unroll
            for (int m = 0; m < 4; ++m)
#pragma unroll
                for (int n = 0; n < 2; ++n) acc[a][b][m][n] = (f32x4){0.f, 0.f, 0.f, 0.f};
    bf16x8 At[4][2], B0[2][2], B1[2][2];
    const char* cA = (const char*)g.A + (size_t)cur.pm * tstepA + (size_t)cur.kc * cstep; const char* cB = (const char*)g.Bt + (size_t)cur.pn * tstep + (size_t)cur.kc * cstep;
    S.a_ready(cur);
    PG8_STAGE(PG8_SB(0, 0), cB, voffB); PG8_STAGE(PG8_SA(0, 0), cA, voffA); PG8_STAGE(PG8_SB(0, 1), cB + hstep, voffB); PG8_STAGE(PG8_SA(0, 1), cA + hstep, voffA);
    if (wr == 1) PG8_BAR;
    PG8_WAIT_V(4); PG8_BAR;
    PG8_STAGE(PG8_SB(1, 0), cB + kstep, voffB); PG8_STAGE(PG8_SA(1, 0), cA + kstep, voffA); PG8_STAGE(PG8_SB(1, 1), cB + hstep + kstep, voffB);
    PG8_WAIT_V(6); PG8_BAR;
    for (;;) {
        const bool has_next = S.next(ui + 1, nxt);
        const char* nA = has_next ? (const char*)g.A + (size_t)nxt.pm * tstepA + (size_t)nxt.kc * cstep : cA; const char* nB = has_next ? (const char*)g.Bt + (size_t)nxt.pn * tstep + (size_t)nxt.kc * cstep : cB;
        for (int t = 0; t < nt; t += 2) {
            const bool last = (t == nt - 2);
            const char* a1 = cA + (size_t)(t + 1) * kstep;
            const char* a2 = last ? nA : cA + (size_t)(t + 2) * kstep; const char* b2 = last ? nB : cB + (size_t)(t + 2) * kstep;
            const char* a3 = a2 + kstep; const char* b3 = b2 + kstep;
            if (last && has_next) S.a_ready(nxt);
            PG8_LDB(B0, 0, 0); PG8_SCHED; PG8_LDA(At, 0, 0); PG8_STAGE(PG8_SA(1, 1), a1 + hstep, voffA);
            PG8_WAIT_L(8); PG8_BAR; PG8_WAIT_L(0); PG8_MMA(0, 0, At, B0); PG8_BAR; PG8_SCHED;
            PG8_LDB(B1, 0, 1); PG8_STAGE(PG8_SB(0, 0), b2, voffB);
            PG8_BAR; PG8_WAIT_L(0); PG8_MMA(0, 1, At, B1); PG8_BAR;
            PG8_LDA(At, 0, 1); PG8_STAGE(PG8_SA(0, 0), a2, voffA);
            PG8_BAR; PG8_WAIT_L(0); PG8_MMA(1, 0, At, B0); PG8_BAR; PG8_SCHED;
            PG8_STAGE(PG8_SB(0, 1), b2 + hstep, voffB);
            PG8_WAIT_V(6); PG8_BAR; PG8_MMA(1, 1, At, B1); PG8_BAR;
            PG8_LDB(B0, 1, 0); PG8_SCHED; PG8_LDA(At, 1, 0); PG8_STAGE(PG8_SA(0, 1), a2 + hstep, voffA);
            PG8_WAIT_L(8); PG8_BAR; PG8_WAIT_L(0); PG8_MMA(0, 0, At, B0); PG8_BAR; PG8_SCHED;
            PG8_LDB(B1, 1, 1); PG8_STAGE(PG8_SB(1, 0), b3, voffB);
            PG8_BAR; PG8_WAIT_L(0); PG8_MMA(0, 1, At, B1); PG8_BAR;
            PG8_LDA(At, 1, 1); PG8_STAGE(PG8_SA(1, 0), a3, voffA);
            PG8_BAR; PG8_WAIT_L(0); PG8_MMA(1, 0, At, B0); PG8_BAR; PG8_SCHED;
            PG8_STAGE(PG8_SB(1, 1), b3 + hstep, voffB);
            PG8_WAIT_V(6); PG8_BAR; PG8_MMA(1, 1, At, B1); PG8_BAR;
        }
        if constexpr (!Epi::AFTER_DRAIN) { E(acc, cur, wr, wc, fr, fq); S.done(cur); }
        if (!has_next) break;
#pragma unroll
        for (int a = 0; a < 2; ++a)
#pragma unroll
            for (int b = 0; b < 2; ++b)
#pragma unroll
                for (int m = 0; m < 4; ++m)
#pragma unroll
                    for (int n = 0; n < 2; ++n) acc[a][b][m][n] = (f32x4){0.f, 0.f, 0.f, 0.f};
        cur = nxt; cA = nA; cB = nB; ++ui;
    }
    PG8_WAIT_V(0);
    if (wr == 0) PG8_BAR;
    PG8_BAR;
    if constexpr (Epi::AFTER_DRAIN) { E.fused(acc, cur, wr, wc, fr, fq, lds, wid, lane); S.done(cur); }
#undef PG8_SA
#undef PG8_SB
#undef PG8_STAGE
#undef PG8_LDA
#undef PG8_LDB
#undef PG8_MMA
#undef PG8_WAIT_V
#undef PG8_WAIT_L
#undef PG8_BAR
#undef PG8_SCHED
}
}
#define XB_TMO      128
#define XB_XCNT(j)  (256  + 64 * (j))
#define XB_XSUB(j)  (1280 + 64 * (j))
#define XB_XGEN(j)  (2304 + 64 * (j))
#define XB_TOP      3328
#define XB_TOPGEN   3392
#define XCD_BAR_WORDS 3456
#define XB_SPIN_CAP (1u << 18)

__device__ __forceinline__ unsigned xb_ld(unsigned* p)              { return __hip_atomic_load(p, __ATOMIC_RELAXED, __HIP_MEMORY_SCOPE_AGENT); }
__device__ __forceinline__ unsigned xb_add(unsigned* p, unsigned v) { return __hip_atomic_fetch_add(p, v, __ATOMIC_RELAXED, __HIP_MEMORY_SCOPE_AGENT); }
__device__ __forceinline__ unsigned xb_xcc_id() { return (unsigned)__builtin_amdgcn_s_getreg((3 << 11) | 20) & 0xFu; }
#define XB_SPIN(cond, bar) do { unsigned _sp = 0; while (cond) { __builtin_amdgcn_s_sleep(1); \
    if ((++_sp & 255u) == 0u) { if (xb_ld(&(bar)[XB_TMO])) break; if (_sp > XB_SPIN_CAP) { atomicAdd(&(bar)[XB_TMO], 1u); break; } } } } while (0)

struct XcdBarrier {
    unsigned* bar; unsigned x;
    volatile LAS unsigned* st;
};

__device__ __forceinline__ XcdBarrier xcd_barrier_post(unsigned* bar, volatile LAS unsigned* st) {
    XcdBarrier b; b.bar = bar; b.x = xb_xcc_id(); b.st = st;
    if (threadIdx.x == 0) (void)xb_add(&bar[XB_XCNT(b.x)], 1u);
    return b;
}
__device__ __forceinline__ void xcd_barrier_complete(unsigned* bar, unsigned x, unsigned& nloc, unsigned& nx) {
    const unsigned G = gridDim.x * gridDim.y * gridDim.z;
    unsigned sum, cnt, mine, sp = 0u;
    for (;;) {
        sum = 0u; cnt = 0u; mine = 0u;
#pragma unroll
        for (unsigned j = 0; j < 16; ++j) { const unsigned c = xb_ld(&bar[XB_XCNT(j)]); sum += c; cnt += (c > 0u) ? 1u : 0u; mine = (j == x) ? c : mine; }
        if (sum == G) break;
        __builtin_amdgcn_s_sleep(1);
        if ((++sp & 255u) == 0u) { if (xb_ld(&bar[XB_TMO])) break; if (sp > XB_SPIN_CAP) { atomicAdd(&bar[XB_TMO], 1u); break; } }
    }
    nloc = mine > 0u ? mine : 1u; nx = cnt > 0u ? cnt : 1u;
}

__device__ __forceinline__ void xcd_barrier(const XcdBarrier& b) {
    asm volatile("s_waitcnt vmcnt(0)" ::: "memory");
    __syncthreads();
    if (threadIdx.x == 0) {
        unsigned* bar = b.bar;
        __builtin_amdgcn_s_waitcnt(0);
        unsigned nloc = b.st[0], nx = b.st[1];
        if (nloc == 0u) { xcd_barrier_complete(bar, b.x, nloc, nx); b.st[0] = nloc; b.st[1] = nx; }
        const unsigned old = xb_add(&bar[XB_XSUB(b.x)], 1u);
        const unsigned gen = old / nloc;
        if (old + 1u == (gen + 1u) * nloc) {
            __builtin_amdgcn_fence(__ATOMIC_RELEASE, "agent");
            asm volatile("s_waitcnt vmcnt(0)" ::: "memory");
            const unsigned og = xb_add(&bar[XB_TOP], 1u);
            const unsigned tg = og / nx;
            if (og + 1u == (tg + 1u) * nx) xb_add(&bar[XB_TOPGEN], 1u);
            else XB_SPIN(xb_ld(&bar[XB_TOPGEN]) == tg, bar);
            __builtin_amdgcn_fence(__ATOMIC_ACQUIRE, "agent");
            xb_add(&bar[XB_XGEN(b.x)], 1u);
            asm volatile("s_waitcnt vmcnt(0)" ::: "memory");
        } else {
            XB_SPIN(xb_ld(&bar[XB_XGEN(b.x)]) == gen, bar);
            __builtin_amdgcn_fence(__ATOMIC_ACQUIRE, "agent");
            asm volatile("s_waitcnt vmcnt(0)" ::: "memory");
        }
    }
    __syncthreads();
}


using pg8::bf16_t; using pg8::bf16x8; using pg8::f32x4; using pg8::u32x4;
typedef float f32x16 __attribute__((ext_vector_type(16)));
typedef unsigned u32x2 __attribute__((ext_vector_type(2)));

constexpr int DM = 1024, NB = 8, SEQ = 4096, CTXL = 256, ML = NB * SEQ, MC = NB * CTXL, MT = ML + MC, NH = 16, HD = 64, DFF = 3072;
constexpr int NCHUNK = 34;
constexpr float EPSN = 1e-6f;
constexpr size_t MiB = (size_t)1 << 20, MEL = (size_t)1 << 20;
constexpr size_t WS_MODS = 0, WS_SUM = 1 * MiB, WS_BAR = 8 * MiB, WS_BDW = 9 * MiB, WS_CTXR = 10 * MiB, WS_WB = 18 * MiB, WS_HN = 118 * MiB, WS_R = 186 * MiB, WS_PART = (186 + 272) * MiB, WS_END = 510 * MiB;
constexpr size_t R_Q = 0, R_K = (size_t)MT * DM, R_VT = 2 * (size_t)MT * DM;
constexpr size_t R_GATE = 0, R_REC = (size_t)MT * DM, R_XR = 2 * (size_t)MT * DM, R_YP = 3 * (size_t)MT * DM;
constexpr size_t R_U = 0, R_G = 0;
constexpr int LDS_BYTES = 147456;

enum { OP_PRO = 0, OP_NORM, OP_GQK, OP_GST, OP_GRES, OP_ATTN, OP_LCONV, OP_LRUA, OP_LRUC, OP_FCONV, OP_GUP };
#ifndef DUP_MASK
#define DUP_MASK 0
#endif
#define DUPE(op, i, arg) DUPE_(((DUP_MASK >> op) & 1), op, i, arg)
#define DUPE_(c, op, i, arg) DUPE__(c, op, i, arg)
#define DUPE__(c, op, i, arg) DUPE_##c(op, i, arg)
#define DUPE_0(op, i, arg)
#define DUPE_1(op, i, arg) {op, i, arg, 0},
#if DUP_MASK & 2
#define DN(i, a) {OP_NORM, i, a, 0},
#else
#define DN(i, a)
#endif
#if DUP_MASK & 4
#define DQK(i) {OP_GQK, i, 0, 0},
#else
#define DQK(i)
#endif
#if DUP_MASK & 8
#define DST(i, a) {OP_GST, i, a, 0},
#else
#define DST(i, a)
#endif
#if DUP_MASK & 32
#define DAT(i) {OP_ATTN, i, 1, 0},
#else
#define DAT(i)
#endif
#if DUP_MASK & 64
#define DLC(i) {OP_LCONV, i, 0, 0},
#else
#define DLC(i)
#endif
#if DUP_MASK & 128
#define DLA(i) {OP_LRUA, i, 0, 0},
#else
#define DLA(i)
#endif
#if DUP_MASK & 256
#define DLCC(i) {OP_LRUC, i, 0, 0},
#else
#define DLCC(i)
#endif
#if DUP_MASK & 1024
#define DUP_(i) {OP_GUP, i, 0, 0},
#else
#define DUP_(i)
#endif
#if DUP_MASK & 1
#define DPRO {OP_PRO, 0, 0, 0},
#else
#define DPRO
#endif
#define FFN_OPS(i) DN(i, 1) {OP_NORM, i, 1, 1}, DUP_(i) {OP_GUP, i, 0, 1}, {OP_GRES, i, 2, 1}
#define NA_OPS(i) DN(i, 0) {OP_NORM, i, 0, 1}, DQK(i) {OP_GQK, i, 0, 0}, DST(i, 0) {OP_GST, i, 0, 1}, DAT(i) {OP_ATTN, i, 0, 1}, {OP_GRES, i, 0, 1}, FFN_OPS(i)
#define LRU_OPS(i) DN(i, 0) {OP_NORM, i, 0, 1}, DST(i, 1) {OP_GST, i, 1, 1}, DLC(i) {OP_LCONV, i, 0, 1}, DLCC(i) {OP_LRUC, i, 0, 1}, {OP_GRES, i, 0, 1}, FFN_OPS(i)
#define PROG_INIT { DPRO {OP_PRO, 0, 0, 1}, NA_OPS(0), LRU_OPS(1), NA_OPS(2), LRU_OPS(3) }
__device__ const int PROG[][4] = PROG_INIT;
static const int HOSTPROG[][4] = PROG_INIT;
constexpr int NPROG = (int)(sizeof(HOSTPROG) / sizeof(HOSTPROG[0]));

struct Args { const float* in[26]; float* out; unsigned char* ws; int pc_lo, pc_hi; };

__device__ __forceinline__ unsigned pk2(float lo, float hi) { unsigned r; asm("v_cvt_pk_bf16_f32 %0, %1, %2" : "=v"(r) : "v"(lo), "v"(hi)); return r; }
__device__ __forceinline__ unsigned f2bf(float f) { return pk2(f, 0.0f) & 0xffffu; }
__device__ __forceinline__ float bflo(unsigned w) { return __uint_as_float(w << 16); }
__device__ __forceinline__ float bfhi(unsigned w) { return __uint_as_float(w & 0xffff0000u); }
__device__ __forceinline__ float wave_sum(float v) {
#pragma unroll
    for (int o = 1; o < 64; o <<= 1) v += __shfl_xor(v, o);
    return v;
}
__device__ __forceinline__ float fexp(float x) { return __builtin_amdgcn_exp2f(x * 1.4426950408889634f); }
__device__ __forceinline__ float sigmoidf_(float x) { return __builtin_amdgcn_rcpf(1.0f + __builtin_amdgcn_exp2f(x * -1.4426950408889634f)); }
__device__ __forceinline__ f32x16 mfma32(bf16x8 a, bf16x8 b, f32x16 c) { return __builtin_amdgcn_mfma_f32_32x32x16_bf16(a, b, c, 0, 0, 0); }
__device__ __forceinline__ f32x4 mfma16(bf16x8 a, bf16x8 b, f32x4 c) { return __builtin_amdgcn_mfma_f32_16x16x32_bf16(a, b, c, 0, 0, 0); }

struct EpiStore {
    static constexpr bool PERM = true, AFTER_DRAIN = false;
    bf16_t* O; int ldc; int split_cols; size_t split_stride;
    __device__ __forceinline__ void operator()(const f32x4 (&acc)[2][2][4][2], const pg8::Unit& u, int wr, int wc, int fr, int fq) const {
        const int row0 = u.pm * 256 + wr * 64 + fr; int colt = u.pn * 256; bf16_t* base = O;
        if (split_cols) { const int t = colt / split_cols; base += (size_t)t * split_stride; colt -= t * split_cols; }
        const int col0 = colt + wc * 32 + 8 * fq;
#pragma unroll
        for (int ai = 0; ai < 2; ++ai)
#pragma unroll
            for (int m = 0; m < 4; ++m) { bf16_t* rowp = base + (size_t)(row0 + ai * 128 + m * 16) * ldc + col0;
#pragma unroll
                for (int bj = 0; bj < 2; ++bj) { const f32x4 v0 = acc[ai][bj][m][0], v1 = acc[ai][bj][m][1];
                    u32x4 w; w.x = pg8::cvt_pk_bf16(v0[0], v0[1]); w.y = pg8::cvt_pk_bf16(v0[2], v0[3]); w.z = pg8::cvt_pk_bf16(v1[0], v1[1]); w.w = pg8::cvt_pk_bf16(v1[2], v1[3]);
                    *(u32x4*)(rowp + bj * 128) = w; } }
    }
};
struct EpiQK {
    static constexpr bool PERM = true, AFTER_DRAIN = false;
    bf16_t* Q; bf16_t* K; const float* qg; const float* kg;
    __device__ __forceinline__ void operator()(const f32x4 (&acc)[2][2][4][2], const pg8::Unit& u, int wr, int wc, int fr, int fq) const {
        const int row0 = u.pm * 256 + wr * 64 + fr; const bool isk = u.pn >= 4;
        bf16_t* base = (isk ? K : Q) + (u.pn & 3) * 256 + 64 * wc + 8 * fq;
        const float* g = isk ? kg : qg; const float sc = isk ? 1.0f : 0.125f * 1.4426950408889634f;
        f32x4 gv[2][2];
#pragma unroll
        for (int bj = 0; bj < 2; ++bj)
#pragma unroll
            for (int n = 0; n < 2; ++n) gv[bj][n] = *(const f32x4*)(g + 32 * bj + 8 * fq + 4 * n) * sc;
#pragma unroll
        for (int ai = 0; ai < 2; ++ai)
#pragma unroll
            for (int m = 0; m < 4; ++m) {
                float ss = 0.f;
#pragma unroll
                for (int bj = 0; bj < 2; ++bj)
#pragma unroll
                    for (int n = 0; n < 2; ++n) { const f32x4 x = acc[ai][bj][m][n]; ss += (x[0] * x[0] + x[1] * x[1]) + (x[2] * x[2] + x[3] * x[3]); }
                ss += __shfl_xor(ss, 16); ss += __shfl_xor(ss, 32);
                const float rs = __builtin_amdgcn_rsqf(ss * (1.0f / 64.0f) + EPSN);
                bf16_t* rowp = base + (size_t)(row0 + ai * 128 + m * 16) * DM;
#pragma unroll
                for (int bj = 0; bj < 2; ++bj) { const f32x4 v0 = acc[ai][bj][m][0] * rs * gv[bj][0], v1 = acc[ai][bj][m][1] * rs * gv[bj][1];
                    u32x4 w; w.x = pg8::cvt_pk_bf16(v0[0], v0[1]); w.y = pg8::cvt_pk_bf16(v0[2], v0[3]); w.z = pg8::cvt_pk_bf16(v1[0], v1[1]); w.w = pg8::cvt_pk_bf16(v1[2], v1[3]);
                    *(u32x4*)(rowp + 32 * bj) = w; }
            }
    }
};
struct EpiRes {
    static constexpr bool PERM = false, AFTER_DRAIN = false;
    const float* in_lat; const float* in_ctx; float* out_lat; float* out_ctx; const float* gate; int row_off;
    __device__ __forceinline__ void operator()(const f32x4 (&acc)[2][2][4][2], const pg8::Unit& u, int wr, int wc, int fr, int fq) const {
        const int R0 = row_off + u.pm * 256;
        const float* inp; float* outp; int bidx;
        if (R0 < ML) { bidx = R0 >> 12; inp = in_lat + (size_t)R0 * DM; outp = out_lat + (size_t)R0 * DM; }
        else { bidx = 8; inp = in_ctx + (size_t)(R0 - ML) * DM; outp = out_ctx + (size_t)(R0 - ML) * DM; }
        const int col0 = u.pn * 256 + wc * 32 + 4 * fq;
        const float* gp = gate + (size_t)bidx * 6144 + col0;
        f32x4 gv[2][2];
#pragma unroll
        for (int bj = 0; bj < 2; ++bj)
#pragma unroll
            for (int n = 0; n < 2; ++n) gv[bj][n] = *(const f32x4*)(gp + bj * 128 + n * 16);
#pragma unroll
        for (int ai = 0; ai < 2; ++ai)
#pragma unroll
            for (int m = 0; m < 4; ++m) { const size_t ro = (size_t)(wr * 64 + fr + ai * 128 + m * 16) * DM + col0;
#pragma unroll
                for (int bj = 0; bj < 2; ++bj)
#pragma unroll
                    for (int n = 0; n < 2; ++n) { const size_t o = ro + bj * 128 + n * 16; *(f32x4*)(outp + o) = *(const f32x4*)(inp + o) + gv[bj][n] * acc[ai][bj][m][n]; } }
    }
};


struct CtxSplitOrder {
    int nkc, G, c, pm0;
    __device__ __forceinline__ bool next(int i, pg8::Unit& u) const {
        const int L = i * G + c; if (L >= 8 * 4 * nkc) return false;
        u.kc = L % nkc; u.pn = (L / nkc) & 3; u.pm = pm0 + L / (nkc * 4); return true;
    }
    __device__ __forceinline__ void a_ready(const pg8::Unit&) const {}
    __device__ __forceinline__ void done(const pg8::Unit&) const {}
};
struct EpiPart {
    static constexpr bool PERM = false, AFTER_DRAIN = false;
    float* part;
    __device__ __forceinline__ void operator()(const f32x4 (&acc)[2][2][4][2], const pg8::Unit& u, int wr, int wc, int fr, int fq) const {
        float* outp = part + ((size_t)u.kc * MC + (size_t)(u.pm * 256 - ML)) * DM;
        const int col0 = u.pn * 256 + wc * 32 + 4 * fq;
#pragma unroll
        for (int ai = 0; ai < 2; ++ai)
#pragma unroll
            for (int m = 0; m < 4; ++m) { float* rp = outp + (size_t)(wr * 64 + fr + ai * 128 + m * 16) * DM + col0;
#pragma unroll
                for (int bj = 0; bj < 2; ++bj)
#pragma unroll
                    for (int n = 0; n < 2; ++n) *(f32x4*)(rp + bj * 128 + n * 16) = acc[ai][bj][m][n]; }
    }
};

template <int CTRL> __device__ __forceinline__ float dppf(float x) { return __int_as_float(__builtin_amdgcn_mov_dpp(__float_as_int(x), CTRL, 0xf, 0xf, true)); }
struct EpiUpConv {
    static constexpr bool PERM = true, AFTER_DRAIN = false;
    bf16_t* Gb; const float* cw; const float* cbias; LAS float* xb;
    __device__ __forceinline__ void operator()(const f32x4 (&acc)[2][2][4][2], const pg8::Unit& u, int wr, int wc, int fr, int fq) const {
        const int cl = 32 * wc + 8 * fq, cv = u.pn * 128 + cl;
#pragma unroll
        for (int ai = 0; ai < 2; ++ai) { const int s = 2 * ai + wr;
            if (fr == 0) { LAS float* p = xb + (s * 2 + 0) * 256 + cl; *(LAS f32x4*)p = acc[ai][0][0][0]; *(LAS f32x4*)(p + 4) = acc[ai][0][0][1]; *(LAS f32x4*)(p + 128) = acc[ai][1][0][0]; *(LAS f32x4*)(p + 132) = acc[ai][1][0][1]; }
            if (fr == 15) { LAS float* p = xb + (s * 2 + 1) * 256 + cl; *(LAS f32x4*)p = acc[ai][0][3][0]; *(LAS f32x4*)(p + 4) = acc[ai][0][3][1]; *(LAS f32x4*)(p + 128) = acc[ai][1][3][0]; *(LAS f32x4*)(p + 132) = acc[ai][1][3][1]; } }
        asm volatile("s_waitcnt lgkmcnt(0)\n\ts_barrier\n\ts_barrier" ::: "memory");
        const int R0 = 254 * u.pm - 1;
        bool bnd = false;
#pragma unroll
        for (int ai = 0; ai < 2; ++ai)
#pragma unroll
            for (int m = 0; m < 4; ++m) { const int row = R0 + 128 * ai + 64 * wr + 16 * m + fr;
                int pos, last; if (row < ML) { pos = row & (SEQ - 1); last = SEQ - 1; } else { pos = (row - ML) & (CTXL - 1); last = CTXL - 1; }
                bnd = bnd || pos == 0 || pos == last || row < 0 || row >= MT; }
        if (__builtin_amdgcn_ballot_w64(bnd) == 0ull) {
#pragma unroll
            for (int n = 0; n < 2; ++n) {
                f32x4 wv[3], wg[3], bv, bg;
#pragma unroll
                for (int k = 0; k < 3; ++k) { wv[k] = *(const f32x4*)(cw + k * 6144 + cv + 4 * n); wg[k] = *(const f32x4*)(cw + k * 6144 + DFF + cv + 4 * n); }
                bv = *(const f32x4*)(cbias + cv + 4 * n); bg = *(const f32x4*)(cbias + DFF + cv + 4 * n);
#pragma unroll
                for (int ai = 0; ai < 2; ++ai) { const int s = 2 * ai + wr;
#pragma unroll
                    for (int m = 0; m < 4; ++m) {
                        const int rl = 128 * ai + 64 * wr + 16 * m + fr, row = R0 + rl;
                        f32x4 xpv, xpg, xnv, xng;
                        if (m == 0) { const LAS float* p = xb + ((s > 0 ? s - 1 : 0) * 2 + 1) * 256 + cl + 4 * n; xpv = *(const LAS f32x4*)p; xpg = *(const LAS f32x4*)(p + 128); }
                        if (m == 3) { const LAS float* p = xb + ((s < 3 ? s + 1 : 3) * 2 + 0) * 256 + cl + 4 * n; xnv = *(const LAS f32x4*)p; xng = *(const LAS f32x4*)(p + 128); }
                        float o[4];
#pragma unroll
                        for (int e = 0; e < 4; ++e) {
                            const float cvv = acc[ai][0][m][n][e], cgg = acc[ai][1][m][n][e];
                            const float upv = m > 0 ? acc[ai][0][m > 0 ? m - 1 : 0][n][e] : xpv[e], upg = m > 0 ? acc[ai][1][m > 0 ? m - 1 : 0][n][e] : xpg[e];
                            const float dnv = m < 3 ? acc[ai][0][m < 3 ? m + 1 : 3][n][e] : xnv[e], dng = m < 3 ? acc[ai][1][m < 3 ? m + 1 : 3][n][e] : xng[e];
                            const float xpv_ = fr == 15 ? upv : cvv, xpg_ = fr == 15 ? upg : cgg;
                            const float xnv_ = fr == 0 ? dnv : cvv, xng_ = fr == 0 ? dng : cgg;
                            float val = bv[e] + wv[1][e] * cvv; val += wv[0][e] * dppf<0x121>(xpv_); val += wv[2][e] * dppf<0x12F>(xnv_);
                            float gt = bg[e] + wg[1][e] * cgg; gt += wg[0][e] * dppf<0x121>(xpg_); gt += wg[2][e] * dppf<0x12F>(xng_);
                            o[e] = val * gt * sigmoidf_(gt);
                        }
                        u32x2 ow; ow.x = pg8::cvt_pk_bf16(o[0], o[1]); ow.y = pg8::cvt_pk_bf16(o[2], o[3]);
                        if (rl >= 1 && rl <= 254) *(u32x2*)(Gb + (size_t)row * DFF + cv + 4 * n) = ow;
                    }
                }
            }
            return;
        }
#pragma unroll
        for (int n = 0; n < 2; ++n) {
            f32x4 wv[3], wg[3], bv, bg;
#pragma unroll
            for (int k = 0; k < 3; ++k) { wv[k] = *(const f32x4*)(cw + k * 6144 + cv + 4 * n); wg[k] = *(const f32x4*)(cw + k * 6144 + DFF + cv + 4 * n); }
            bv = *(const f32x4*)(cbias + cv + 4 * n); bg = *(const f32x4*)(cbias + DFF + cv + 4 * n);
#pragma unroll
            for (int ai = 0; ai < 2; ++ai) { const int s = 2 * ai + wr;
#pragma unroll
                for (int m = 0; m < 4; ++m) {
                    const int rl = 128 * ai + 64 * wr + 16 * m + fr, row = R0 + rl;
                    int pos, last; if (row < ML) { pos = row & (SEQ - 1); last = SEQ - 1; } else { pos = (row - ML) & (CTXL - 1); last = CTXL - 1; }
                    const bool pok = pos > 0, nok = pos < last;
                    f32x4 xpv, xpg, xnv, xng;
                    if (m == 0) { const LAS float* p = xb + ((s > 0 ? s - 1 : 0) * 2 + 1) * 256 + cl + 4 * n; xpv = *(const LAS f32x4*)p; xpg = *(const LAS f32x4*)(p + 128); }
                    if (m == 3) { const LAS float* p = xb + ((s < 3 ? s + 1 : 3) * 2 + 0) * 256 + cl + 4 * n; xnv = *(const LAS f32x4*)p; xng = *(const LAS f32x4*)(p + 128); }
                    float o[4];
#pragma unroll
                    for (int e = 0; e < 4; ++e) {
                        const float cvv = acc[ai][0][m][n][e], cgg = acc[ai][1][m][n][e];
                        const float av = dppf<0x121>(cvv), ag = dppf<0x121>(cgg);
                        float bvv, bgg;
                        if (m > 0) { bvv = dppf<0x121>(acc[ai][0][m > 0 ? m - 1 : 0][n][e]); bgg = dppf<0x121>(acc[ai][1][m > 0 ? m - 1 : 0][n][e]); } else { bvv = xpv[e]; bgg = xpg[e]; }
                        float pvv = fr == 0 ? bvv : av, pgg = fr == 0 ? bgg : ag;
                        const float a2v = dppf<0x12F>(cvv), a2g = dppf<0x12F>(cgg);
                        float b2v, b2g;
                        if (m < 3) { b2v = dppf<0x12F>(acc[ai][0][m < 3 ? m + 1 : 3][n][e]); b2g = dppf<0x12F>(acc[ai][1][m < 3 ? m + 1 : 3][n][e]); } else { b2v = xnv[e]; b2g = xng[e]; }
                        float nvv = fr == 15 ? b2v : a2v, ngg = fr == 15 ? b2g : a2g;
                        pvv = pok ? pvv : 0.f; pgg = pok ? pgg : 0.f; nvv = nok ? nvv : 0.f; ngg = nok ? ngg : 0.f;
                        const float val = bv[e] + wv[0][e] * pvv + wv[1][e] * cvv + wv[2][e] * nvv;
                        const float gt = bg[e] + wg[0][e] * pgg + wg[1][e] * cgg + wg[2][e] * ngg;
                        o[e] = val * gt * sigmoidf_(gt);
                    }
                    u32x2 ow; ow.x = pg8::cvt_pk_bf16(o[0], o[1]); ow.y = pg8::cvt_pk_bf16(o[2], o[3]);
                    if (rl >= 1 && rl <= 254 && row >= 0 && row < MT) *(u32x2*)(Gb + (size_t)row * DFF + cv + 4 * n) = ow;
                }
            }
        }
    }
};

__device__ __forceinline__ void transpose_item(const float* W, int ldw, int K, int ncol0, int ncols, bf16_t* WT, int perm, LAS float* scr, int item, int lane) {
    const int nblk = ncols / 32, kb = item / nblk, nb = item % nblk, k0 = 64 * kb, n0 = 32 * nb;
    { f32x4 v[8];
#pragma unroll
      for (int i = 0; i < 8; ++i) v[i] = *(const f32x4*)(W + (size_t)(k0 + (lane >> 3) + 8 * i) * ldw + ncol0 + n0 + 4 * (lane & 7));
#pragma unroll
      for (int i = 0; i < 8; ++i) { LAS float* d = scr + ((lane >> 3) + 8 * i) * 33 + 4 * (lane & 7); d[0] = v[i][0]; d[1] = v[i][1]; d[2] = v[i][2]; d[3] = v[i][3]; } }
    asm volatile("s_waitcnt lgkmcnt(0)" ::: "memory");
    int d0 = n0;
    if (perm == 1) { const int pn = n0 >> 8, wc = (n0 >> 6) & 3, bj = (n0 >> 5) & 1; d0 = pn * 256 + bj * 128 + wc * 32; }
    else if (perm == 2) { const int isg = n0 >= DFF, nn = isg ? n0 - DFF : n0; d0 = (nn >> 7) * 256 + isg * 128 + (nn & 127); }
    const int c = lane & 7;
#pragma unroll
    for (int j = 0; j < 4; ++j) { const int n = (lane >> 3) + 8 * j; const LAS float* s = scr + (8 * c) * 33 + n;
        u32x4 o; o.x = pk2(s[0 * 33], s[1 * 33]); o.y = pk2(s[2 * 33], s[3 * 33]); o.z = pk2(s[4 * 33], s[5 * 33]); o.w = pk2(s[6 * 33], s[7 * 33]);
        *(u32x4*)(WT + (size_t)(d0 + n) * K + k0 + 8 * c) = o; }
    asm volatile("s_waitcnt lgkmcnt(0)" ::: "memory");
}
struct TDesc { const float* src; int ldw, K, ncol0, ncols, perm; bf16_t* dst; int nitems; };
__device__ __forceinline__ TDesc get_tdesc(int m, const Args& a, bf16_t* WB) {
    TDesc t;
    if (m < 6) { const int j = m / 3, w = m % 3;
        if (w == 0) { t.src = a.in[8] + (size_t)j * DM * 3072; t.ldw = 3072; t.K = DM; t.ncol0 = 0; t.ncols = 2048; t.perm = 1; t.dst = WB + (size_t)j * 4 * MEL; }
        else if (w == 1) { t.src = a.in[8] + (size_t)j * DM * 3072; t.ldw = 3072; t.K = DM; t.ncol0 = 2048; t.ncols = 1024; t.perm = 0; t.dst = WB + (size_t)j * 4 * MEL + 2 * MEL; }
        else { t.src = a.in[12] + (size_t)j * DM * DM; t.ldw = DM; t.K = DM; t.ncol0 = 0; t.ncols = DM; t.perm = 0; t.dst = WB + (size_t)j * 4 * MEL + 3 * MEL; }
    } else if (m < 10) { const int j = (m - 6) / 2, w = (m - 6) % 2;
        if (w == 0) { t.src = a.in[13] + (size_t)j * DM * 2048; t.ldw = 2048; t.K = DM; t.ncol0 = 0; t.ncols = 2048; t.perm = 0; t.dst = WB + 8 * MEL + (size_t)j * 3 * MEL; }
        else { t.src = a.in[21] + (size_t)j * DM * DM; t.ldw = DM; t.K = DM; t.ncol0 = 0; t.ncols = DM; t.perm = 0; t.dst = WB + 8 * MEL + (size_t)j * 3 * MEL + 2 * MEL; }
    } else { const int i = (m - 10) / 2, w = (m - 10) % 2;
        if (w == 0) { t.src = a.in[22] + (size_t)i * DM * 6144; t.ldw = 6144; t.K = DM; t.ncol0 = 0; t.ncols = 6144; t.perm = 2; t.dst = WB + 14 * MEL + (size_t)i * 9 * MEL; }
        else { t.src = a.in[25] + (size_t)i * DFF * DM; t.ldw = DM; t.K = DFF; t.ncol0 = 0; t.ncols = DM; t.perm = 0; t.dst = WB + 14 * MEL + (size_t)i * 9 * MEL + 6 * MEL; }
    }
    t.nitems = (t.K / 64) * (t.ncols / 32);
    return t;
}
__device__ __forceinline__ void prologue(const Args& a, LAS unsigned char* lds, int tid, int lane, int wave, int G) {
    unsigned char* ws = a.ws;
    float* MODS = (float*)(ws + WS_MODS);
    bf16_t* WB = (bf16_t*)(ws + WS_WB);
    bf16_t* BDW = (bf16_t*)(ws + WS_BDW);
    LAS float* sl = (LAS float*)(lds + 69632);
    LAS float* red = (LAS float*)(lds + 69632 + 36864);
    for (int i = tid; i < 9 * DM; i += 512) { const int bi = i >> 10, k = i & 1023; const float v = bi < 8 ? a.in[1][bi * DM + k] : a.in[3][k]; sl[i] = v * sigmoidf_(v); }
    __syncthreads();
    for (int it = opaque_bid(); it < 4 * 96; it += G) {
        const int l = it / 96, n0 = (it % 96) * 64;
        const float* wp = a.in[4] + ((size_t)l * DM + wave * 128) * 6144 + n0 + lane;
        float acc[9];
#pragma unroll
        for (int bi = 0; bi < 9; ++bi) acc[bi] = 0.f;
        for (int k = 0; k < 128; k += 16) {
            float w[16];
#pragma unroll
            for (int kk = 0; kk < 16; ++kk) w[kk] = wp[(size_t)(k + kk) * 6144];
#pragma unroll
            for (int k4 = 0; k4 < 16; k4 += 4)
#pragma unroll
                for (int bi = 0; bi < 9; ++bi) { const f32x4 s = *(const LAS f32x4*)(sl + bi * DM + wave * 128 + k + k4); acc[bi] += (s[0] * w[k4] + s[1] * w[k4 + 1]) + (s[2] * w[k4 + 2] + s[3] * w[k4 + 3]); }
        }
#pragma unroll
        for (int bi = 0; bi < 9; ++bi) red[(wave * 9 + bi) * 64 + lane] = acc[bi];
        __syncthreads();
        for (int o = tid; o < 9 * 64; o += 512) { const int bi = o >> 6, ln = o & 63; float s = a.in[5][(size_t)l * 6144 + n0 + ln];
#pragma unroll
            for (int w = 0; w < 8; ++w) s += red[(w * 9 + bi) * 64 + ln];
            MODS[((size_t)l * 9 + bi) * 6144 + n0 + ln] = s; }
        __syncthreads();
    }
    { float* CTXR = (float*)(ws + WS_CTXR);
      for (int i = opaque_bid() * 512 + tid; i < MC * DM / 4; i += G * 512) { asm volatile("" : "+v"(i)); ((f32x4*)CTXR)[i] = ((const f32x4*)a.in[2])[i]; } }
#pragma unroll 1
    for (int idx = opaque_bid() * 512 + tid; idx < 2 * 2 * 2 * 16 * 4096; idx += G * 512) { asm volatile("" : "+v"(idx));
        const int d = idx & 63, e = (idx >> 6) & 63, n = (idx >> 12) & 15, gt = (idx >> 16) & 1, dir = (idx >> 17) & 1, j = idx >> 18;
        const float* W = gt ? a.in[18] : a.in[16];
        BDW[idx] = (bf16_t)f2bf(W[((((size_t)j * 2 + dir) * 16 + n) * 64 + d) * 64 + e]);
    }
    LAS float* scr = (LAS float*)(lds + wave * 8448);
    const int gw = opaque_bid() * 8 + wave, NGW = G * 8;
    int base = 0;
    for (int m = 0; m < 18; ++m) {
        const TDesc t = get_tdesc(m, a, WB);
        int first = (gw - base) % NGW; if (first < 0) first += NGW;
        for (int it = first; it < t.nitems; it += NGW) transpose_item(t.src, t.ldw, t.K, t.ncol0, t.ncols, t.dst, t.perm, scr, it, lane);
        base = (base + t.nitems) % NGW;
    }
}

__device__ __forceinline__ void norm_phase(const float* xl, const float* xc, bf16_t* HN, const float* gain, const float* mods_l, int sidx, int nrows, int lane, int gw, int NGW,
                                           float* ctxr_rw, const float* part, int npart, const float* pgate) {
    const bool blocked = (ML % NGW) == 0;
    const int rpw = blocked ? ML / NGW : (ML + NGW - 1) / NGW;
    const int nctx = nrows > ML ? (nrows - ML + NGW - 1) / NGW : 0;
    int curb = -1; f32x4 gm[4], shv[4];
#pragma unroll
    for (int j = 0; j < 4; ++j) { gm[j] = (f32x4){0.f, 0.f, 0.f, 0.f}; shv[j] = gm[j]; }
    for (int idx = 0; idx < rpw + nctx; ++idx) {
        int row;
        if (idx < rpw) { row = blocked ? gw * rpw + idx : gw + idx * NGW; if (row >= ML) continue; }
        else { row = ML + gw + (idx - rpw) * NGW; if (row >= nrows) continue; }
        const float* src; int bidx;
        if (row < ML) { src = xl + (size_t)row * DM; bidx = row >> 12; } else { src = xc + (size_t)(row - ML) * DM; bidx = 8; }
        const f32x4* xr = (const f32x4*)src + lane;
        f32x4 v[4]; float s = 0.f;
#pragma unroll
        for (int j = 0; j < 4; ++j) v[j] = xr[64 * j];
        if (bidx != curb) { curb = bidx;
            const float* shp = mods_l + (size_t)bidx * 6144 + sidx * DM; const float* scp = shp + DM;
#pragma unroll
            for (int j = 0; j < 4; ++j) { const int col = 4 * (lane + 64 * j); gm[j] = *(const f32x4*)(gain + col) * (*(const f32x4*)(scp + col) + 1.0f); shv[j] = *(const f32x4*)(shp + col); } }
        if (row >= ML && npart > 0) {
            f32x4 ps[4];
#pragma unroll
            for (int j = 0; j < 4; ++j) ps[j] = (f32x4){0.f, 0.f, 0.f, 0.f};
            for (int kc = 0; kc < npart; ++kc) { const f32x4* pr = (const f32x4*)(part + ((size_t)kc * MC + (row - ML)) * DM) + lane;
#pragma unroll
                for (int j = 0; j < 4; ++j) ps[j] += pr[64 * j]; }
            f32x4* wr_ = (f32x4*)(ctxr_rw + (size_t)(row - ML) * DM) + lane;
#pragma unroll
            for (int j = 0; j < 4; ++j) { v[j] += *(const f32x4*)(pgate + 4 * (lane + 64 * j)) * ps[j]; wr_[64 * j] = v[j]; }
        }
#pragma unroll
        for (int j = 0; j < 4; ++j) s += (v[j][0] * v[j][0] + v[j][1] * v[j][1]) + (v[j][2] * v[j][2] + v[j][3] * v[j][3]);
        const float rstd = __builtin_amdgcn_rsqf(wave_sum(s) * (1.0f / DM) + EPSN);
        u32x2* o8 = (u32x2*)(HN + (size_t)row * DM) + lane;
#pragma unroll
        for (int j = 0; j < 4; ++j) { const f32x4 y = v[j] * rstd * gm[j] + shv[j];
            u32x2 w; w.x = pk2(y[0], y[1]); w.y = pk2(y[2], y[3]); o8[64 * j] = w; }
    }
}

template <bool CTXQ>
__device__ __forceinline__ void attn_task(const bf16_t* QO, bf16_t* OO, const bf16_t* Kb, const bf16_t* VT, const float* rpb, int lane, int task) {
    constexpr int G0 = CTXQ ? 8 : 0;
    const int q = lane & 15, g = lane >> 4;
    int cb, r, h, b, q0, ks, rs; size_t qrow;
    if (CTXQ) { const int qb = task & 15; h = (task >> 4) & 15; b = task >> 8; cb = 0; r = 0; q0 = 0; ks = 0; rs = 0; qrow = (size_t)ML + b * CTXL + qb * 16 + q; }
    else { cb = task & 3; r = (task >> 2) & 63; h = (task >> 8) & 15; b = task >> 12; q0 = cb * 16; ks = min(max(q0 - 8, 0), 32); rs = min(max(r - 4, 0), 56); qrow = (size_t)b * SEQ + r * 64 + q0 + q; }
    const bf16x8 qf0 = *(const bf16x8*)(QO + qrow * DM + h * 64 + 8 * g), qf1 = *(const bf16x8*)(QO + qrow * DM + h * 64 + 32 + 8 * g);
    const int qcol = q0 + q, wstart = min(max(qcol - 8, 0), 48);
    const float* rp = rpb + h * 465;
    const int koff = 8 * (q >> 2) + (q & 3);
    f32x4 S[16][2];
#pragma unroll
    for (int grp = G0; grp < 16; ++grp) {
        const size_t base = grp < 8 ? (size_t)b * SEQ + (rs + grp) * 64 + ks : (size_t)ML + b * CTXL + 32 * (grp - 8);
#pragma unroll
        for (int T = 0; T < 2; ++T) {
            const bf16_t* kp = Kb + (base + koff + 4 * T) * DM + h * 64 + 8 * g;
            const bf16x8 kf0 = *(const bf16x8*)kp, kf1 = *(const bf16x8*)(kp + 32);
            f32x4 s = {0.f, 0.f, 0.f, 0.f};
            s = mfma16(kf0, qf0, s); s = mfma16(kf1, qf1, s);
            if (grp < 8) {
                const int drow = rs + grp - r + 7;
#pragma unroll
                for (int j = 0; j < 4; ++j) { const int kcol = ks + 8 * g + 4 * T + j; const bool ok = (kcol >= wstart) && (kcol < wstart + 16);
                    const int dcol = min(max(kcol - qcol + 15, 0), 30);
                    const float bias = rp[drow * 31 + dcol];
                    s[j] = ok ? s[j] + bias : -1e30f; }
            }
            S[grp][T] = s;
        }
    }
    float mx = -1e30f;
#pragma unroll
    for (int grp = G0; grp < 16; ++grp)
#pragma unroll
        for (int T = 0; T < 2; ++T) mx = fmaxf(mx, fmaxf(fmaxf(S[grp][T][0], S[grp][T][1]), fmaxf(S[grp][T][2], S[grp][T][3])));
    mx = fmaxf(mx, __shfl_xor(mx, 16)); mx = fmaxf(mx, __shfl_xor(mx, 32));
    float sum = 0.f;
#pragma unroll
    for (int grp = G0; grp < 16; ++grp)
#pragma unroll
        for (int T = 0; T < 2; ++T) {
#pragma unroll
            for (int j = 0; j < 4; ++j) { const float p = __expf(S[grp][T][j] - mx); S[grp][T][j] = p; sum += p; } }
    sum += __shfl_xor(sum, 16); sum += __shfl_xor(sum, 32);
    f32x4 O[4];
#pragma unroll
    for (int dt = 0; dt < 4; ++dt) O[dt] = (f32x4){0.f, 0.f, 0.f, 0.f};
#pragma unroll
    for (int grp = G0; grp < 16; ++grp) {
        const size_t base = grp < 8 ? (size_t)b * SEQ + (rs + grp) * 64 + ks : (size_t)ML + b * CTXL + 32 * (grp - 8);
        u32x4 pw; pw.x = pk2(S[grp][0][0], S[grp][0][1]); pw.y = pk2(S[grp][0][2], S[grp][0][3]); pw.z = pk2(S[grp][1][0], S[grp][1][1]); pw.w = pk2(S[grp][1][2], S[grp][1][3]);
        const bf16x8 pf = __builtin_bit_cast(bf16x8, pw);
#pragma unroll
        for (int dt = 0; dt < 4; ++dt) {
            const bf16x8 vf = *(const bf16x8*)(VT + (size_t)(h * 64 + 16 * dt + q) * MT + base + 8 * g);
            O[dt] = mfma16(vf, pf, O[dt]);
        }
        if (grp & 1) __builtin_amdgcn_sched_barrier(0);
    }
    const float inv = __builtin_amdgcn_rcpf(sum);
#pragma unroll
    for (int dt = 0; dt < 4; ++dt) { u32x2 w; w.x = pk2(O[dt][0] * inv, O[dt][1] * inv); w.y = pk2(O[dt][2] * inv, O[dt][3] * inv);
        *(u32x2*)(OO + qrow * DM + h * 64 + 16 * dt + 4 * g) = w; }
}
constexpr int AT_PITCH = 144;
template <bool CTXQ>
__device__ __forceinline__ void attn_super(const bf16_t* QO, bf16_t* OO, const bf16_t* Kb, const bf16_t* VT, const float* rpb, LAS unsigned char* lds, int tid_, int lane_, int wave, int st) {
    constexpr int G0 = CTXQ ? 8 : 0, I0 = CTXQ ? 9 : 0;
    const int tid = opaque_tid(), lane = tid & 63;
    const int q = lane & 15, g = lane >> 4;
    int b, h, r = 0, q0 = 0, ks = 0, rs = 0, kbase = 0, krl0 = 0; size_t qrow;
    if (CTXQ) { const int hf = st & 1; h = (st >> 1) & 15; b = st >> 5; qrow = (size_t)ML + b * CTXL + hf * 128 + wave * 16 + q; }
    else { const int rp = st & 31; h = (st >> 5) & 15; b = st >> 9; r = 2 * rp + (wave >> 2); q0 = (wave & 3) * 16; ks = min(max(q0 - 8, 0), 32); rs = min(max(r - 4, 0), 56);
        kbase = min(min(max(2 * rp - 4, 0), 56), 55); krl0 = rs - kbase; qrow = (size_t)b * SEQ + r * 64 + q0 + q; }
    u32x4 stg[13];
#pragma unroll
    for (int i = I0; i < 13; ++i) { const int c = tid + 512 * i, t = c >> 3, cc = c & 7;
        const size_t urow = t < 576 ? (size_t)b * SEQ + kbase * 64 + t : (size_t)ML + b * CTXL + (t - 576);
        stg[i] = *(const u32x4*)(Kb + urow * DM + h * 64 + cc * 8); }
    const bf16x8 qf0 = *(const bf16x8*)(QO + qrow * DM + h * 64 + 8 * g), qf1 = *(const bf16x8*)(QO + qrow * DM + h * 64 + 32 + 8 * g);
    LAS float* rpl = (LAS float*)(lds + 832 * AT_PITCH);
    if (!CTXQ) { if (tid < 465) rpl[tid] = rpb[h * 465 + tid] * 1.4426950408889634f; }
#pragma unroll
    for (int i = I0; i < 13; ++i) { const int c = tid + 512 * i, t = c >> 3, cc = c & 7; *(LAS u32x4*)(lds + t * AT_PITCH + cc * 16) = stg[i]; }
    __syncthreads();
    const int qcol = q0 + q, wstart = min(max(qcol - 8, 0), 48);
    const int koff = 8 * (q >> 2) + (q & 3);
    f32x4 S[16][2];
#pragma unroll
    for (int grp = G0; grp < 16; ++grp) {
        const int tb = grp < 8 ? (krl0 + grp) * 64 + ks : 576 + 32 * (grp - 8);
#pragma unroll
        for (int T = 0; T < 2; ++T) {
            const LAS unsigned char* kp = lds + (tb + koff + 4 * T) * AT_PITCH + g * 16;
            const bf16x8 kf0 = *(const LAS bf16x8*)kp, kf1 = *(const LAS bf16x8*)(kp + 64);
            f32x4 s = {0.f, 0.f, 0.f, 0.f};
            s = mfma16(kf0, qf0, s); s = mfma16(kf1, qf1, s);
            if (grp < 8) {
                const int drow = rs + grp - r + 7;
#pragma unroll
                for (int j = 0; j < 4; ++j) { const int kcol = ks + 8 * g + 4 * T + j; const bool ok = (kcol >= wstart) && (kcol < wstart + 16);
                    const int dcol = min(max(kcol - qcol + 15, 0), 30);
                    const float bias = rpl[drow * 31 + dcol];
                    s[j] = ok ? s[j] + bias : -1e30f; }
            }
            S[grp][T] = s;
        }
        __builtin_amdgcn_sched_barrier(0);
    }
    __syncthreads();
    float mx = -1e30f;
#pragma unroll
    for (int grp = G0; grp < 16; ++grp)
#pragma unroll
        for (int T = 0; T < 2; ++T) mx = fmaxf(mx, fmaxf(fmaxf(S[grp][T][0], S[grp][T][1]), fmaxf(S[grp][T][2], S[grp][T][3])));
    mx = fmaxf(mx, __shfl_xor(mx, 16)); mx = fmaxf(mx, __shfl_xor(mx, 32));
    float sum = 0.f;
    u32x4 P[16];
#pragma unroll
    for (int grp = G0; grp < 16; ++grp) {
        float p[8];
#pragma unroll
        for (int T = 0; T < 2; ++T)
#pragma unroll
            for (int j = 0; j < 4; ++j) { p[4 * T + j] = __builtin_amdgcn_exp2f(S[grp][T][j] - mx); sum += p[4 * T + j]; }
        P[grp].x = pk2(p[0], p[1]); P[grp].y = pk2(p[2], p[3]); P[grp].z = pk2(p[4], p[5]); P[grp].w = pk2(p[6], p[7]);
        __builtin_amdgcn_sched_barrier(0);
    }
    sum += __shfl_xor(sum, 16); sum += __shfl_xor(sum, 32);
#pragma unroll
    for (int i = I0; i < 13; ++i) { const int d = (tid >> 3) & 63, cc = tid & 7;
        const size_t tokb = i < 9 ? (size_t)b * SEQ + (kbase + i) * 64 : (size_t)ML + b * CTXL + (i - 9) * 64;
        stg[i] = *(const u32x4*)(VT + (size_t)(h * 64 + d) * MT + tokb + cc * 8); }
#pragma unroll
    for (int i = I0; i < 13; ++i) { const int d = (tid >> 3) & 63, cc = tid & 7; *(LAS u32x4*)(lds + (i * 64 + d) * AT_PITCH + cc * 16) = stg[i]; }
    __syncthreads();
    f32x4 O[4];
#pragma unroll
    for (int dt = 0; dt < 4; ++dt) O[dt] = (f32x4){0.f, 0.f, 0.f, 0.f};
#pragma unroll
    for (int grp = G0; grp < 16; ++grp) {
        const int blk = grp < 8 ? krl0 + grp : 9 + ((grp - 8) >> 1), col = grp < 8 ? ks : 32 * ((grp - 8) & 1);
        const bf16x8 pf = __builtin_bit_cast(bf16x8, P[grp]);
#pragma unroll
        for (int dt = 0; dt < 4; ++dt) {
            const bf16x8 vf = *(const LAS bf16x8*)(lds + (blk * 64 + 16 * dt + q) * AT_PITCH + (col + 8 * g) * 2);
            O[dt] = mfma16(vf, pf, O[dt]);
        }
        if (grp & 1) __builtin_amdgcn_sched_barrier(0);
    }
    const float inv = __builtin_amdgcn_rcpf(sum);
#pragma unroll
    for (int dt = 0; dt < 4; ++dt) { u32x2 w; w.x = pk2(O[dt][0] * inv, O[dt][1] * inv); w.y = pk2(O[dt][2] * inv, O[dt][3] * inv);
        *(u32x2*)(OO + qrow * DM + h * 64 + 16 * dt + 4 * g) = w; }
    __syncthreads();
}
__device__ __forceinline__ void attn_phase(const bf16_t* QO, bf16_t* OO, const bf16_t* Kb, const bf16_t* VT, const float* rpb, LAS unsigned char* lds, int tid, int lane, int wave, int G) {
    const int bid = opaque_bid();
    if (G == 256) {
        const int x = bid & 7, c = bid >> 3;
        for (int it = 0; it < 16; ++it) attn_super<false>(QO, OO, Kb, VT, rpb, lds, tid, lane, wave, ((it * 8 + x) << 5) | c);
        attn_super<true>(QO, OO, Kb, VT, rpb, lds, tid, lane, wave, ((((c >> 1) * 8) + x) << 1) | (c & 1));
    } else {
        for (int st = bid; st < 4096; st += G) attn_super<false>(QO, OO, Kb, VT, rpb, lds, tid, lane, wave, st);
        for (int st = bid; st < 256; st += G) attn_super<true>(QO, OO, Kb, VT, rpb, lds, tid, lane, wave, st);
    }
}

__device__ __forceinline__ void lconv_phase(const bf16_t* REC, bf16_t* XR, const float* cw, const float* cbias, int tid, int G) {
#pragma unroll 1
    for (int it = opaque_bid() * 512 + tid; it < MT * 128; it += G * 512) { asm volatile("" : "+v"(it));
        const int row = it >> 7, ch = (it & 127) * 8;
        int pos, len; if (row < ML) { pos = row & (SEQ - 1); len = SEQ; } else { pos = (row - ML) & (CTXL - 1); len = CTXL; }
        float acc[8];
        { const f32x4 b0 = *(const f32x4*)(cbias + ch), b1 = *(const f32x4*)(cbias + ch + 4);
#pragma unroll
          for (int e = 0; e < 4; ++e) { acc[e] = b0[e]; acc[4 + e] = b1[e]; } }
#pragma unroll
        for (int k = 0; k < 4; ++k) { const int t = pos + k - 2;
            if (t >= 0 && t < len) {
                const u32x4 v = *(const u32x4*)(REC + (size_t)(row + k - 2) * DM + ch);
                const f32x4 w0 = *(const f32x4*)(cw + k * DM + ch), w1 = *(const f32x4*)(cw + k * DM + ch + 4);
                acc[0] += w0[0] * bflo(v.x); acc[1] += w0[1] * bfhi(v.x); acc[2] += w0[2] * bflo(v.y); acc[3] += w0[3] * bfhi(v.y);
                acc[4] += w1[0] * bflo(v.z); acc[5] += w1[1] * bfhi(v.z); acc[6] += w1[2] * bflo(v.w); acc[7] += w1[3] * bfhi(v.w);
            } }
        u32x4 o; o.x = pk2(acc[0], acc[1]); o.y = pk2(acc[2], acc[3]); o.z = pk2(acc[4], acc[5]); o.w = pk2(acc[6], acc[7]);
        *(u32x4*)(XR + (size_t)row * DM + ch) = o;
    }
}

template <int DIR, bool APPLY>
__device__ __forceinline__ void lru_sweep(const bf16_t* XR, const bf16_t* GATE, bf16_t* YP, const bf16_t* bdw_dir, float bias_r, float bias_i, float sp,
                                          int row0, int n, int half, int lane, float& hcar, float& ptot, unsigned (&hsf)[4][8]) {
    const int e = lane & 31, hh = lane >> 5;
    const int tau = 16 * ((e >> 2) & 1) + (e & 3) + 4 * (e >> 3);
    bf16x8 Br[4], Bi[4];
    const bf16_t* wrp = bdw_dir + (size_t)n * 4096 + (half * 32 + e) * 64 + 8 * hh;
    const bf16_t* wip = wrp + 16 * 4096;
#pragma unroll
    for (int kk = 0; kk < 4; ++kk) { Br[kk] = *(const bf16x8*)(wrp + 16 * kk); Bi[kk] = *(const bf16x8*)(wip + 16 * kk); }
    bf16x8 I0, I1;
#pragma unroll
    for (int jj = 0; jj < 8; ++jj) { I0[jj] = (8 * hh + jj == e) ? (short)0x3F80 : (short)0; I1[jj] = (16 + 8 * hh + jj == e) ? (short)0x3F80 : (short)0; }
    const bool first = (hh == DIR);
    const int chcol = n * 64 + half * 32;
    const float spm = -8.0f * 1.4426950408889634f * sp;
#pragma unroll
    for (int tt = 0; tt < 4; ++tt) {
        const int tile = DIR == 0 ? tt : 3 - tt; const int trow = row0 + tile * 32;
        const bf16_t* ap = XR + (size_t)(trow + tau) * DM + n * 64 + 8 * hh;
        bf16x8 A[4];
#pragma unroll
        for (int kk = 0; kk < 4; ++kk) A[kk] = *(const bf16x8*)(ap + 16 * kk);
        f32x16 ar, ai, xv;
#pragma unroll
        for (int r = 0; r < 16; ++r) { ar[r] = 0.f; ai[r] = 0.f; xv[r] = 0.f; }
#pragma unroll
        for (int kk = 0; kk < 4; ++kk) { ar = mfma32(A[kk], Br[kk], ar); ai = mfma32(A[kk], Bi[kk], ai); }
        const bf16x8 Ax0 = half ? A[2] : A[0], Ax1 = half ? A[3] : A[1];
        xv = mfma32(Ax0, I0, xv); xv = mfma32(Ax1, I1, xv);
        f32x16 av, bv;
#pragma unroll
        for (int r = 0; r < 16; ++r) {
            const float rg = sigmoidf_(ar[r] + bias_r), ig = sigmoidf_(ai[r] + bias_i);
            const float aa = __builtin_amdgcn_exp2f(rg * spm);
            av[r] = aa; bv[r] = __builtin_amdgcn_sqrtf(fmaxf(1.0f - aa * aa, 0.f)) * ig * xv[r];
        }
        float Hl = 0.f, Pl = 1.f;
#pragma unroll
        for (int rr = 0; rr < 16; ++rr) { const int r = DIR == 0 ? rr : 15 - rr; Hl = av[r] * Hl + bv[r]; Pl *= av[r]; }
        const float val = Hl + Pl * hcar, got = __shfl_xor(val, 32);
        const float start = first ? hcar : got;
        float endv;
        f32x16 hs;
        if (APPLY) {
            float hcur = start;
#pragma unroll
            for (int rr = 0; rr < 16; ++rr) { const int r = DIR == 0 ? rr : 15 - rr; hcur = av[r] * hcur + bv[r]; hs[r] = hcur; }
            endv = hcur;
        } else { endv = Hl + Pl * start; }
        const float got2 = __shfl_xor(endv, 32);
        hcar = first ? got2 : endv;
        if (!APPLY) ptot *= Pl * __shfl_xor(Pl, 32);
        if (APPLY) {
            if (DIR == 0) {
#pragma unroll
                for (int r2 = 0; r2 < 8; ++r2) hsf[tile][r2] = pk2(hs[2 * r2], hs[2 * r2 + 1]);
            }
            else {
                const bf16_t* gp = GATE + (size_t)(trow + tau) * DM + chcol + 8 * hh;
                const bf16x8 G0 = *(const bf16x8*)gp, G1 = *(const bf16x8*)(gp + 16);
                f32x16 gv;
#pragma unroll
                for (int r = 0; r < 16; ++r) gv[r] = 0.f;
                gv = mfma32(G0, I0, gv); gv = mfma32(G1, I1, gv);
                bf16_t* yp = YP + (size_t)(trow + 16 * hh) * DM + chcol + e;
#pragma unroll
                for (int r = 0; r < 16; ++r) { const float x = gv[r], u2 = 1.5957691216f * (x + 0.044715f * x * x * x);
                    const float hf = (r & 1) ? bfhi(hsf[tile][r >> 1]) : bflo(hsf[tile][r >> 1]);
                    const float y = (hf + hs[r]) * x * sigmoidf_(u2);
                    yp[(size_t)r * DM] = (bf16_t)f2bf(y); }
            }
        }
    }
}
template <bool APPLY>
__device__ __forceinline__ void lru_phase(const bf16_t* XR, const bf16_t* GATE, bf16_t* YP, const bf16_t* bdw_j, const float* ga_b, const float* gx_b, const float* lam, float* SUM,
                                          int lane, int gw, int NGW) {
    for (int task = gw; task < NB * NCHUNK * 32; task += NGW) {
        const int n2 = task & 31, c = (task >> 5) % NCHUNK, b = task / (32 * NCHUNK);
        const int row0 = c < 2 ? ML + b * CTXL + c * 128 : b * SEQ + (c - 2) * 128;
        const int n = n2 >> 1, half = n2 & 1, ch = n2 * 32 + (lane & 31);
        unsigned hsf[4][8];
#pragma unroll
        for (int dir = 0; dir < 2; ++dir) {
            const float bias_r = ga_b[dir * DM + ch], bias_i = gx_b[dir * DM + ch];
            const float sp = log1pf(__expf(-lam[dir * DM + ch]));
            const int p = dir == 0 ? c : (c < 2 ? 1 - c : 35 - c);
            float* sump = SUM + ((size_t)(dir * NB + b) * NCHUNK) * DM * 2 + (size_t)ch * 2;
            float hcar = 0.f, ptot = 1.f;
            if (APPLY) { for (int pp = 0; pp < p; ++pp) { const float2 ph = *(const float2*)(sump + (size_t)pp * DM * 2); hcar = ph.x * hcar + ph.y; } }
            if (dir == 0) lru_sweep<0, APPLY>(XR, GATE, YP, bdw_j, bias_r, bias_i, sp, row0, n, half, lane, hcar, ptot, hsf);
            else lru_sweep<1, APPLY>(XR, GATE, YP, bdw_j + 2 * 16 * 4096, bias_r, bias_i, sp, row0, n, half, lane, hcar, ptot, hsf);
            if (!APPLY) { if (lane < 32) *(float2*)(sump + (size_t)p * DM * 2) = make_float2(ptot, hcar); }
        }
    }
}

template <int DIR>
__device__ __forceinline__ void lru_dir(const bf16_t* XR, const bf16_t* GATE, bf16_t* YP, u32x4* HSF, const bf16_t* bdw_dir, float bias_r, float bias_i, float sp,
                                        int b, int n2, int lane, int wave, LAS float* xl) {
    const int e = lane & 31, hh = lane >> 5, n = n2 >> 1, half = n2 & 1;
    const int tau = 16 * ((e >> 2) & 1) + (e & 3) + 4 * (e >> 3);
    bf16x8 Br[4], Bi[4];
    const bf16_t* wrp = bdw_dir + (size_t)n * 4096 + (half * 32 + e) * 64 + 8 * hh;
    const bf16_t* wip = wrp + 16 * 4096;
#pragma unroll
    for (int kk = 0; kk < 4; ++kk) { Br[kk] = *(const bf16x8*)(wrp + 16 * kk); Bi[kk] = *(const bf16x8*)(wip + 16 * kk); }
    bf16x8 I0, I1;
#pragma unroll
    for (int jj = 0; jj < 8; ++jj) { I0[jj] = (8 * hh + jj == e) ? (short)0x3F80 : (short)0; I1[jj] = (16 + 8 * hh + jj == e) ? (short)0x3F80 : (short)0; }
    const bool first = (hh == DIR);
    const int chcol = n * 64 + half * 32;
    const float spm = -8.0f * 1.4426950408889634f * sp;
    float segcar = 0.f;
#pragma unroll 1
    for (int seg = 0; seg < 9; ++seg) {
        f32x16 av[2], bv[2]; float Hl[2], Pl[2]; int trow[2]; bool valid[2];
        float hloc = 0.f, ploc = 1.f;
#pragma unroll
        for (int k = 0; k < 2; ++k) {
            const int q = seg * 16 + wave * 2 + k; valid[k] = q < 136;
            const int T = DIR == 0 ? q : (q < 8 ? 7 - q : 143 - q);
            trow[k] = T < 8 ? ML + b * CTXL + 32 * T : b * SEQ + 32 * (T - 8);
            if (valid[k]) {
                const bf16_t* ap = XR + (size_t)(trow[k] + tau) * DM + n * 64 + 8 * hh;
                bf16x8 A[4];
#pragma unroll
                for (int kk = 0; kk < 4; ++kk) A[kk] = *(const bf16x8*)(ap + 16 * kk);
                f32x16 ar, ai, xv;
#pragma unroll
                for (int r = 0; r < 16; ++r) { ar[r] = 0.f; ai[r] = 0.f; xv[r] = 0.f; }
#pragma unroll
                for (int kk = 0; kk < 4; ++kk) { ar = mfma32(A[kk], Br[kk], ar); ai = mfma32(A[kk], Bi[kk], ai); }
                const bf16x8 Ax0 = half ? A[2] : A[0], Ax1 = half ? A[3] : A[1];
                xv = mfma32(Ax0, I0, xv); xv = mfma32(Ax1, I1, xv);
#pragma unroll
                for (int r = 0; r < 16; ++r) {
                    const float rg = sigmoidf_(ar[r] + bias_r), ig = sigmoidf_(ai[r] + bias_i);
                    const float aa = __builtin_amdgcn_exp2f(rg * spm);
                    av[k][r] = aa; bv[k][r] = __builtin_amdgcn_sqrtf(fmaxf(1.0f - aa * aa, 0.f)) * ig * xv[r];
                }
            } else {
#pragma unroll
                for (int r = 0; r < 16; ++r) { av[k][r] = 1.0f; bv[k][r] = 0.0f; }
            }
            float H = 0.f, P = 1.f;
#pragma unroll
            for (int rr = 0; rr < 16; ++rr) { const int r = DIR == 0 ? rr : 15 - rr; H = av[k][r] * H + bv[k][r]; P *= av[k][r]; }
            Hl[k] = H; Pl[k] = P;
            const float val = H + P * hloc, got = __shfl_xor(val, 32);
            const float st2 = first ? hloc : got;
            const float endv = H + P * st2, got2 = __shfl_xor(endv, 32);
            hloc = first ? got2 : endv;
            ploc *= P * __shfl_xor(P, 32);
        }
        LAS float* slot = xl + ((seg & 1) * 8 + wave) * 64 + e * 2;
        if (lane < 32) { slot[0] = ploc; slot[1] = hloc; }
        __syncthreads();
        float c = segcar, hcar = segcar;
#pragma unroll
        for (int w = 0; w < 8; ++w) { const LAS float* sp_ = xl + ((seg & 1) * 8 + w) * 64 + e * 2; const float P = sp_[0], H = sp_[1]; if (w == wave) hcar = c; c = P * c + H; }
        segcar = c;
#pragma unroll
        for (int k = 0; k < 2; ++k) {
            if (valid[k]) {
                const float val = Hl[k] + Pl[k] * hcar, got = __shfl_xor(val, 32);
                float hcur = first ? hcar : got;
                f32x16 hs;
#pragma unroll
                for (int rr = 0; rr < 16; ++rr) { const int r = DIR == 0 ? rr : 15 - rr; hcur = av[k][r] * hcur + bv[k][r]; hs[r] = hcur; }
                const float got2 = __shfl_xor(hcur, 32);
                hcar = first ? got2 : hcur;
                const int tg = trow[k] < ML ? (trow[k] >> 12) * 136 + 8 + ((trow[k] & (SEQ - 1)) >> 5) : b * 136 + ((trow[k] - ML - b * CTXL) >> 5);
                u32x4* hp = HSF + (((size_t)tg * 32 + n2) * 64 + lane) * 2;
                if (DIR == 0) {
                    u32x4 w0, w1;
                    w0.x = pk2(hs[0], hs[1]); w0.y = pk2(hs[2], hs[3]); w0.z = pk2(hs[4], hs[5]); w0.w = pk2(hs[6], hs[7]);
                    w1.x = pk2(hs[8], hs[9]); w1.y = pk2(hs[10], hs[11]); w1.z = pk2(hs[12], hs[13]); w1.w = pk2(hs[14], hs[15]);
                    hp[0] = w0; hp[1] = w1;
                } else {
                    const u32x4 w0 = hp[0], w1 = hp[1];
                    const unsigned hw[8] = {w0.x, w0.y, w0.z, w0.w, w1.x, w1.y, w1.z, w1.w};
                    const bf16_t* gp = GATE + (size_t)(trow[k] + tau) * DM + chcol + 8 * hh;
                    const bf16x8 G0 = *(const bf16x8*)gp, G1 = *(const bf16x8*)(gp + 16);
                    f32x16 gv;
#pragma unroll
                    for (int r = 0; r < 16; ++r) gv[r] = 0.f;
                    gv = mfma32(G0, I0, gv); gv = mfma32(G1, I1, gv);
                    bf16_t* yp = YP + (size_t)(trow[k] + 16 * hh) * DM + chcol + e;
#pragma unroll
                    for (int r = 0; r < 16; ++r) { const float x = gv[r], u2 = 1.5957691216f * (x + 0.044715f * x * x * x);
                        const float hf = (r & 1) ? bfhi(hw[r >> 1]) : bflo(hw[r >> 1]);
                        const float y = (hf + hs[r]) * x * sigmoidf_(u2);
                        yp[(size_t)r * DM] = (bf16_t)f2bf(y); }
                }
            }
        }
    }
}
__device__ __forceinline__ void lru_block_phase(const bf16_t* XR, const bf16_t* GATE, bf16_t* YP, u32x4* HSF, const bf16_t* bdw_j, const float* ga_b, const float* gx_b, const float* lam,
                                                LAS unsigned char* lds, int lane, int wave, int G) {
    LAS float* xl = (LAS float*)lds;
    for (int item = opaque_bid(); item < NB * 32; item += G) {
        const int b = item >> 5, n2 = item & 31, ch = n2 * 32 + (lane & 31);
        { const float bias_r = ga_b[ch], bias_i = gx_b[ch], sp = log1pf(__expf(-lam[ch]));
          lru_dir<0>(XR, GATE, YP, HSF, bdw_j, bias_r, bias_i, sp, b, n2, lane, wave, xl); }
        __syncthreads();
        { const float bias_r = ga_b[DM + ch], bias_i = gx_b[DM + ch], sp = log1pf(__expf(-lam[DM + ch]));
          lru_dir<1>(XR, GATE, YP, HSF, bdw_j + 2 * 16 * 4096, bias_r, bias_i, sp, b, n2, lane, wave, xl); }
        __syncthreads();
    }
}

__device__ __forceinline__ void fconv_phase(const bf16_t* U, bf16_t* Gb, const float* cw, const float* cbias, int rbeg, int nrows, int tid, int G) {
    const int total = nrows * 384;
#pragma unroll 1
    for (int it = opaque_bid() * 512 + tid; it < total; it += G * 512) { asm volatile("" : "+v"(it));
        const int r = it / 384, ch = (it % 384) * 8, row = rbeg + r;
        int pos, len; if (row < ML) { pos = row & (SEQ - 1); len = SEQ; } else { pos = (row - ML) & (CTXL - 1); len = CTXL; }
        float va[8], ga[8];
        { const f32x4 b0 = *(const f32x4*)(cbias + ch), b1 = *(const f32x4*)(cbias + ch + 4), c0 = *(const f32x4*)(cbias + DFF + ch), c1 = *(const f32x4*)(cbias + DFF + ch + 4);
#pragma unroll
          for (int e = 0; e < 4; ++e) { va[e] = b0[e]; va[4 + e] = b1[e]; ga[e] = c0[e]; ga[4 + e] = c1[e]; } }
#pragma unroll
        for (int k = 0; k < 3; ++k) { const int t = pos + k - 1;
            if (t >= 0 && t < len) {
                const bf16_t* up = U + (size_t)(r + k - 1) * 6144 + ch;
                const u32x4 v = *(const u32x4*)up, gq = *(const u32x4*)(up + DFF);
                const float* wp = cw + (size_t)k * 6144 + ch;
                const f32x4 w0 = *(const f32x4*)wp, w1 = *(const f32x4*)(wp + 4), x0 = *(const f32x4*)(wp + DFF), x1 = *(const f32x4*)(wp + DFF + 4);
                va[0] += w0[0] * bflo(v.x); va[1] += w0[1] * bfhi(v.x); va[2] += w0[2] * bflo(v.y); va[3] += w0[3] * bfhi(v.y);
                va[4] += w1[0] * bflo(v.z); va[5] += w1[1] * bfhi(v.z); va[6] += w1[2] * bflo(v.w); va[7] += w1[3] * bfhi(v.w);
                ga[0] += x0[0] * bflo(gq.x); ga[1] += x0[1] * bfhi(gq.x); ga[2] += x0[2] * bflo(gq.y); ga[3] += x0[3] * bfhi(gq.y);
                ga[4] += x1[0] * bflo(gq.z); ga[5] += x1[1] * bfhi(gq.z); ga[6] += x1[2] * bflo(gq.w); ga[7] += x1[3] * bfhi(gq.w);
            } }
        float o[8];
#pragma unroll
        for (int e = 0; e < 8; ++e) o[e] = va[e] * ga[e] * sigmoidf_(ga[e]);
        u32x4 w; w.x = pk2(o[0], o[1]); w.y = pk2(o[2], o[3]); w.z = pk2(o[4], o[5]); w.w = pk2(o[6], o[7]);
        *(u32x4*)(Gb + (size_t)r * DFF + ch) = w;
    }
}

template <int OP>
__device__ __forceinline__ void run_op(const Args& a, LAS unsigned char* lds, const int li, const int arg, const int rep) {
    const int tid = opaque_tid(), lane = tid & 63, wave = __builtin_amdgcn_readfirstlane(tid >> 6), G = gridDim.x;
    const int gw = opaque_bid() * 8 + wave, NGW = G * 8;
    unsigned char* ws = a.ws;
    float* MODS = (float*)(ws + WS_MODS);
    float* SUM = (float*)(ws + WS_SUM);
    bf16_t* BDW = (bf16_t*)(ws + WS_BDW);
    float* CTXR = (float*)(ws + WS_CTXR);
    bf16_t* WB = (bf16_t*)(ws + WS_WB);
    bf16_t* HN = (bf16_t*)(ws + WS_HN);
    bf16_t* RR = (bf16_t*)(ws + WS_R);
    const int j = li >> 1;
    const float* mods_l = MODS + (size_t)li * 9 * 6144;
    if constexpr (OP == OP_PRO) {
        prologue(a, lds, tid, lane, wave, G);
    } else if constexpr (OP == OP_NORM) {
        const bool first = (li == 0 && arg == 0);
        const float* gain = (arg ? a.in[7] : a.in[6]) + (size_t)li * DM;
        const int nrows = (arg == 1 && li == 3) ? ML : MT;
        const int npart = first ? 0 : (arg == 1 ? (li == 3 ? 0 : 4) : 6);
        const float* pgate = arg == 1 ? mods_l + 8 * 6144 + 2 * DM : MODS + (size_t)(li - 1) * 9 * 6144 + 8 * 6144 + 5 * DM;
        norm_phase(first ? a.in[0] : a.out, CTXR, HN, gain, mods_l, arg * 3, nrows, lane, gw, NGW, CTXR, (const float*)(ws + WS_PART), npart, pgate);
    } else if constexpr (OP == OP_GQK) {
        pg8::Gemm g{HN, WB + (size_t)j * 4 * MEL, MT, 2048, DM, 0, 0};
        pg8::StaticOrder S; S.init(g.M, g.N, G, opaque_bid());
        EpiQK E{RR + R_Q, RR + R_K, a.in[9] + j * HD, a.in[10] + j * HD};
        pg8::gemm_phase<EpiQK, pg8::StaticOrder>(lds, g, S, E);
    } else if constexpr (OP == OP_GST) {
        pg8::Gemm g; EpiStore E; int c = opaque_bid();
        if (arg == 0) { g = pg8::Gemm{WB + (size_t)j * 4 * MEL + 2 * MEL, HN, DM, MT, DM, 0, 0}; E = EpiStore{RR + R_VT, MT, 0, 0}; c = (c + G - (64 % G)) % G; }
        else if (arg == 1) { g = pg8::Gemm{HN, WB + 8 * MEL + (size_t)j * 3 * MEL, MT, 2048, DM, 0, 0}; E = EpiStore{RR + R_GATE, DM, DM, (size_t)MT * DM}; }
        else { const int rbeg = arg == 2 ? 0 : 16384, nrows = arg == 2 ? 16384 : (li == 3 ? 16384 : 18432);
            g = pg8::Gemm{HN + (size_t)rbeg * DM, WB + 14 * MEL + (size_t)li * 9 * MEL, nrows, 6144, DM, 0, 0}; E = EpiStore{RR + R_U, 6144, 0, 0}; }
        pg8::StaticOrder S; S.init(g.M, g.N, G, c);
        pg8::gemm_phase<EpiStore, pg8::StaticOrder>(lds, g, S, E);
    } else if constexpr (OP == OP_GRES) {
        pg8::Gemm g; EpiRes E;
        const bool l0 = (li == 0 && arg == 0);
        E.in_lat = l0 ? a.in[0] : a.out; E.in_ctx = CTXR; E.out_lat = a.out; E.out_ctx = CTXR; E.row_off = 0;
        const bf16_t* Ap; const bf16_t* Bp; int Kd, gidx;
        if (arg == 0) { gidx = 2; Kd = DM;
            if (li & 1) { Ap = RR + R_YP; Bp = WB + 8 * MEL + (size_t)j * 3 * MEL + 2 * MEL; } else { Ap = RR + R_Q; Bp = WB + (size_t)j * 4 * MEL + 3 * MEL; }
        } else { gidx = 5; Kd = DFF; Ap = RR + R_G; Bp = WB + 14 * MEL + (size_t)li * 9 * MEL + 6 * MEL; }
        E.gate = mods_l + gidx * DM;
        g = pg8::Gemm{Ap, Bp, ML, DM, Kd, 0, 0};
        pg8::StaticOrder S; S.init(g.M, g.N, G, opaque_bid());
        pg8::gemm_phase<EpiRes, pg8::StaticOrder>(lds, g, S, E);
        if (li != 3) {
            const int nkc = Kd == DFF ? 6 : 4;
            pg8::Gemm g2{Ap, Bp, MT, DM, Kd / nkc, 0, Kd};
            CtxSplitOrder S2{nkc, G, opaque_bid(), ML / 256};
            EpiPart E2{(float*)(ws + WS_PART)};
            pg8::gemm_phase<EpiPart, CtxSplitOrder>(lds, g2, S2, E2);
        }
    } else if constexpr (OP == OP_GUP) {
        pg8::Gemm g{HN - DM, WB + 14 * MEL + (size_t)li * 9 * MEL, 138 * 256, 6144, DM, 254, 0};
        pg8::StaticOrder S; S.init(g.M, g.N, G, opaque_bid());
        EpiUpConv E{RR + R_G, a.in[23] + (size_t)li * 3 * 6144, a.in[24] + (size_t)li * 6144, (LAS float*)(lds + 132096)};
        pg8::gemm_phase<EpiUpConv, pg8::StaticOrder>(lds, g, S, E);
    } else if constexpr (OP == OP_ATTN) {
        attn_phase(RR + R_Q, rep ? RR + R_YP : RR + R_Q, RR + R_K, RR + R_VT, a.in[11] + (size_t)j * NH * 465, lds, tid, lane, wave, G);
    } else if constexpr (OP == OP_LCONV) {
        lconv_phase(RR + R_REC, RR + R_XR, a.in[14] + (size_t)j * 4 * DM, a.in[15] + (size_t)j * DM, tid, G);
    } else if constexpr (OP == OP_LRUA) {
    } else if constexpr (OP == OP_LRUC) {
        lru_block_phase(RR + R_XR, RR + R_GATE, RR + R_YP, (u32x4*)HN, BDW + (size_t)j * 4 * 16 * 4096, a.in[17] + (size_t)j * 2 * DM, a.in[19] + (size_t)j * 2 * DM, a.in[20] + (size_t)j * 2 * DM, lds, lane, wave, G);
    } else if constexpr (OP == OP_FCONV) {
        const int rbeg = arg == 2 ? 0 : 16384, nrows = arg == 2 ? 16384 : (li == 3 ? 16384 : 18432);
        fconv_phase(RR + R_U, RR + R_G, a.in[23] + (size_t)li * 3 * 6144, a.in[24] + (size_t)li * 6144, rbeg, nrows, tid, G);
    }
}

#ifdef MULTI_LAUNCH
template <int OP> __global__ void __launch_bounds__(512, 2) op_kernel(Args a, int li, int arg) {
    extern __shared__ __attribute__((aligned(16))) unsigned char lds_raw[];
    run_op<OP>(a, (LAS unsigned char*)lds_raw, li, arg, 0);
}
template <int OP> static void launch_op(const Args& a, int li, int arg, int grid, hipStream_t stream) {
    static bool attr = false;
    if (!attr) { (void)hipFuncSetAttribute((const void*)op_kernel<OP>, hipFuncAttributeMaxDynamicSharedMemorySize, LDS_BYTES); attr = true; }
    hipLaunchKernelGGL(op_kernel<OP>, dim3(grid), dim3(512), LDS_BYTES, stream, a, li, arg);
}
#else
__global__ void __launch_bounds__(512, 2) fwd_kernel(Args a) {
    extern __shared__ __attribute__((aligned(16))) unsigned char lds_raw[];
    LAS unsigned char* lds = (LAS unsigned char*)lds_raw;
    cg::grid_group grid = cg::this_grid();
    volatile LAS unsigned* bst = (volatile LAS unsigned*)(lds + 131072 + 64);
    if (threadIdx.x < 4) bst[threadIdx.x] = 0u;
    __syncthreads();
    const XcdBarrier bar = xcd_barrier_post((unsigned*)(a.ws + WS_BAR), bst);
    typedef const __attribute__((address_space(4))) Args* KArgP;
    const int pc_lo = a.pc_lo, pc_hi = a.pc_hi;
    for (int pc = pc_lo; pc < pc_hi; ++pc) {
        const int op = PROG[pc][0], li = PROG[pc][1], arg = PROG[pc][2], sync = PROG[pc][3];
        KArgP kap = (KArgP)__builtin_amdgcn_kernarg_segment_ptr();
        asm volatile("" : "+s"(kap));
        const Args& a = *(const Args*)kap;
        const int rep = (op == OP_ATTN) ? arg : 0;
        switch (op) {
            case OP_PRO: run_op<OP_PRO>(a, lds, li, arg, rep); break;
            case OP_NORM: run_op<OP_NORM>(a, lds, li, arg, rep); break;
            case OP_GQK: run_op<OP_GQK>(a, lds, li, arg, rep); break;
            case OP_GST: run_op<OP_GST>(a, lds, li, arg, rep); break;
            case OP_GRES: run_op<OP_GRES>(a, lds, li, arg, rep); break;
            case OP_ATTN: run_op<OP_ATTN>(a, lds, li, arg, rep); break;
            case OP_LCONV: run_op<OP_LCONV>(a, lds, li, arg, rep); break;
            case OP_LRUA: run_op<OP_LRUA>(a, lds, li, arg, rep); break;
            case OP_LRUC: run_op<OP_LRUC>(a, lds, li, arg, rep); break;
            default: run_op<OP_GUP>(a, lds, li, arg, rep); break;
        }
        if (sync && pc + 1 < pc_hi) { if (pc == 0) grid.sync(); else xcd_barrier(bar); }
    }
}
#endif

extern "C" void kernel_launch(void* const* d_in, const int* in_sizes, int n_in, void* d_out, int out_size, void* d_ws, size_t ws_size, hipStream_t stream) {
    static int grid = 0;
    if (grid == 0) {
        if (n_in != 26 || out_size != ML * DM || ws_size < WS_END) { fprintf(stderr, "kernel_launch: unexpected shapes: n_in %d out %d ws %zu (need %zu)\n", n_in, out_size, ws_size, (size_t)WS_END); grid = -1; return; }
        int dev = 0, cus = 0, per_cu = 1;
        (void)hipGetDevice(&dev);
        (void)hipDeviceGetAttribute(&cus, hipDeviceAttributeMultiprocessorCount, dev);
#ifndef MULTI_LAUNCH
        if (hipFuncSetAttribute((const void*)fwd_kernel, hipFuncAttributeMaxDynamicSharedMemorySize, LDS_BYTES) != hipSuccess) { fprintf(stderr, "kernel_launch: hipFuncSetAttribute failed\n"); grid = -1; return; }
        if (hipOccupancyMaxActiveBlocksPerMultiprocessor(&per_cu, (const void*)fwd_kernel, 512, LDS_BYTES) != hipSuccess || per_cu < 1) { fprintf(stderr, "kernel_launch: occupancy query gave %d\n", per_cu); per_cu = 1; }
        (void)hipGetLastError();
#endif
        grid = cus * per_cu;
        fprintf(stderr, "kernel_launch: grid %d (cus %d x %d), ws %zu\n", grid, cus, per_cu, ws_size);
    }
    if (grid < 0) return;
    Args a{};
    for (int i = 0; i < 26; ++i) a.in[i] = (const float*)d_in[i];
    a.out = (float*)d_out; a.ws = (unsigned char*)d_ws;
    a.pc_lo = 0; a.pc_hi = NPROG;
#ifdef MULTI_LAUNCH
    for (int pc = 0; pc < NPROG; ++pc) {
        const int op = HOSTPROG[pc][0], li = HOSTPROG[pc][1], arg = HOSTPROG[pc][2];
        switch (op) {
            case OP_PRO: launch_op<OP_PRO>(a, li, arg, grid, stream); break;
            case OP_NORM: launch_op<OP_NORM>(a, li, arg, grid, stream); break;
            case OP_GQK: launch_op<OP_GQK>(a, li, arg, grid, stream); break;
            case OP_GST: launch_op<OP_GST>(a, li, arg, grid, stream); break;
            case OP_GRES: launch_op<OP_GRES>(a, li, arg, grid, stream); break;
            case OP_ATTN: launch_op<OP_ATTN>(a, li, arg, grid, stream); break;
            case OP_LCONV: launch_op<OP_LCONV>(a, li, arg, grid, stream); break;
            case OP_LRUA: launch_op<OP_LRUA>(a, li, arg, grid, stream); break;
            case OP_LRUC: launch_op<OP_LRUC>(a, li, arg, grid, stream); break;
            default: launch_op<OP_GUP>(a, li, arg, grid, stream); break;
        }
    }
#else
    (void)hipMemsetAsync((char*)d_ws + WS_BAR, 0, 16384, stream);
    void* args[] = {&a};
    hipError_t e = hipLaunchCooperativeKernel((const void*)fwd_kernel, dim3(grid), dim3(512), args, LDS_BYTES, stream);
    if (e != hipSuccess) fprintf(stderr, "kernel_launch: cooperative launch failed: %s (grid %d)\n", hipGetErrorString(e), grid);
#endif
}
```

```cpp
#include <hip/hip_runtime.h>
#include <hip/hip_cooperative_groups.h>
#include <cstdio>
#include <cstdint>
namespace cg = cooperative_groups;
__device__ __forceinline__ int opaque_tid() { int t; asm volatile("v_mov_b32 %0, %1" : "=v"(t) : "v"((int)threadIdx.x)); return t; }
__device__ __forceinline__ int opaque_bid() { int t; asm volatile("s_mov_b32 %0, %1" : "=s"(t) : "s"((int)blockIdx.x)); return t; }
#define LAS __attribute__((address_space(3)))
namespace pg8 {
#define PG8_LAS __attribute__((address_space(3)))
typedef unsigned short bf16_t;
typedef short bf16x8 __attribute__((ext_vector_type(8)));
typedef float f32x4 __attribute__((ext_vector_type(4)));
typedef unsigned u32x4 __attribute__((ext_vector_type(4)));
constexpr int BM = 256, BK = 64, HALF = 128, HTB = HALF * BK * 2  , STAGE_BYTES = 8 * HTB, NXCD = 8, WGM = 8;

__host__ __device__ __forceinline__ int lds_byte(int r, int c) { const int st = (r >> 4) * 2 + (c >> 5), rr = r & 15, cc = c & 31, ob = rr * 64 + cc * 2; return st * 1024 + (ob ^ (((ob >> 9) & 1) << 5)); }
__host__ __device__ __forceinline__ void stage_rc(int b, int& R, int& C) { const int st = b / 1024, sb = b % 1024, swz = sb ^ (((sb >> 9) & 1) << 5); R = (st >> 1) * 16 + swz / 64; C = (st & 1) * 32 + (swz % 64) / 2; }
__host__ __device__ __forceinline__ int perm32(int rho) { const int n = rho >> 4, i = rho & 15; return 8 * (i >> 2) + 4 * n + (i & 3); }

struct Unit { int pm, pn, kc; };
struct Gemm { const bf16_t* A; const bf16_t* Bt; int M, N, K; int a_step_rows; int ldk; };

struct StaticOrder {
    int nM, nN, nwg, G, c;
    __host__ __device__ void init(int M, int N, int G_, int c_) { nM = M / BM; nN = N / BM; nwg = nM * nN; G = G_; c = c_; }
    __host__ __device__ bool next(int i, Unit& u) const {
        const long L = (long)i * G + c; if (L >= nwg) return false;
        int wgid = (int)L; { const int q = nwg / NXCD, r = nwg % NXCD, xcd = wgid % NXCD, off = wgid / NXCD; wgid = (xcd < r ? xcd * (q + 1) : r * (q + 1) + (xcd - r) * q) + off; }
        const int nig = WGM * nN, gid = wgid / nig, fm = gid * WGM, gsz = (nM - fm) < WGM ? (nM - fm) : WGM;
        u.pm = fm + ((wgid % nig) % gsz); u.pn = (wgid % nig) / gsz; u.kc = 0; return true;
    }
    __device__ __forceinline__ void a_ready(const Unit&) const {}
    __device__ __forceinline__ void done(const Unit&) const {}
};
__device__ __forceinline__ unsigned cvt_pk_bf16(float lo, float hi) { unsigned r; asm volatile("v_cvt_pk_bf16_f32 %0, %1, %2" : "=v"(r) : "v"(lo), "v"(hi)); return r; }
template <class Epi, class Sched>
__device__ __forceinline__ void gemm_phase(PG8_LAS unsigned char* lds, const Gemm g, const Sched& S, const Epi& E) {
    const int tid = opaque_tid(), wid = __builtin_amdgcn_readfirstlane(tid >> 6), lane = tid & 63, wr = wid >> 2, wc = wid & 3, fr = lane & 15, fq = lane >> 4;
    const int K = g.K, nt = K / BK, P = g.ldk ? g.ldk : K;
    unsigned voffA[2], voffB[2];
#pragma unroll
    for (int i = 0; i < 2; ++i) { int R, C; stage_rc(tid * 16 + i * 8192, R, C); const int Rb = Epi::PERM ? ((R & ~31) + perm32(R & 31)) : R;
        voffA[i] = (unsigned)(R * P + C) * 2u; voffB[i] = (unsigned)(Rb * P + C) * 2u; }
    const size_t kstep = (size_t)(BK * 2);
    const size_t hstep = (size_t)HALF * P * 2;
    const size_t tstep = 2 * hstep; const size_t tstepA = g.a_step_rows ? (size_t)g.a_step_rows * P * 2 : tstep; const size_t cstep = (size_t)K * 2;
    const unsigned ldsw = (unsigned)wid * 1024u;
    const int aoff = lds_byte(wr * 64 + fr, fq * 8), boff = lds_byte(wc * 32 + fr, fq * 8);
#define PG8_SA(b, h) (((b) * 2 + (h)) * HTB)
#define PG8_SB(b, h) ((4 + (b) * 2 + (h)) * HTB)
#define PG8_STAGE(bufoff, gbase, voff) do { _Pragma("unroll") for (int _i = 0; _i < 2; ++_i) \
        __builtin_amdgcn_global_load_lds((const unsigned*)((const char*)(gbase) + (voff)[_i]), (PG8_LAS unsigned*)(lds + (bufoff) + ldsw + _i * 8192), 16, 0, 0); } while (0)
#define PG8_LDA(dst, b, h) do { _Pragma("unroll") for (int m = 0; m < 4; ++m) _Pragma("unroll") for (int k = 0; k < 2; ++k) dst[m][k] = *(const PG8_LAS bf16x8*)(lds + PG8_SA(b, h) + aoff + m * 2048 + k * 1024); } while (0)
#define PG8_LDB(dst, b, h) do { _Pragma("unroll") for (int n = 0; n < 2; ++n) _Pragma("unroll") for (int k = 0; k < 2; ++k) dst[n][k] = *(const PG8_LAS bf16x8*)(lds + PG8_SB(b, h) + boff + n * 2048 + k * 1024); } while (0)
#define PG8_MMA(ai, bj, At, Bt) do { __builtin_amdgcn_s_setprio(1); _Pragma("unroll") for (int m = 0; m < 4; ++m) _Pragma("unroll") for (int n = 0; n < 2; ++n) _Pragma("unroll") for (int k = 0; k < 2; ++k) \
        acc[ai][bj][m][n] = __builtin_amdgcn_mfma_f32_16x16x32_bf16(Bt[n][k], At[m][k], acc[ai][bj][m][n], 0, 0, 0); __builtin_amdgcn_s_setprio(0); } while (0)
#define PG8_WAIT_V(n) asm volatile("s_waitcnt vmcnt(" #n ")" ::: "memory")
#define PG8_WAIT_L(n) asm volatile("s_waitcnt lgkmcnt(" #n ")" ::: "memory")
#define PG8_BAR __builtin_amdgcn_s_barrier()
#define PG8_SCHED __builtin_amdgcn_sched_barrier(0)
    Unit cur, nxt; int ui = 0;
    if (!S.next(0, cur)) return;
    f32x4 acc[2][2][4][2];
#pragma unroll
    for (int a = 0; a < 2; ++a)
#pragma unroll
        for (int b = 0; b < 2; ++b)
#pragma unroll
            for (int m = 0; m < 4; ++m)
#pragma unroll
                for (int n = 0; n < 2; ++n) acc[a][b][m][n] = (f32x4){0.f, 0.f, 0.f, 0.f};
    bf16x8 At[4][2], B0[2][2], B1[2][2];
    const char* cA = (const char*)g.A + (size_t)cur.pm * tstepA + (size_t)cur.kc * cstep; const char* cB = (const char*)g.Bt + (size_t)cur.pn * tstep + (size_t)cur.kc * cstep;
    S.a_ready(cur);
    PG8_STAGE(PG8_SB(0, 0), cB, voffB); PG8_STAGE(PG8_SA(0, 0), cA, voffA); PG8_STAGE(PG8_SB(0, 1), cB + hstep, voffB); PG8_STAGE(PG8_SA(0, 1), cA + hstep, voffA);
    if (wr == 1) PG8_BAR;
    PG8_WAIT_V(4); PG8_BAR;
    PG8_STAGE(PG8_SB(1, 0), cB + kstep, voffB); PG8_STAGE(PG8_SA(1, 0), cA + kstep, voffA); PG8_STAGE(PG8_SB(1, 1), cB + hstep + kstep, voffB);
    PG8_WAIT_V(6); PG8_BAR;
    for (;;) {
        const bool has_next = S.next(ui + 1, nxt);
        const char* nA = has_next ? (const char*)g.A + (size_t)nxt.pm * tstepA + (size_t)nxt.kc * cstep : cA; const char* nB = has_next ? (const char*)g.Bt + (size_t)nxt.pn * tstep + (size_t)nxt.kc * cstep : cB;
        for (int t = 0; t < nt; t += 2) {
            const bool last = (t == nt - 2);
            const char* a1 = cA + (size_t)(t + 1) * kstep;
            const char* a2 = last ? nA : cA + (size_t)(t + 2) * kstep; const char* b2 = last ? nB : cB + (size_t)(t + 2) * kstep;
            const char* a3 = a2 + kstep; const char* b3 = b2 + kstep;
            if (last && has_next) S.a_ready(nxt);
            PG8_LDB(B0, 0, 0); PG8_SCHED; PG8_LDA(At, 0, 0); PG8_STAGE(PG8_SA(1, 1), a1 + hstep, voffA);
            PG8_WAIT_L(8); PG8_BAR; PG8_WAIT_L(0); PG8_MMA(0, 0, At, B0); PG8_BAR; PG8_SCHED;
            PG8_LDB(B1, 0, 1); PG8_STAGE(PG8_SB(0, 0), b2, voffB);
            PG8_BAR; PG8_WAIT_L(0); PG8_MMA(0, 1, At, B1); PG8_BAR;
            PG8_LDA(At, 0, 1); PG8_STAGE(PG8_SA(0, 0), a2, voffA);
            PG8_BAR; PG8_WAIT_L(0); PG8_MMA(1, 0, At, B0); PG8_BAR; PG8_SCHED;
            PG8_STAGE(PG8_SB(0, 1), b2 + hstep, voffB);
            PG8_WAIT_V(6); PG8_BAR; PG8_MMA(1, 1, At, B1); PG8_BAR;
            PG8_LDB(B0, 1, 0); PG8_SCHED; PG8_LDA(At, 1, 0); PG8_STAGE(PG8_SA(0, 1), a2 + hstep, voffA);
            PG8_WAIT_L(8); PG8_BAR; PG8_WAIT_L(0); PG8_MMA(0, 0, At, B0); PG8_BAR; PG8_SCHED;
            PG8_LDB(B1, 1, 1); PG8_STAGE(PG8_SB(1, 0), b3, voffB);
            PG8_BAR; PG8_WAIT_L(0); PG8_MMA(0, 1, At, B1); PG8_BAR;
            PG8_LDA(At, 1, 1); PG8_STAGE(PG8_SA(1, 0), a3, voffA);
            PG8_BAR; PG8_WAIT_L(0); PG8_MMA(1, 0, At, B0); PG8_BAR; PG8_SCHED;
            PG8_STAGE(PG8_SB(1, 1), b3 + hstep, voffB);
            PG8_WAIT_V(6); PG8_BAR; PG8_MMA(1, 1, At, B1); PG8_BAR;
        }
        if constexpr (!Epi::AFTER_DRAIN) { E(acc, cur, wr, wc, fr, fq); S.done(cur); }
        if (!has_next) break;
#pragma unroll
        for (int a = 0; a < 2; ++a)
#pragma unroll
            for (int b = 0; b < 2; ++b)
#pragma unroll
                for (int m = 0; m < 4; ++m)
#pragma unroll
                    for (int n = 0; n < 2; ++n) acc[a][b][m][n] = (f32x4){0.f, 0.f, 0.f, 0.f};
        cur = nxt; cA = nA; cB = nB; ++ui;
    }
    PG8_WAIT_V(0);
    if (wr == 0) PG8_BAR;
    PG8_BAR;
    if constexpr (Epi::AFTER_DRAIN) { E.fused(acc, cur, wr, wc, fr, fq, lds, wid, lane); S.done(cur); }
#undef PG8_SA
#undef PG8_SB
#undef PG8_STAGE
#undef PG8_LDA
#undef PG8_LDB
#undef PG8_MMA
#undef PG8_WAIT_V
#undef PG8_WAIT_L
#undef PG8_BAR
#undef PG8_SCHED
}
}
#define XB_TMO      128
#define XB_XCNT(j)  (256  + 64 * (j))
#define XB_XSUB(j)  (1280 + 64 * (j))
#define XB_XGEN(j)  (2304 + 64 * (j))
#define XB_TOP      3328
#define XB_TOPGEN   3392
#define XCD_BAR_WORDS 3456
#define XB_SPIN_CAP (1u << 18)

__device__ __forceinline__ unsigned xb_ld(unsigned* p)              { return __hip_atomic_load(p, __ATOMIC_RELAXED, __HIP_MEMORY_SCOPE_AGENT); }
__device__ __forceinline__ unsigned xb_add(unsigned* p, unsigned v) { return __hip_atomic_fetch_add(p, v, __ATOMIC_RELAXED, __HIP_MEMORY_SCOPE_AGENT); }
__device__ __forceinline__ unsigned xb_xcc_id() { return (unsigned)__builtin_amdgcn_s_getreg((3 << 11) | 20) & 0xFu; }
#define XB_SPIN(cond, bar) do { unsigned _sp = 0; while (cond) { __builtin_amdgcn_s_sleep(1); \
    if ((++_sp & 255u) == 0u) { if (xb_ld(&(bar)[XB_TMO])) break; if (_sp > XB_SPIN_CAP) { atomicAdd(&(bar)[XB_TMO], 1u); break; } } } } while (0)

struct XcdBarrier {
    unsigned* bar; unsigned x;
    volatile LAS unsigned* st;
};

__device__ __forceinline__ XcdBarrier xcd_barrier_post(unsigned* bar, volatile LAS unsigned* st) {
    XcdBarrier b; b.bar = bar; b.x = xb_xcc_id(); b.st = st;
    if (threadIdx.x == 0) (void)xb_add(&bar[XB_XCNT(b.x)], 1u);
    return b;
}
__device__ __forceinline__ void xcd_barrier_complete(unsigned* bar, unsigned x, unsigned& nloc, unsigned& nx) {
    const unsigned G = gridDim.x * gridDim.y * gridDim.z;
    unsigned sum, cnt, mine, sp = 0u;
    for (;;) {
        sum = 0u; cnt = 0u; mine = 0u;
#pragma unroll
        for (unsigned j = 0; j < 16; ++j) { const unsigned c = xb_ld(&bar[XB_XCNT(j)]); sum += c; cnt += (c > 0u) ? 1u : 0u; mine = (j == x) ? c : mine; }
        if (sum == G) break;
        __builtin_amdgcn_s_sleep(1);
        if ((++sp & 255u) == 0u) { if (xb_ld(&bar[XB_TMO])) break; if (sp > XB_SPIN_CAP) { atomicAdd(&bar[XB_TMO], 1u); break; } }
    }
    nloc = mine > 0u ? mine : 1u; nx = cnt > 0u ? cnt : 1u;
}

__device__ __forceinline__ void xcd_barrier(const XcdBarrier& b) {
    asm volatile("s_waitcnt vmcnt(0)" ::: "memory");
    __syncthreads();
    if (threadIdx.x == 0) {
        unsigned* bar = b.bar;
        __builtin_amdgcn_s_waitcnt(0);
        unsigned nloc = b.st[0], nx = b.st[1];
        if (nloc == 0u) { xcd_barrier_complete(bar, b.x, nloc, nx); b.st[0] = nloc; b.st[1] = nx; }
        const unsigned old = xb_add(&bar[XB_XSUB(b.x)], 1u);
        const unsigned gen = old / nloc;
        if (old + 1u == (gen + 1u) * nloc) {
            __builtin_amdgcn_fence(__ATOMIC_RELEASE, "agent");
            asm volatile("s_waitcnt vmcnt(0)" ::: "memory");
            const unsigned og = xb_add(&bar[XB_TOP], 1u);
            const unsigned tg = og / nx;
            if (og + 1u == (tg + 1u) * nx) xb_add(&bar[XB_TOPGEN], 1u);
            else XB_SPIN(xb_ld(&bar[XB_TOPGEN]) == tg, bar);
            __builtin_amdgcn_fence(__ATOMIC_ACQUIRE, "agent");
            xb_add(&bar[XB_XGEN(b.x)], 1u);
            asm volatile("s_waitcnt vmcnt(0)" ::: "memory");
        } else {
            XB_SPIN(xb_ld(&bar[XB_XGEN(b.x)]) == gen, bar);
            __builtin_amdgcn_fence(__ATOMIC_ACQUIRE, "agent");
            asm volatile("s_waitcnt vmcnt(0)" ::: "memory");
        }
    }
    __syncthreads();
}


using pg8::bf16_t; using pg8::bf16x8; using pg8::f32x4; using pg8::u32x4;
typedef float f32x16 __attribute__((ext_vector_type(16)));
typedef unsigned u32x2 __attribute__((ext_vector_type(2)));

constexpr int DM = 1024, NB = 8, SEQ = 4096, CTXL = 256, ML = NB * SEQ, MC = NB * CTXL, MT = ML + MC, NH = 16, HD = 64, DFF = 3072;
constexpr int NCHUNK = 34;
constexpr float EPSN = 1e-6f;
constexpr size_t MiB = (size_t)1 << 20, MEL = (size_t)1 << 20;
constexpr size_t WS_MODS = 0, WS_SUM = 1 * MiB, WS_BAR = 8 * MiB, WS_BDW = 9 * MiB, WS_CTXR = 10 * MiB, WS_WB = 18 * MiB, WS_HN = 118 * MiB, WS_R = 186 * MiB, WS_PART = (186 + 272) * MiB, WS_END = 510 * MiB;
constexpr size_t R_Q = 0, R_K = (size_t)MT * DM, R_VT = 2 * (size_t)MT * DM;
constexpr size_t R_GATE = 0, R_REC = (size_t)MT * DM, R_XR = 2 * (size_t)MT * DM, R_YP = 3 * (size_t)MT * DM;
constexpr size_t R_U = 0, R_G = 0;
constexpr int LDS_BYTES = 147456;

enum { OP_PRO = 0, OP_NORM, OP_GQK, OP_GST, OP_GRES, OP_ATTN, OP_LCONV, OP_LRUA, OP_LRUC, OP_FCONV, OP_GUP };
#ifndef DUP_MASK
#define DUP_MASK 0
#endif
#define DUPE(op, i, arg) DUPE_(((DUP_MASK >> op) & 1), op, i, arg)
#define DUPE_(c, op, i, arg) DUPE__(c, op, i, arg)
#define DUPE__(c, op, i, arg) DUPE_##c(op, i, arg)
#define DUPE_0(op, i, arg)
#define DUPE_1(op, i, arg) {op, i, arg, 0},
#if DUP_MASK & 2
#define DN(i, a) {OP_NORM, i, a, 0},
#else
#define DN(i, a)
#endif
#if DUP_MASK & 4
#define DQK(i) {OP_GQK, i, 0, 0},
#else
#define DQK(i)
#endif
#if DUP_MASK & 8
#define DST(i, a) {OP_GST, i, a, 0},
#else
#define DST(i, a)
#endif
#if DUP_MASK & 32
#define DAT(i) {OP_ATTN, i, 1, 0},
#else
#define DAT(i)
#endif
#if DUP_MASK & 64
#define DLC(i) {OP_LCONV, i, 0, 0},
#else
#define DLC(i)
#endif
#if DUP_MASK & 128
#define DLA(i) {OP_LRUA, i, 0, 0},
#else
#define DLA(i)
#endif
#if DUP_MASK & 256
#define DLCC(i) {OP_LRUC, i, 0, 0},
#else
#define DLCC(i)
#endif
#if DUP_MASK & 1024
#define DUP_(i) {OP_GUP, i, 0, 0},
#else
#define DUP_(i)
#endif
#if DUP_MASK & 1
#define DPRO {OP_PRO, 0, 0, 0},
#else
#define DPRO
#endif
#define FFN_OPS(i) DN(i, 1) {OP_NORM, i, 1, 1}, DUP_(i) {OP_GUP, i, 0, 1}, {OP_GRES, i, 2, 1}
#define NA_OPS(i) DN(i, 0) {OP_NORM, i, 0, 1}, DQK(i) {OP_GQK, i, 0, 0}, DST(i, 0) {OP_GST, i, 0, 1}, DAT(i) {OP_ATTN, i, 0, 1}, {OP_GRES, i, 0, 1}, FFN_OPS(i)
#define LRU_OPS(i) DN(i, 0) {OP_NORM, i, 0, 1}, DST(i, 1) {OP_GST, i, 1, 1}, DLC(i) {OP_LCONV, i, 0, 1}, DLCC(i) {OP_LRUC, i, 0, 1}, {OP_GRES, i, 0, 1}, FFN_OPS(i)
#define PROG_INIT { DPRO {OP_PRO, 0, 0, 1}, NA_OPS(0), LRU_OPS(1), NA_OPS(2), LRU_OPS(3) }
__device__ const int PROG[][4] = PROG_INIT;
static const int HOSTPROG[][4] = PROG_INIT;
constexpr int NPROG = (int)(sizeof(HOSTPROG) / sizeof(HOSTPROG[0]));

struct Args { const float* in[26]; float* out; unsigned char* ws; int pc_lo, pc_hi; };

__device__ __forceinline__ unsigned pk2(float lo, float hi) { unsigned r; asm("v_cvt_pk_bf16_f32 %0, %1, %2" : "=v"(r) : "v"(lo), "v"(hi)); return r; }
__device__ __forceinline__ unsigned f2bf(float f) { return pk2(f, 0.0f) & 0xffffu; }
__device__ __forceinline__ float bflo(unsigned w) { return __uint_as_float(w << 16); }
__device__ __forceinline__ float bfhi(unsigned w) { return __uint_as_float(w & 0xffff0000u); }
__device__ __forceinline__ float wave_sum(float v) {
#pragma unroll
    for (int o = 1; o < 64; o <<= 1) v += __shfl_xor(v, o);
    return v;
}
__device__ __forceinline__ float fexp(float x) { return __builtin_amdgcn_exp2f(x * 1.4426950408889634f); }
__device__ __forceinline__ float sigmoidf_(float x) { return __builtin_amdgcn_rcpf(1.0f + __builtin_amdgcn_exp2f(x * -1.4426950408889634f)); }
__device__ __forceinline__ f32x16 mfma32(bf16x8 a, bf16x8 b, f32x16 c) { return __builtin_amdgcn_mfma_f32_32x32x16_bf16(a, b, c, 0, 0, 0); }
__device__ __forceinline__ f32x4 mfma16(bf16x8 a, bf16x8 b, f32x4 c) { return __builtin_amdgcn_mfma_f32_16x16x32_bf16(a, b, c, 0, 0, 0); }

struct EpiStore {
    static constexpr bool PERM = true, AFTER_DRAIN = false;
    bf16_t* O; int ldc; int split_cols; size_t split_stride;
    __device__ __forceinline__ void operator()(const f32x4 (&acc)[2][2][4][2], const pg8::Unit& u, int wr, int wc, int fr, int fq) const {
        const int row0 = u.pm * 256 + wr * 64 + fr; int colt = u.pn * 256; bf16_t* base = O;
        if (split_cols) { const int t = colt / split_cols; base += (size_t)t * split_stride; colt -= t * split_cols; }
        const int col0 = colt + wc * 32 + 8 * fq;
#pragma unroll
        for (int ai = 0; ai < 2; ++ai)
#pragma unroll
            for (int m = 0; m < 4; ++m) { bf16_t* rowp = base + (size_t)(row0 + ai * 128 + m * 16) * ldc + col0;
#pragma unroll
                for (int bj = 0; bj < 2; ++bj) { const f32x4 v0 = acc[ai][bj][m][0], v1 = acc[ai][bj][m][1];
                    u32x4 w; w.x = pg8::cvt_pk_bf16(v0[0], v0[1]); w.y = pg8::cvt_pk_bf16(v0[2], v0[3]); w.z = pg8::cvt_pk_bf16(v1[0], v1[1]); w.w = pg8::cvt_pk_bf16(v1[2], v1[3]);
                    *(u32x4*)(rowp + bj * 128) = w; } }
    }
};
struct EpiQK {
    static constexpr bool PERM = true, AFTER_DRAIN = false;
    bf16_t* Q; bf16_t* K; const float* qg; const float* kg;
    __device__ __forceinline__ void operator()(const f32x4 (&acc)[2][2][4][2], const pg8::Unit& u, int wr, int wc, int fr, int fq) const {
        const int row0 = u.pm * 256 + wr * 64 + fr; const bool isk = u.pn >= 4;
        bf16_t* base = (isk ? K : Q) + (u.pn & 3) * 256 + 64 * wc + 8 * fq;
        const float* g = isk ? kg : qg; const float sc = isk ? 1.0f : 0.125f * 1.4426950408889634f;
        f32x4 gv[2][2];
#pragma unroll
        for (int bj = 0; bj < 2; ++bj)
#pragma unroll
            for (int n = 0; n < 2; ++n) gv[bj][n] = *(const f32x4*)(g + 32 * bj + 8 * fq + 4 * n) * sc;
#pragma unroll
        for (int ai = 0; ai < 2; ++ai)
#pragma unroll
            for (int m = 0; m < 4; ++m) {
                float ss = 0.f;
#pragma unroll
                for (int bj = 0; bj < 2; ++bj)
#pragma unroll
                    for (int n = 0; n < 2; ++n) { const f32x4 x = acc[ai][bj][m][n]; ss += (x[0] * x[0] + x[1] * x[1]) + (x[2] * x[2] + x[3] * x[3]); }
                ss += __shfl_xor(ss, 16); ss += __shfl_xor(ss, 32);
                const float rs = __builtin_amdgcn_rsqf(ss * (1.0f / 64.0f) + EPSN);
                bf16_t* rowp = base + (size_t)(row0 + ai * 128 + m * 16) * DM;
#pragma unroll
                for (int bj = 0; bj < 2; ++bj) { const f32x4 v0 = acc[ai][bj][m][0] * rs * gv[bj][0], v1 = acc[ai][bj][m][1] * rs * gv[bj][1];
                    u32x4 w; w.x = pg8::cvt_pk_bf16(v0[0], v0[1]); w.y = pg8::cvt_pk_bf16(v0[2], v0[3]); w.z = pg8::cvt_pk_bf16(v1[0], v1[1]); w.w = pg8::cvt_pk_bf16(v1[2], v1[3]);
                    *(u32x4*)(rowp + 32 * bj) = w; }
            }
    }
};
struct EpiRes {
    static constexpr bool PERM = false, AFTER_DRAIN = false;
    const float* in_lat; const float* in_ctx; float* out_lat; float* out_ctx; const float* gate; int row_off;
    __device__ __forceinline__ void operator()(const f32x4 (&acc)[2][2][4][2], const pg8::Unit& u, int wr, int wc, int fr, int fq) const {
        const int R0 = row_off + u.pm * 256;
        const float* inp; float* outp; int bidx;
        if (R0 < ML) { bidx = R0 >> 12; inp = in_lat + (size_t)R0 * DM; outp = out_lat + (size_t)R0 * DM; }
        else { bidx = 8; inp = in_ctx + (size_t)(R0 - ML) * DM; outp = out_ctx + (size_t)(R0 - ML) * DM; }
        const int col0 = u.pn * 256 + wc * 32 + 4 * fq;
        const float* gp = gate + (size_t)bidx * 6144 + col0;
        f32x4 gv[2][2];
#pragma unroll
        for (int bj = 0; bj < 2; ++bj)
#pragma unroll
            for (int n = 0; n < 2; ++n) gv[bj][n] = *(const f32x4*)(gp + bj * 128 + n * 16);
#pragma unroll
        for (int ai = 0; ai < 2; ++ai)
#pragma unroll
            for (int m = 0; m < 4; ++m) { const size_t ro = (size_t)(wr * 64 + fr + ai * 128 + m * 16) * DM + col0;
#pragma unroll
                for (int bj = 0; bj < 2; ++bj)
#pragma unroll
                    for (int n = 0; n < 2; ++n) { const size_t o = ro + bj * 128 + n * 16; *(f32x4*)(outp + o) = *(const f32x4*)(inp + o) + gv[bj][n] * acc[ai][bj][m][n]; } }
    }
};


struct CtxSplitOrder {
    int nkc, G, c, pm0;
    __device__ __forceinline__ bool next(int i, pg8::Unit& u) const {
        const int L = i * G + c; if (L >= 8 * 4 * nkc) return false;
        u.kc = L % nkc; u.pn = (L / nkc) & 3; u.pm = pm0 + L / (nkc * 4); return true;
    }
    __device__ __forceinline__ void a_ready(const pg8::Unit&) const {}
    __device__ __forceinline__ void done(const pg8::Unit&) const {}
};
struct EpiPart {
    static constexpr bool PERM = false, AFTER_DRAIN = false;
    float* part;
    __device__ __forceinline__ void operator()(const f32x4 (&acc)[2][2][4][2], const pg8::Unit& u, int wr, int wc, int fr, int fq) const {
        float* outp = part + ((size_t)u.kc * MC + (size_t)(u.pm * 256 - ML)) * DM;
        const int col0 = u.pn * 256 + wc * 32 + 4 * fq;
#pragma unroll
        for (int ai = 0; ai < 2; ++ai)
#pragma unroll
            for (int m = 0; m < 4; ++m) { float* rp = outp + (size_t)(wr * 64 + fr + ai * 128 + m * 16) * DM + col0;
#pragma unroll
                for (int bj = 0; bj < 2; ++bj)
#pragma unroll
                    for (int n = 0; n < 2; ++n) *(f32x4*)(rp + bj * 128 + n * 16) = acc[ai][bj][m][n]; }
    }
};

template <int CTRL> __device__ __forceinline__ float dppf(float x) { return __int_as_float(__builtin_amdgcn_mov_dpp(__float_as_int(x), CTRL, 0xf, 0xf, true)); }
struct EpiUpConv {
    static constexpr bool PERM = true, AFTER_DRAIN = false;
    bf16_t* Gb; const float* cw; const float* cbias; LAS float* xb;
    __device__ __forceinline__ void operator()(const f32x4 (&acc)[2][2][4][2], const pg8::Unit& u, int wr, int wc, int fr, int fq) const {
        const int cl = 32 * wc + 8 * fq, cv = u.pn * 128 + cl;
#pragma unroll
        for (int ai = 0; ai < 2; ++ai) { const int s = 2 * ai + wr;
            if (fr == 0) { LAS float* p = xb + (s * 2 + 0) * 256 + cl; *(LAS f32x4*)p = acc[ai][0][0][0]; *(LAS f32x4*)(p + 4) = acc[ai][0][0][1]; *(LAS f32x4*)(p + 128) = acc[ai][1][0][0]; *(LAS f32x4*)(p + 132) = acc[ai][1][0][1]; }
            if (fr == 15) { LAS float* p = xb + (s * 2 + 1) * 256 + cl; *(LAS f32x4*)p = acc[ai][0][3][0]; *(LAS f32x4*)(p + 4) = acc[ai][0][3][1]; *(LAS f32x4*)(p + 128) = acc[ai][1][3][0]; *(LAS f32x4*)(p + 132) = acc[ai][1][3][1]; } }
        asm volatile("s_waitcnt lgkmcnt(0)\n\ts_barrier\n\ts_barrier" ::: "memory");
        const int R0 = 254 * u.pm - 1;
        bool bnd = false;
#pragma unroll
        for (int ai = 0; ai < 2; ++ai)
#pragma unroll
            for (int m = 0; m < 4; ++m) { const int row = R0 + 128 * ai + 64 * wr + 16 * m + fr;
                int pos, last; if (row < ML) { pos = row & (SEQ - 1); last = SEQ - 1; } else { pos = (row - ML) & (CTXL - 1); last = CTXL - 1; }
                bnd = bnd || pos == 0 || pos == last || row < 0 || row >= MT; }
        if (__builtin_amdgcn_ballot_w64(bnd) == 0ull) {
#pragma unroll
            for (int n = 0; n < 2; ++n) {
                f32x4 wv[3], wg[3], bv, bg;
#pragma unroll
                for (int k = 0; k < 3; ++k) { wv[k] = *(const f32x4*)(cw + k * 6144 + cv + 4 * n); wg[k] = *(const f32x4*)(cw + k * 6144 + DFF + cv + 4 * n); }
                bv = *(const f32x4*)(cbias + cv + 4 * n); bg = *(const f32x4*)(cbias + DFF + cv + 4 * n);
#pragma unroll
                for (int ai = 0; ai < 2; ++ai) { const int s = 2 * ai + wr;
#pragma unroll
                    for (int m = 0; m < 4; ++m) {
                        const int rl = 128 * ai + 64 * wr + 16 * m + fr, row = R0 + rl;
                        f32x4 xpv, xpg, xnv, xng;
                        if (m == 0) { const LAS float* p = xb + ((s > 0 ? s - 1 : 0) * 2 + 1) * 256 + cl + 4 * n; xpv = *(const LAS f32x4*)p; xpg = *(const LAS f32x4*)(p + 128); }
                        if (m == 3) { const LAS float* p = xb + ((s < 3 ? s + 1 : 3) * 2 + 0) * 256 + cl + 4 * n; xnv = *(const LAS f32x4*)p; xng = *(const LAS f32x4*)(p + 128); }
                        float o[4];
#pragma unroll
                        for (int e = 0; e < 4; ++e) {
                            const float cvv = acc[ai][0][m][n][e], cgg = acc[ai][1][m][n][e];
                            const float upv = m > 0 ? acc[ai][0][m > 0 ? m - 1 : 0][n][e] : xpv[e], upg = m > 0 ? acc[ai][1][m > 0 ? m - 1 : 0][n][e] : xpg[e];
                            const float dnv = m < 3 ? acc[ai][0][m < 3 ? m + 1 : 3][n][e] : xnv[e], dng = m < 3 ? acc[ai][1][m < 3 ? m + 1 : 3][n][e] : xng[e];
                            const float xpv_ = fr == 15 ? upv : cvv, xpg_ = fr == 15 ? upg : cgg;
                            const float xnv_ = fr == 0 ? dnv : cvv, xng_ = fr == 0 ? dng : cgg;
                            float val = bv[e] + wv[1][e] * cvv; val += wv[0][e] * dppf<0x121>(xpv_); val += wv[2][e] * dppf<0x12F>(xnv_);
                            float gt = bg[e] + wg[1][e] * cgg; gt += wg[0][e] * dppf<0x121>(xpg_); gt += wg[2][e] * dppf<0x12F>(xng_);
                            o[e] = val * gt * sigmoidf_(gt);
                        }
                        u32x2 ow; ow.x = pg8::cvt_pk_bf16(o[0], o[1]); ow.y = pg8::cvt_pk_bf16(o[2], o[3]);
                        if (rl >= 1 && rl <= 254) *(u32x2*)(Gb + (size_t)row * DFF + cv + 4 * n) = ow;
                    }
                }
            }
            return;
        }
#pragma unroll
        for (int n = 0; n < 2; ++n) {
            f32x4 wv[3], wg[3], bv, bg;
#pragma unroll
            for (int k = 0; k < 3; ++k) { wv[k] = *(const f32x4*)(cw + k * 6144 + cv + 4 * n); wg[k] = *(const f32x4*)(cw + k * 6144 + DFF + cv + 4 * n); }
            bv = *(const f32x4*)(cbias + cv + 4 * n); bg = *(const f32x4*)(cbias + DFF + cv + 4 * n);
#pragma unroll
            for (int ai = 0; ai < 2; ++ai) { const int s = 2 * ai + wr;
#pragma unroll
                for (int m = 0; m < 4; ++m) {
                    const int rl = 128 * ai + 64 * wr + 16 * m + fr, row = R0 + rl;
                    int pos, last; if (row < ML) { pos = row & (SEQ - 1); last = SEQ - 1; } else { pos = (row - ML) & (CTXL - 1); last = CTXL - 1; }
                    const bool pok = pos > 0, nok = pos < last;
                    f32x4 xpv, xpg, xnv, xng;
                    if (m == 0) { const LAS float* p = xb + ((s > 0 ? s - 1 : 0) * 2 + 1) * 256 + cl + 4 * n; xpv = *(const LAS f32x4*)p; xpg = *(const LAS f32x4*)(p + 128); }
                    if (m == 3) { const LAS float* p = xb + ((s < 3 ? s + 1 : 3) * 2 + 0) * 256 + cl + 4 * n; xnv = *(const LAS f32x4*)p; xng = *(const LAS f32x4*)(p + 128); }
                    float o[4];
#pragma unroll
                    for (int e = 0; e < 4; ++e) {
                        const float cvv = acc[ai][0][m][n][e], cgg = acc[ai][1][m][n][e];
                        const float av = dppf<0x121>(cvv), ag = dppf<0x121>(cgg);
                        float bvv, bgg;
                        if (m > 0) { bvv = dppf<0x121>(acc[ai][0][m > 0 ? m - 1 : 0][n][e]); bgg = dppf<0x121>(acc[ai][1][m > 0 ? m - 1 : 0][n][e]); } else { bvv = xpv[e]; bgg = xpg[e]; }
                        float pvv = fr == 0 ? bvv : av, pgg = fr == 0 ? bgg : ag;
                        const float a2v = dppf<0x12F>(cvv), a2g = dppf<0x12F>(cgg);
                        float b2v, b2g;
                        if (m < 3) { b2v = dppf<0x12F>(acc[ai][0][m < 3 ? m + 1 : 3][n][e]); b2g = dppf<0x12F>(acc[ai][1][m < 3 ? m + 1 : 3][n][e]); } else { b2v = xnv[e]; b2g = xng[e]; }
                        float nvv = fr == 15 ? b2v : a2v, ngg = fr == 15 ? b2g : a2g;
                        pvv = pok ? pvv : 0.f; pgg = pok ? pgg : 0.f; nvv = nok ? nvv : 0.f; ngg = nok ? ngg : 0.f;
                        const float val = bv[e] + wv[0][e] * pvv + wv[1][e] * cvv + wv[2][e] * nvv;
                        const float gt = bg[e] + wg[0][e] * pgg + wg[1][e] * cgg + wg[2][e] * ngg;
                        o[e] = val * gt * sigmoidf_(gt);
                    }
                    u32x2 ow; ow.x = pg8::cvt_pk_bf16(o[0], o[1]); ow.y = pg8::cvt_pk_bf16(o[2], o[3]);
                    if (rl >= 1 && rl <= 254 && row >= 0 && row < MT) *(u32x2*)(Gb + (size_t)row * DFF + cv + 4 * n) = ow;
                }
            }
        }
    }
};

__device__ __forceinline__ void transpose_item(const float* W, int ldw, int K, int ncol0, int ncols, bf16_t* WT, int perm, LAS float* scr, int item, int lane) {
    const int nblk = ncols / 32, kb = item / nblk, nb = item % nblk, k0 = 64 * kb, n0 = 32 * nb;
    { f32x4 v[8];
#pragma unroll
      for (int i = 0; i < 8; ++i) v[i] = *(const f32x4*)(W + (size_t)(k0 + (lane >> 3) + 8 * i) * ldw + ncol0 + n0 + 4 * (lane & 7));
#pragma unroll
      for (int i = 0; i < 8; ++i) { LAS float* d = scr + ((lane >> 3) + 8 * i) * 33 + 4 * (lane & 7); d[0] = v[i][0]; d[1] = v[i][1]; d[2] = v[i][2]; d[3] = v[i][3]; } }
    asm volatile("s_waitcnt lgkmcnt(0)" ::: "memory");
    int d0 = n0;
    if (perm == 1) { const int pn = n0 >> 8, wc = (n0 >> 6) & 3, bj = (n0 >> 5) & 1; d0 = pn * 256 + bj * 128 + wc * 32; }
    else if (perm == 2) { const int isg = n0 >= DFF, nn = isg ? n0 - DFF : n0; d0 = (nn >> 7) * 256 + isg * 128 + (nn & 127); }
    const int c = lane & 7;
#pragma unroll
    for (int j = 0; j < 4; ++j) { const int n = (lane >> 3) + 8 * j; const LAS float* s = scr + (8 * c) * 33 + n;
        u32x4 o; o.x = pk2(s[0 * 33], s[1 * 33]); o.y = pk2(s[2 * 33], s[3 * 33]); o.z = pk2(s[4 * 33], s[5 * 33]); o.w = pk2(s[6 * 33], s[7 * 33]);
        *(u32x4*)(WT + (size_t)(d0 + n) * K + k0 + 8 * c) = o; }
    asm volatile("s_waitcnt lgkmcnt(0)" ::: "memory");
}
struct TDesc { const float* src; int ldw, K, ncol0, ncols, perm; bf16_t* dst; int nitems; };
__device__ __forceinline__ TDesc get_tdesc(int m, const Args& a, bf16_t* WB) {
    TDesc t;
    if (m < 6) { const int j = m / 3, w = m % 3;
        if (w == 0) { t.src = a.in[8] + (size_t)j * DM * 3072; t.ldw = 3072; t.K = DM; t.ncol0 = 0; t.ncols = 2048; t.perm = 1; t.dst = WB + (size_t)j * 4 * MEL; }
        else if (w == 1) { t.src = a.in[8] + (size_t)j * DM * 3072; t.ldw = 3072; t.K = DM; t.ncol0 = 2048; t.ncols = 1024; t.perm = 0; t.dst = WB + (size_t)j * 4 * MEL + 2 * MEL; }
        else { t.src = a.in[12] + (size_t)j * DM * DM; t.ldw = DM; t.K = DM; t.ncol0 = 0; t.ncols = DM; t.perm = 0; t.dst = WB + (size_t)j * 4 * MEL + 3 * MEL; }
    } else if (m < 10) { const int j = (m - 6) / 2, w = (m - 6) % 2;
        if (w == 0) { t.src = a.in[13] + (size_t)j * DM * 2048; t.ldw = 2048; t.K = DM; t.ncol0 = 0; t.ncols = 2048; t.perm = 0; t.dst = WB + 8 * MEL + (size_t)j * 3 * MEL; }
        else { t.src = a.in[21] + (size_t)j * DM * DM; t.ldw = DM; t.K = DM; t.ncol0 = 0; t.ncols = DM; t.perm = 0; t.dst = WB + 8 * MEL + (size_t)j * 3 * MEL + 2 * MEL; }
    } else { const int i = (m - 10) / 2, w = (m - 10) % 2;
        if (w == 0) { t.src = a.in[22] + (size_t)i * DM * 6144; t.ldw = 6144; t.K = DM; t.ncol0 = 0; t.ncols = 6144; t.perm = 2; t.dst = WB + 14 * MEL + (size_t)i * 9 * MEL; }
        else { t.src = a.in[25] + (size_t)i * DFF * DM; t.ldw = DM; t.K = DFF; t.ncol0 = 0; t.ncols = DM; t.perm = 0; t.dst = WB + 14 * MEL + (size_t)i * 9 * MEL + 6 * MEL; }
    }
    t.nitems = (t.K / 64) * (t.ncols / 32);
    return t;
}
__device__ __forceinline__ void prologue(const Args& a, LAS unsigned char* lds, int tid, int lane, int wave, int G) {
    unsigned char* ws = a.ws;
    float* MODS = (float*)(ws + WS_MODS);
    bf16_t* WB = (bf16_t*)(ws + WS_WB);
    bf16_t* BDW = (bf16_t*)(ws + WS_BDW);
    LAS float* sl = (LAS float*)(lds + 69632);
    LAS float* red = (LAS float*)(lds + 69632 + 36864);
    for (int i = tid; i < 9 * DM; i += 512) { const int bi = i >> 10, k = i & 1023; const float v = bi < 8 ? a.in[1][bi * DM + k] : a.in[3][k]; sl[i] = v * sigmoidf_(v); }
    __syncthreads();
    for (int it = opaque_bid(); it < 4 * 96; it += G) {
        const int l = it / 96, n0 = (it % 96) * 64;
        const float* wp = a.in[4] + ((size_t)l * DM + wave * 128) * 6144 + n0 + lane;
        float acc[9];
#pragma unroll
        for (int bi = 0; bi < 9; ++bi) acc[bi] = 0.f;
        for (int k = 0; k < 128; k += 16) {
            float w[16];
#pragma unroll
            for (int kk = 0; kk < 16; ++kk) w[kk] = wp[(size_t)(k + kk) * 6144];
#pragma unroll
            for (int k4 = 0; k4 < 16; k4 += 4)
#pragma unroll
                for (int bi = 0; bi < 9; ++bi) { const f32x4 s = *(const LAS f32x4*)(sl + bi * DM + wave * 128 + k + k4); acc[bi] += (s[0] * w[k4] + s[1] * w[k4 + 1]) + (s[2] * w[k4 + 2] + s[3] * w[k4 + 3]); }
        }
#pragma unroll
        for (int bi = 0; bi < 9; ++bi) red[(wave * 9 + bi) * 64 + lane] = acc[bi];
        __syncthreads();
        for (int o = tid; o < 9 * 64; o += 512) { const int bi = o >> 6, ln = o & 63; float s = a.in[5][(size_t)l * 6144 + n0 + ln];
#pragma unroll
            for (int w = 0; w < 8; ++w) s += red[(w * 9 + bi) * 64 + ln];
            MODS[((size_t)l * 9 + bi) * 6144 + n0 + ln] = s; }
        __syncthreads();
    }
    { float* CTXR = (float*)(ws + WS_CTXR);
      for (int i = opaque_bid() * 512 + tid; i < MC * DM / 4; i += G * 512) { asm volatile("" : "+v"(i)); ((f32x4*)CTXR)[i] = ((const f32x4*)a.in[2])[i]; } }
#pragma unroll 1
    for (int idx = opaque_bid() * 512 + tid; idx < 2 * 2 * 2 * 16 * 4096; idx += G * 512) { asm volatile("" : "+v"(idx));
        const int d = idx & 63, e = (idx >> 6) & 63, n = (idx >> 12) & 15, gt = (idx >> 16) & 1, dir = (idx >> 17) & 1, j = idx >> 18;
        const float* W = gt ? a.in[18] : a.in[16];
        BDW[idx] = (bf16_t)f2bf(W[((((size_t)j * 2 + dir) * 16 + n) * 64 + d) * 64 + e]);
    }
    LAS float* scr = (LAS float*)(lds + wave * 8448);
    const int gw = opaque_bid() * 8 + wave, NGW = G * 8;
    int base = 0;
    for (int m = 0; m < 18; ++m) {
        const TDesc t = get_tdesc(m, a, WB);
        int first = (gw - base) % NGW; if (first < 0) first += NGW;
        for (int it = first; it < t.nitems; it += NGW) transpose_item(t.src, t.ldw, t.K, t.ncol0, t.ncols, t.dst, t.perm, scr, it, lane);
        base = (base + t.nitems) % NGW;
    }
}

__device__ __forceinline__ void norm_phase(const float* xl, const float* xc, bf16_t* HN, const float* gain, const float* mods_l, int sidx, int nrows, int lane, int gw, int NGW,
                                           float* ctxr_rw, const float* part, int npart, const float* pgate) {
    const bool blocked = (ML % NGW) == 0;
    const int rpw = blocked ? ML / NGW : (ML + NGW - 1) / NGW;
    const int nctx = nrows > ML ? (nrows - ML + NGW - 1) / NGW : 0;
    int curb = -1; f32x4 gm[4], shv[4];
#pragma unroll
    for (int j = 0; j < 4; ++j) { gm[j] = (f32x4){0.f, 0.f, 0.f, 0.f}; shv[j] = gm[j]; }
    for (int idx = 0; idx < rpw + nctx; ++idx) {
        int row;
        if (idx < rpw) { row = blocked ? gw * rpw + idx : gw + idx * NGW; if (row >= ML) continue; }
        else { row = ML + gw + (idx - rpw) * NGW; if (row >= nrows) continue; }
        const float* src; int bidx;
        if (row < ML) { src = xl + (size_t)row * DM; bidx = row >> 12; } else { src = xc + (size_t)(row - ML) * DM; bidx = 8; }
        const f32x4* xr = (const f32x4*)src + lane;
        f32x4 v[4]; float s = 0.f;
#pragma unroll
        for (int j = 0; j < 4; ++j) v[j] = xr[64 * j];
        if (bidx != curb) { curb = bidx;
            const float* shp = mods_l + (size_t)bidx * 6144 + sidx * DM; const float* scp = shp + DM;
#pragma unroll
            for (int j = 0; j < 4; ++j) { const int col = 4 * (lane + 64 * j); gm[j] = *(const f32x4*)(gain + col) * (*(const f32x4*)(scp + col) + 1.0f); shv[j] = *(const f32x4*)(shp + col); } }
        if (row >= ML && npart > 0) {
            f32x4 ps[4];
#pragma unroll
            for (int j = 0; j < 4; ++j) ps[j] = (f32x4){0.f, 0.f, 0.f, 0.f};
            for (int kc = 0; kc < npart; ++kc) { const f32x4* pr = (const f32x4*)(part + ((size_t)kc * MC + (row - ML)) * DM) + lane;
#pragma unroll
                for (int j = 0; j < 4; ++j) ps[j] += pr[64 * j]; }
            f32x4* wr_ = (f32x4*)(ctxr_rw + (size_t)(row - ML) * DM) + lane;
#pragma unroll
            for (int j = 0; j < 4; ++j) { v[j] += *(const f32x4*)(pgate + 4 * (lane + 64 * j)) * ps[j]; wr_[64 * j] = v[j]; }
        }
#pragma unroll
        for (int j = 0; j < 4; ++j) s += (v[j][0] * v[j][0] + v[j][1] * v[j][1]) + (v[j][2] * v[j][2] + v[j][3] * v[j][3]);
        const float rstd = __builtin_amdgcn_rsqf(wave_sum(s) * (1.0f / DM) + EPSN);
        u32x2* o8 = (u32x2*)(HN + (size_t)row * DM) + lane;
#pragma unroll
        for (int j = 0; j < 4; ++j) { const f32x4 y = v[j] * rstd * gm[j] + shv[j];
            u32x2 w; w.x = pk2(y[0], y[1]); w.y = pk2(y[2], y[3]); o8[64 * j] = w; }
    }
}

template <bool CTXQ>
__device__ __forceinline__ void attn_task(const bf16_t* QO, bf16_t* OO, const bf16_t* Kb, const bf16_t* VT, const float* rpb, int lane, int task) {
    constexpr int G0 = CTXQ ? 8 : 0;
    const int q = lane & 15, g = lane >> 4;
    int cb, r, h, b, q0, ks, rs; size_t qrow;
    if (CTXQ) { const int qb = task & 15; h = (task >> 4) & 15; b = task >> 8; cb = 0; r = 0; q0 = 0; ks = 0; rs = 0; qrow = (size_t)ML + b * CTXL + qb * 16 + q; }
    else { cb = task & 3; r = (task >> 2) & 63; h = (task >> 8) & 15; b = task >> 12; q0 = cb * 16; ks = min(max(q0 - 8, 0), 32); rs = min(max(r - 4, 0), 56); qrow = (size_t)b * SEQ + r * 64 + q0 + q; }
    const bf16x8 qf0 = *(const bf16x8*)(QO + qrow * DM + h * 64 + 8 * g), qf1 = *(const bf16x8*)(QO + qrow * DM + h * 64 + 32 + 8 * g);
    const int qcol = q0 + q, wstart = min(max(qcol - 8, 0), 48);
    const float* rp = rpb + h * 465;
    const int koff = 8 * (q >> 2) + (q & 3);
    f32x4 S[16][2];
#pragma unroll
    for (int grp = G0; grp < 16; ++grp) {
        const size_t base = grp < 8 ? (size_t)b * SEQ + (rs + grp) * 64 + ks : (size_t)ML + b * CTXL + 32 * (grp - 8);
#pragma unroll
        for (int T = 0; T < 2; ++T) {
            const bf16_t* kp = Kb + (base + koff + 4 * T) * DM + h * 64 + 8 * g;
            const bf16x8 kf0 = *(const bf16x8*)kp, kf1 = *(const bf16x8*)(kp + 32);
            f32x4 s = {0.f, 0.f, 0.f, 0.f};
            s = mfma16(kf0, qf0, s); s = mfma16(kf1, qf1, s);
            if (grp < 8) {
                const int drow = rs + grp - r + 7;
#pragma unroll
                for (int j = 0; j < 4; ++j) { const int kcol = ks + 8 * g + 4 * T + j; const bool ok = (kcol >= wstart) && (kcol < wstart + 16);
                    const int dcol = min(max(kcol - qcol + 15, 0), 30);
                    const float bias = rp[drow * 31 + dcol];
                    s[j] = ok ? s[j] + bias : -1e30f; }
            }
            S[grp][T] = s;
        }
    }
    float mx = -1e30f;
#pragma unroll
    for (int grp = G0; grp < 16; ++grp)
#pragma unroll
        for (int T = 0; T < 2; ++T) mx = fmaxf(mx, fmaxf(fmaxf(S[grp][T][0], S[grp][T][1]), fmaxf(S[grp][T][2], S[grp][T][3])));
    mx = fmaxf(mx, __shfl_xor(mx, 16)); mx = fmaxf(mx, __shfl_xor(mx, 32));
    float sum = 0.f;
#pragma unroll
    for (int grp = G0; grp < 16; ++grp)
#pragma unroll
        for (int T = 0; T < 2; ++T) {
#pragma unroll
            for (int j = 0; j < 4; ++j) { const float p = __expf(S[grp][T][j] - mx); S[grp][T][j] = p; sum += p; } }
    sum += __shfl_xor(sum, 16); sum += __shfl_xor(sum, 32);
    f32x4 O[4];
#pragma unroll
    for (int dt = 0; dt < 4; ++dt) O[dt] = (f32x4){0.f, 0.f, 0.f, 0.f};
#pragma unroll
    for (int grp = G0; grp < 16; ++grp) {
        const size_t base = grp < 8 ? (size_t)b * SEQ + (rs + grp) * 64 + ks : (size_t)ML + b * CTXL + 32 * (grp - 8);
        u32x4 pw; pw.x = pk2(S[grp][0][0], S[grp][0][1]); pw.y = pk2(S[grp][0][2], S[grp][0][3]); pw.z = pk2(S[grp][1][0], S[grp][1][1]); pw.w = pk2(S[grp][1][2], S[grp][1][3]);
        const bf16x8 pf = __builtin_bit_cast(bf16x8, pw);
#pragma unroll
        for (int dt = 0; dt < 4; ++dt) {
            const bf16x8 vf = *(const bf16x8*)(VT + (size_t)(h * 64 + 16 * dt + q) * MT + base + 8 * g);
            O[dt] = mfma16(vf, pf, O[dt]);
        }
        if (grp & 1) __builtin_amdgcn_sched_barrier(0);
    }
    const float inv = __builtin_amdgcn_rcpf(sum);
#pragma unroll
    for (int dt = 0; dt < 4; ++dt) { u32x2 w; w.x = pk2(O[dt][0] * inv, O[dt][1] * inv); w.y = pk2(O[dt][2] * inv, O[dt][3] * inv);
        *(u32x2*)(OO + qrow * DM + h * 64 + 16 * dt + 4 * g) = w; }
}
constexpr int AT_PITCH = 144;
template <bool CTXQ>
__device__ __forceinline__ void attn_super(const bf16_t* QO, bf16_t* OO, const bf16_t* Kb, const bf16_t* VT, const float* rpb, LAS unsigned char* lds, int tid_, int lane_, int wave, int st) {
    constexpr int G0 = CTXQ ? 8 : 0, I0 = CTXQ ? 9 : 0;
    const int tid = opaque_tid(), lane = tid & 63;
    const int q = lane & 15, g = lane >> 4;
    int b, h, r = 0, q0 = 0, ks = 0, rs = 0, kbase = 0, krl0 = 0; size_t qrow;
    if (CTXQ) { const int hf = st & 1; h = (st >> 1) & 15; b = st >> 5; qrow = (size_t)ML + b * CTXL + hf * 128 + wave * 16 + q; }
    else { const int rp = st & 31; h = (st >> 5) & 15; b = st >> 9; r = 2 * rp + (wave >> 2); q0 = (wave & 3) * 16; ks = min(max(q0 - 8, 0), 32); rs = min(max(r - 4, 0), 56);
        kbase = min(min(max(2 * rp - 4, 0), 56), 55); krl0 = rs - kbase; qrow = (size_t)b * SEQ + r * 64 + q0 + q; }
    u32x4 stg[13];
#pragma unroll
    for (int i = I0; i < 13; ++i) { const int c = tid + 512 * i, t = c >> 3, cc = c & 7;
        const size_t urow = t < 576 ? (size_t)b * SEQ + kbase * 64 + t : (size_t)ML + b * CTXL + (t - 576);
        stg[i] = *(const u32x4*)(Kb + urow * DM + h * 64 + cc * 8); }
    const bf16x8 qf0 = *(const bf16x8*)(QO + qrow * DM + h * 64 + 8 * g), qf1 = *(const bf16x8*)(QO + qrow * DM + h * 64 + 32 + 8 * g);
    LAS float* rpl = (LAS float*)(lds + 832 * AT_PITCH);
    if (!CTXQ) { if (tid < 465) rpl[tid] = rpb[h * 465 + tid] * 1.4426950408889634f; }
#pragma unroll
    for (int i = I0; i < 13; ++i) { const int c = tid + 512 * i, t = c >> 3, cc = c & 7; *(LAS u32x4*)(lds + t * AT_PITCH + cc * 16) = stg[i]; }
    __syncthreads();
    const int qcol = q0 + q, wstart = min(max(qcol - 8, 0), 48);
    const int koff = 8 * (q >> 2) + (q & 3);
    const LAS float* bptr[2][4]; float madd[2][4];
#pragma unroll
    for (int T = 0; T < 2; ++T)
#pragma unroll
        for (int j = 0; j < 4; ++j) { const int kcol = ks + 8 * g + 4 * T + j; const bool ok = (kcol >= wstart) && (kcol < wstart + 16);
            const int dcol = min(max(kcol - qcol + 15, 0), 30);
            bptr[T][j] = rpl + (rs - r + 7) * 31 + dcol; madd[T][j] = ok ? 0.0f : -1e30f; }
    f32x4 S[16][2];
#pragma unroll
    for (int grp = G0; grp < 16; ++grp) {
        const int tb = grp < 8 ? (krl0 + grp) * 64 + ks : 576 + 32 * (grp - 8);
#pragma unroll
        for (int T = 0; T < 2; ++T) {
            const LAS unsigned char* kp = lds + (tb + koff + 4 * T) * AT_PITCH + g * 16;
            const bf16x8 kf0 = *(const LAS bf16x8*)kp, kf1 = *(const LAS bf16x8*)(kp + 64);
            f32x4 s = {0.f, 0.f, 0.f, 0.f};
            s = mfma16(kf0, qf0, s); s = mfma16(kf1, qf1, s);
            if (grp < 8) {
#pragma unroll
                for (int j = 0; j < 4; ++j) s[j] += bptr[T][j][grp * 31] + madd[T][j];
            }
            S[grp][T] = s;
        }
        __builtin_amdgcn_sched_barrier(0);
    }
    __syncthreads();
    float mx = -1e30f;
#pragma unroll
    for (int grp = G0; grp < 16; ++grp)
#pragma unroll
        for (int T = 0; T < 2; ++T) mx = fmaxf(mx, fmaxf(fmaxf(S[grp][T][0], S[grp][T][1]), fmaxf(S[grp][T][2], S[grp][T][3])));
    mx = fmaxf(mx, __shfl_xor(mx, 16)); mx = fmaxf(mx, __shfl_xor(mx, 32));
    float sum = 0.f;
    u32x4 P[16];
#pragma unroll
    for (int grp = G0; grp < 16; ++grp) {
        float p[8];
#pragma unroll
        for (int T = 0; T < 2; ++T)
#pragma unroll
            for (int j = 0; j < 4; ++j) { p[4 * T + j] = __builtin_amdgcn_exp2f(S[grp][T][j] - mx); sum += p[4 * T + j]; }
        P[grp].x = pk2(p[0], p[1]); P[grp].y = pk2(p[2], p[3]); P[grp].z = pk2(p[4], p[5]); P[grp].w = pk2(p[6], p[7]);
        __builtin_amdgcn_sched_barrier(0);
    }
    sum += __shfl_xor(sum, 16); sum += __shfl_xor(sum, 32);
#pragma unroll
    for (int i = I0; i < 13; ++i) { const int d = (tid >> 3) & 63, cc = tid & 7;
        const size_t tokb = i < 9 ? (size_t)b * SEQ + (kbase + i) * 64 : (size_t)ML + b * CTXL + (i - 9) * 64;
        stg[i] = *(const u32x4*)(VT + (size_t)(h * 64 + d) * MT + tokb + cc * 8); }
#pragma unroll
    for (int i = I0; i < 13; ++i) { const int d = (tid >> 3) & 63, cc = tid & 7; *(LAS u32x4*)(lds + (i * 64 + d) * AT_PITCH + cc * 16) = stg[i]; }
    __syncthreads();
    f32x4 O[4];
#pragma unroll
    for (int dt = 0; dt < 4; ++dt) O[dt] = (f32x4){0.f, 0.f, 0.f, 0.f};
#pragma unroll
    for (int grp = G0; grp < 16; ++grp) {
        const int blk = grp < 8 ? krl0 + grp : 9 + ((grp - 8) >> 1), col = grp < 8 ? ks : 32 * ((grp - 8) & 1);
        const bf16x8 pf = __builtin_bit_cast(bf16x8, P[grp]);
#pragma unroll
        for (int dt = 0; dt < 4; ++dt) {
            const bf16x8 vf = *(const LAS bf16x8*)(lds + (blk * 64 + 16 * dt + q) * AT_PITCH + (col + 8 * g) * 2);
            O[dt] = mfma16(vf, pf, O[dt]);
        }
        if (grp & 1) __builtin_amdgcn_sched_barrier(0);
    }
    const float inv = __builtin_amdgcn_rcpf(sum);
#pragma unroll
    for (int dt = 0; dt < 4; ++dt) { u32x2 w; w.x = pk2(O[dt][0] * inv, O[dt][1] * inv); w.y = pk2(O[dt][2] * inv, O[dt][3] * inv);
        *(u32x2*)(OO + qrow * DM + h * 64 + 16 * dt + 4 * g) = w; }
    __syncthreads();
}
__device__ __forceinline__ void attn_phase(const bf16_t* QO, bf16_t* OO, const bf16_t* Kb, const bf16_t* VT, const float* rpb, LAS unsigned char* lds, int tid, int lane, int wave, int G) {
    const int bid = opaque_bid();
    if (G == 256) {
        const int x = bid & 7, c = bid >> 3;
        for (int it = 0; it < 16; ++it) attn_super<false>(QO, OO, Kb, VT, rpb, lds, tid, lane, wave, ((it * 8 + x) << 5) | c);
        attn_super<true>(QO, OO, Kb, VT, rpb, lds, tid, lane, wave, ((((c >> 1) * 8) + x) << 1) | (c & 1));
    } else {
        for (int st = bid; st < 4096; st += G) attn_super<false>(QO, OO, Kb, VT, rpb, lds, tid, lane, wave, st);
        for (int st = bid; st < 256; st += G) attn_super<true>(QO, OO, Kb, VT, rpb, lds, tid, lane, wave, st);
    }
}

__device__ __forceinline__ void lconv_phase(const bf16_t* REC, bf16_t* XR, const float* cw, const float* cbias, int tid, int G) {
#pragma unroll 1
    for (int it = opaque_bid() * 512 + tid; it < MT * 128; it += G * 512) { asm volatile("" : "+v"(it));
        const int row = it >> 7, ch = (it & 127) * 8;
        int pos, len; if (row < ML) { pos = row & (SEQ - 1); len = SEQ; } else { pos = (row - ML) & (CTXL - 1); len = CTXL; }
        float acc[8];
        { const f32x4 b0 = *(const f32x4*)(cbias + ch), b1 = *(const f32x4*)(cbias + ch + 4);
#pragma unroll
          for (int e = 0; e < 4; ++e) { acc[e] = b0[e]; acc[4 + e] = b1[e]; } }
#pragma unroll
        for (int k = 0; k < 4; ++k) { const int t = pos + k - 2;
            if (t >= 0 && t < len) {
                const u32x4 v = *(const u32x4*)(REC + (size_t)(row + k - 2) * DM + ch);
                const f32x4 w0 = *(const f32x4*)(cw + k * DM + ch), w1 = *(const f32x4*)(cw + k * DM + ch + 4);
                acc[0] += w0[0] * bflo(v.x); acc[1] += w0[1] * bfhi(v.x); acc[2] += w0[2] * bflo(v.y); acc[3] += w0[3] * bfhi(v.y);
                acc[4] += w1[0] * bflo(v.z); acc[5] += w1[1] * bfhi(v.z); acc[6] += w1[2] * bflo(v.w); acc[7] += w1[3] * bfhi(v.w);
            } }
        u32x4 o; o.x = pk2(acc[0], acc[1]); o.y = pk2(acc[2], acc[3]); o.z = pk2(acc[4], acc[5]); o.w = pk2(acc[6], acc[7]);
        *(u32x4*)(XR + (size_t)row * DM + ch) = o;
    }
}

template <int DIR, bool APPLY>
__device__ __forceinline__ void lru_sweep(const bf16_t* XR, const bf16_t* GATE, bf16_t* YP, const bf16_t* bdw_dir, float bias_r, float bias_i, float sp,
                                          int row0, int n, int half, int lane, float& hcar, float& ptot, unsigned (&hsf)[4][8]) {
    const int e = lane & 31, hh = lane >> 5;
    const int tau = 16 * ((e >> 2) & 1) + (e & 3) + 4 * (e >> 3);
    bf16x8 Br[4], Bi[4];
    const bf16_t* wrp = bdw_dir + (size_t)n * 4096 + (half * 32 + e) * 64 + 8 * hh;
    const bf16_t* wip = wrp + 16 * 4096;
#pragma unroll
    for (int kk = 0; kk < 4; ++kk) { Br[kk] = *(const bf16x8*)(wrp + 16 * kk); Bi[kk] = *(const bf16x8*)(wip + 16 * kk); }
    bf16x8 I0, I1;
#pragma unroll
    for (int jj = 0; jj < 8; ++jj) { I0[jj] = (8 * hh + jj == e) ? (short)0x3F80 : (short)0; I1[jj] = (16 + 8 * hh + jj == e) ? (short)0x3F80 : (short)0; }
    const bool first = (hh == DIR);
    const int chcol = n * 64 + half * 32;
    const float spm = -8.0f * 1.4426950408889634f * sp;
#pragma unroll
    for (int tt = 0; tt < 4; ++tt) {
        const int tile = DIR == 0 ? tt : 3 - tt; const int trow = row0 + tile * 32;
        const bf16_t* ap = XR + (size_t)(trow + tau) * DM + n * 64 + 8 * hh;
        bf16x8 A[4];
#pragma unroll
        for (int kk = 0; kk < 4; ++kk) A[kk] = *(const bf16x8*)(ap + 16 * kk);
        f32x16 ar, ai, xv;
#pragma unroll
        for (int r = 0; r < 16; ++r) { ar[r] = 0.f; ai[r] = 0.f; xv[r] = 0.f; }
#pragma unroll
        for (int kk = 0; kk < 4; ++kk) { ar = mfma32(A[kk], Br[kk], ar); ai = mfma32(A[kk], Bi[kk], ai); }
        const bf16x8 Ax0 = half ? A[2] : A[0], Ax1 = half ? A[3] : A[1];
        xv = mfma32(Ax0, I0, xv); xv = mfma32(Ax1, I1, xv);
        f32x16 av, bv;
#pragma unroll
        for (int r = 0; r < 16; ++r) {
            const float rg = sigmoidf_(ar[r] + bias_r), ig = sigmoidf_(ai[r] + bias_i);
            const float aa = __builtin_amdgcn_exp2f(rg * spm);
            av[r] = aa; bv[r] = __builtin_amdgcn_sqrtf(fmaxf(1.0f - aa * aa, 0.f)) * ig * xv[r];
        }
        float Hl = 0.f, Pl = 1.f;
#pragma unroll
        for (int rr = 0; rr < 16; ++rr) { const int r = DIR == 0 ? rr : 15 - rr; Hl = av[r] * Hl + bv[r]; Pl *= av[r]; }
        const float val = Hl + Pl * hcar, got = __shfl_xor(val, 32);
        const float start = first ? hcar : got;
        float endv;
        f32x16 hs;
        if (APPLY) {
            float hcur = start;
#pragma unroll
            for (int rr = 0; rr < 16; ++rr) { const int r = DIR == 0 ? rr : 15 - rr; hcur = av[r] * hcur + bv[r]; hs[r] = hcur; }
            endv = hcur;
        } else { endv = Hl + Pl * start; }
        const float got2 = __shfl_xor(endv, 32);
        hcar = first ? got2 : endv;
        if (!APPLY) ptot *= Pl * __shfl_xor(Pl, 32);
        if (APPLY) {
            if (DIR == 0) {
#pragma unroll
                for (int r2 = 0; r2 < 8; ++r2) hsf[tile][r2] = pk2(hs[2 * r2], hs[2 * r2 + 1]);
            }
            else {
                const bf16_t* gp = GATE + (size_t)(trow + tau) * DM + chcol + 8 * hh;
                const bf16x8 G0 = *(const bf16x8*)gp, G1 = *(const bf16x8*)(gp + 16);
                f32x16 gv;
#pragma unroll
                for (int r = 0; r < 16; ++r) gv[r] = 0.f;
                gv = mfma32(G0, I0, gv); gv = mfma32(G1, I1, gv);
                bf16_t* yp = YP + (size_t)(trow + 16 * hh) * DM + chcol + e;
#pragma unroll
                for (int r = 0; r < 16; ++r) { const float x = gv[r], u2 = 1.5957691216f * (x + 0.044715f * x * x * x);
                    const float hf = (r & 1) ? bfhi(hsf[tile][r >> 1]) : bflo(hsf[tile][r >> 1]);
                    const float y = (hf + hs[r]) * x * sigmoidf_(u2);
                    yp[(size_t)r * DM] = (bf16_t)f2bf(y); }
            }
        }
    }
}
template <bool APPLY>
__device__ __forceinline__ void lru_phase(const bf16_t* XR, const bf16_t* GATE, bf16_t* YP, const bf16_t* bdw_j, const float* ga_b, const float* gx_b, const float* lam, float* SUM,
                                          int lane, int gw, int NGW) {
    for (int task = gw; task < NB * NCHUNK * 32; task += NGW) {
        const int n2 = task & 31, c = (task >> 5) % NCHUNK, b = task / (32 * NCHUNK);
        const int row0 = c < 2 ? ML + b * CTXL + c * 128 : b * SEQ + (c - 2) * 128;
        const int n = n2 >> 1, half = n2 & 1, ch = n2 * 32 + (lane & 31);
        unsigned hsf[4][8];
#pragma unroll
        for (int dir = 0; dir < 2; ++dir) {
            const float bias_r = ga_b[dir * DM + ch], bias_i = gx_b[dir * DM + ch];
            const float sp = log1pf(__expf(-lam[dir * DM + ch]));
            const int p = dir == 0 ? c : (c < 2 ? 1 - c : 35 - c);
            float* sump = SUM + ((size_t)(dir * NB + b) * NCHUNK) * DM * 2 + (size_t)ch * 2;
            float hcar = 0.f, ptot = 1.f;
            if (APPLY) { for (int pp = 0; pp < p; ++pp) { const float2 ph = *(const float2*)(sump + (size_t)pp * DM * 2); hcar = ph.x * hcar + ph.y; } }
            if (dir == 0) lru_sweep<0, APPLY>(XR, GATE, YP, bdw_j, bias_r, bias_i, sp, row0, n, half, lane, hcar, ptot, hsf);
            else lru_sweep<1, APPLY>(XR, GATE, YP, bdw_j + 2 * 16 * 4096, bias_r, bias_i, sp, row0, n, half, lane, hcar, ptot, hsf);
            if (!APPLY) { if (lane < 32) *(float2*)(sump + (size_t)p * DM * 2) = make_float2(ptot, hcar); }
        }
    }
}

template <int DIR>
__device__ __forceinline__ void lru_dir(const bf16_t* XR, const bf16_t* GATE, bf16_t* YP, u32x4* HSF, const bf16_t* bdw_dir, float bias_r, float bias_i, float sp,
                                        int b, int n2, int lane, int wave, LAS float* xl) {
    const int e = lane & 31, hh = lane >> 5, n = n2 >> 1, half = n2 & 1;
    const int tau = 16 * ((e >> 2) & 1) + (e & 3) + 4 * (e >> 3);
    bf16x8 Br[4], Bi[4];
    const bf16_t* wrp = bdw_dir + (size_t)n * 4096 + (half * 32 + e) * 64 + 8 * hh;
    const bf16_t* wip = wrp + 16 * 4096;
#pragma unroll
    for (int kk = 0; kk < 4; ++kk) { Br[kk] = *(const bf16x8*)(wrp + 16 * kk); Bi[kk] = *(const bf16x8*)(wip + 16 * kk); }
    bf16x8 I0, I1;
#pragma unroll
    for (int jj = 0; jj < 8; ++jj) { I0[jj] = (8 * hh + jj == e) ? (short)0x3F80 : (short)0; I1[jj] = (16 + 8 * hh + jj == e) ? (short)0x3F80 : (short)0; }
    const bool first = (hh == DIR);
    const int chcol = n * 64 + half * 32;
    const float spm = -8.0f * 1.4426950408889634f * sp;
    float segcar = 0.f;
#pragma unroll 1
    for (int seg = 0; seg < 9; ++seg) {
        f32x16 av[2], bv[2]; float Hl[2], Pl[2]; int trow[2]; bool valid[2];
        float hloc = 0.f, ploc = 1.f;
#pragma unroll
        for (int k = 0; k < 2; ++k) {
            const int q = seg * 16 + wave * 2 + k; valid[k] = q < 136;
            const int T = DIR == 0 ? q : (q < 8 ? 7 - q : 143 - q);
            trow[k] = T < 8 ? ML + b * CTXL + 32 * T : b * SEQ + 32 * (T - 8);
            if (valid[k]) {
                const bf16_t* ap = XR + (size_t)(trow[k] + tau) * DM + n * 64 + 8 * hh;
                bf16x8 A[4];
#pragma unroll
                for (int kk = 0; kk < 4; ++kk) A[kk] = *(const bf16x8*)(ap + 16 * kk);
                f32x16 ar, ai, xv;
#pragma unroll
                for (int r = 0; r < 16; ++r) { ar[r] = 0.f; ai[r] = 0.f; xv[r] = 0.f; }
#pragma unroll
                for (int kk = 0; kk < 4; ++kk) { ar = mfma32(A[kk], Br[kk], ar); ai = mfma32(A[kk], Bi[kk], ai); }
                const bf16x8 Ax0 = half ? A[2] : A[0], Ax1 = half ? A[3] : A[1];
                xv = mfma32(Ax0, I0, xv); xv = mfma32(Ax1, I1, xv);
#pragma unroll
                for (int r = 0; r < 16; ++r) {
                    const float rg = sigmoidf_(ar[r] + bias_r), ig = sigmoidf_(ai[r] + bias_i);
                    const float aa = __builtin_amdgcn_exp2f(rg * spm);
                    av[k][r] = aa; bv[k][r] = __builtin_amdgcn_sqrtf(fmaxf(1.0f - aa * aa, 0.f)) * ig * xv[r];
                }
            } else {
#pragma unroll
                for (int r = 0; r < 16; ++r) { av[k][r] = 1.0f; bv[k][r] = 0.0f; }
            }
            float H = 0.f, P = 1.f;
#pragma unroll
            for (int rr = 0; rr < 16; ++rr) { const int r = DIR == 0 ? rr : 15 - rr; H = av[k][r] * H + bv[k][r]; P *= av[k][r]; }
            Hl[k] = H; Pl[k] = P;
            const float val = H + P * hloc, got = __shfl_xor(val, 32);
            const float st2 = first ? hloc : got;
            const float endv = H + P * st2, got2 = __shfl_xor(endv, 32);
            hloc = first ? got2 : endv;
            ploc *= P * __shfl_xor(P, 32);
        }
        LAS float* slot = xl + ((seg & 1) * 8 + wave) * 64 + e * 2;
        if (lane < 32) { slot[0] = ploc; slot[1] = hloc; }
        __syncthreads();
        float c = segcar, hcar = segcar;
#pragma unroll
        for (int w = 0; w < 8; ++w) { const LAS float* sp_ = xl + ((seg & 1) * 8 + w) * 64 + e * 2; const float P = sp_[0], H = sp_[1]; if (w == wave) hcar = c; c = P * c + H; }
        segcar = c;
#pragma unroll
        for (int k = 0; k < 2; ++k) {
            if (valid[k]) {
                const float val = Hl[k] + Pl[k] * hcar, got = __shfl_xor(val, 32);
                float hcur = first ? hcar : got;
                f32x16 hs;
#pragma unroll
                for (int rr = 0; rr < 16; ++rr) { const int r = DIR == 0 ? rr : 15 - rr; hcur = av[k][r] * hcur + bv[k][r]; hs[r] = hcur; }
                const float got2 = __shfl_xor(hcur, 32);
                hcar = first ? got2 : hcur;
                const int tg = trow[k] < ML ? (trow[k] >> 12) * 136 + 8 + ((trow[k] & (SEQ - 1)) >> 5) : b * 136 + ((trow[k] - ML - b * CTXL) >> 5);
                u32x4* hp = HSF + (((size_t)tg * 32 + n2) * 64 + lane) * 2;
                if (DIR == 0) {
                    u32x4 w0, w1;
                    w0.x = pk2(hs[0], hs[1]); w0.y = pk2(hs[2], hs[3]); w0.z = pk2(hs[4], hs[5]); w0.w = pk2(hs[6], hs[7]);
                    w1.x = pk2(hs[8], hs[9]); w1.y = pk2(hs[10], hs[11]); w1.z = pk2(hs[12], hs[13]); w1.w = pk2(hs[14], hs[15]);
                    hp[0] = w0; hp[1] = w1;
                } else {
                    const u32x4 w0 = hp[0], w1 = hp[1];
                    const unsigned hw[8] = {w0.x, w0.y, w0.z, w0.w, w1.x, w1.y, w1.z, w1.w};
                    const bf16_t* gp = GATE + (size_t)(trow[k] + tau) * DM + chcol + 8 * hh;
                    const bf16x8 G0 = *(const bf16x8*)gp, G1 = *(const bf16x8*)(gp + 16);
                    f32x16 gv;
#pragma unroll
                    for (int r = 0; r < 16; ++r) gv[r] = 0.f;
                    gv = mfma32(G0, I0, gv); gv = mfma32(G1, I1, gv);
                    bf16_t* yp = YP + (size_t)(trow[k] + 16 * hh) * DM + chcol + e;
#pragma unroll
                    for (int r = 0; r < 16; ++r) { const float x = gv[r], u2 = 1.5957691216f * (x + 0.044715f * x * x * x);
                        const float hf = (r & 1) ? bfhi(hw[r >> 1]) : bflo(hw[r >> 1]);
                        const float y = (hf + hs[r]) * x * sigmoidf_(u2);
                        yp[(size_t)r * DM] = (bf16_t)f2bf(y); }
                }
            }
        }
    }
}
__device__ __forceinline__ void lru_block_phase(const bf16_t* XR, const bf16_t* GATE, bf16_t* YP, u32x4* HSF, const bf16_t* bdw_j, const float* ga_b, const float* gx_b, const float* lam,
                                                LAS unsigned char* lds, int lane, int wave, int G) {
    LAS float* xl = (LAS float*)lds;
    for (int item = opaque_bid(); item < NB * 32; item += G) {
        const int b = item >> 5, n2 = item & 31, ch = n2 * 32 + (lane & 31);
        { const float bias_r = ga_b[ch], bias_i = gx_b[ch], sp = log1pf(__expf(-lam[ch]));
          lru_dir<0>(XR, GATE, YP, HSF, bdw_j, bias_r, bias_i, sp, b, n2, lane, wave, xl); }
        __syncthreads();
        { const float bias_r = ga_b[DM + ch], bias_i = gx_b[DM + ch], sp = log1pf(__expf(-lam[DM + ch]));
          lru_dir<1>(XR, GATE, YP, HSF, bdw_j + 2 * 16 * 4096, bias_r, bias_i, sp, b, n2, lane, wave, xl); }
        __syncthreads();
    }
}

__device__ __forceinline__ void fconv_phase(const bf16_t* U, bf16_t* Gb, const float* cw, const float* cbias, int rbeg, int nrows, int tid, int G) {
    const int total = nrows * 384;
#pragma unroll 1
    for (int it = opaque_bid() * 512 + tid; it < total; it += G * 512) { asm volatile("" : "+v"(it));
        const int r = it / 384, ch = (it % 384) * 8, row = rbeg + r;
        int pos, len; if (row < ML) { pos = row & (SEQ - 1); len = SEQ; } else { pos = (row - ML) & (CTXL - 1); len = CTXL; }
        float va[8], ga[8];
        { const f32x4 b0 = *(const f32x4*)(cbias + ch), b1 = *(const f32x4*)(cbias + ch + 4), c0 = *(const f32x4*)(cbias + DFF + ch), c1 = *(const f32x4*)(cbias + DFF + ch + 4);
#pragma unroll
          for (int e = 0; e < 4; ++e) { va[e] = b0[e]; va[4 + e] = b1[e]; ga[e] = c0[e]; ga[4 + e] = c1[e]; } }
#pragma unroll
        for (int k = 0; k < 3; ++k) { const int t = pos + k - 1;
            if (t >= 0 && t < len) {
                const bf16_t* up = U + (size_t)(r + k - 1) * 6144 + ch;
                const u32x4 v = *(const u32x4*)up, gq = *(const u32x4*)(up + DFF);
                const float* wp = cw + (size_t)k * 6144 + ch;
                const f32x4 w0 = *(const f32x4*)wp, w1 = *(const f32x4*)(wp + 4), x0 = *(const f32x4*)(wp + DFF), x1 = *(const f32x4*)(wp + DFF + 4);
                va[0] += w0[0] * bflo(v.x); va[1] += w0[1] * bfhi(v.x); va[2] += w0[2] * bflo(v.y); va[3] += w0[3] * bfhi(v.y);
                va[4] += w1[0] * bflo(v.z); va[5] += w1[1] * bfhi(v.z); va[6] += w1[2] * bflo(v.w); va[7] += w1[3] * bfhi(v.w);
                ga[0] += x0[0] * bflo(gq.x); ga[1] += x0[1] * bfhi(gq.x); ga[2] += x0[2] * bflo(gq.y); ga[3] += x0[3] * bfhi(gq.y);
                ga[4] += x1[0] * bflo(gq.z); ga[5] += x1[1] * bfhi(gq.z); ga[6] += x1[2] * bflo(gq.w); ga[7] += x1[3] * bfhi(gq.w);
            } }
        float o[8];
#pragma unroll
        for (int e = 0; e < 8; ++e) o[e] = va[e] * ga[e] * sigmoidf_(ga[e]);
        u32x4 w; w.x = pk2(o[0], o[1]); w.y = pk2(o[2], o[3]); w.z = pk2(o[4], o[5]); w.w = pk2(o[6], o[7]);
        *(u32x4*)(Gb + (size_t)r * DFF + ch) = w;
    }
}

template <int OP>
__device__ __forceinline__ void run_op(const Args& a, LAS unsigned char* lds, const int li, const int arg, const int rep) {
    const int tid = opaque_tid(), lane = tid & 63, wave = __builtin_amdgcn_readfirstlane(tid >> 6), G = gridDim.x;
    const int gw = opaque_bid() * 8 + wave, NGW = G * 8;
    unsigned char* ws = a.ws;
    float* MODS = (float*)(ws + WS_MODS);
    float* SUM = (float*)(ws + WS_SUM);
    bf16_t* BDW = (bf16_t*)(ws + WS_BDW);
    float* CTXR = (float*)(ws + WS_CTXR);
    bf16_t* WB = (bf16_t*)(ws + WS_WB);
    bf16_t* HN = (bf16_t*)(ws + WS_HN);
    bf16_t* RR = (bf16_t*)(ws + WS_R);
    const int j = li >> 1;
    const float* mods_l = MODS + (size_t)li * 9 * 6144;
    if constexpr (OP == OP_PRO) {
        prologue(a, lds, tid, lane, wave, G);
    } else if constexpr (OP == OP_NORM) {
        const bool first = (li == 0 && arg == 0);
        const float* gain = (arg ? a.in[7] : a.in[6]) + (size_t)li * DM;
        const int nrows = (arg == 1 && li == 3) ? ML : MT;
        const int npart = first ? 0 : (arg == 1 ? (li == 3 ? 0 : 4) : 6);
        const float* pgate = arg == 1 ? mods_l + 8 * 6144 + 2 * DM : MODS + (size_t)(li - 1) * 9 * 6144 + 8 * 6144 + 5 * DM;
        norm_phase(first ? a.in[0] : a.out, CTXR, HN, gain, mods_l, arg * 3, nrows, lane, gw, NGW, CTXR, (const float*)(ws + WS_PART), npart, pgate);
    } else if constexpr (OP == OP_GQK) {
        pg8::Gemm g{HN, WB + (size_t)j * 4 * MEL, MT, 2048, DM, 0, 0};
        pg8::StaticOrder S; S.init(g.M, g.N, G, opaque_bid());
        EpiQK E{RR + R_Q, RR + R_K, a.in[9] + j * HD, a.in[10] + j * HD};
        pg8::gemm_phase<EpiQK, pg8::StaticOrder>(lds, g, S, E);
    } else if constexpr (OP == OP_GST) {
        pg8::Gemm g; EpiStore E; int c = opaque_bid();
        if (arg == 0) { g = pg8::Gemm{WB + (size_t)j * 4 * MEL + 2 * MEL, HN, DM, MT, DM, 0, 0}; E = EpiStore{RR + R_VT, MT, 0, 0}; c = (c + G - (64 % G)) % G; }
        else if (arg == 1) { g = pg8::Gemm{HN, WB + 8 * MEL + (size_t)j * 3 * MEL, MT, 2048, DM, 0, 0}; E = EpiStore{RR + R_GATE, DM, DM, (size_t)MT * DM}; }
        else { const int rbeg = arg == 2 ? 0 : 16384, nrows = arg == 2 ? 16384 : (li == 3 ? 16384 : 18432);
            g = pg8::Gemm{HN + (size_t)rbeg * DM, WB + 14 * MEL + (size_t)li * 9 * MEL, nrows, 6144, DM, 0, 0}; E = EpiStore{RR + R_U, 6144, 0, 0}; }
        pg8::StaticOrder S; S.init(g.M, g.N, G, c);
        pg8::gemm_phase<EpiStore, pg8::StaticOrder>(lds, g, S, E);
    } else if constexpr (OP == OP_GRES) {
        pg8::Gemm g; EpiRes E;
        const bool l0 = (li == 0 && arg == 0);
        E.in_lat = l0 ? a.in[0] : a.out; E.in_ctx = CTXR; E.out_lat = a.out; E.out_ctx = CTXR; E.row_off = 0;
        const bf16_t* Ap; const bf16_t* Bp; int Kd, gidx;
        if (arg == 0) { gidx = 2; Kd = DM;
            if (li & 1) { Ap = RR + R_YP; Bp = WB + 8 * MEL + (size_t)j * 3 * MEL + 2 * MEL; } else { Ap = RR + R_Q; Bp = WB + (size_t)j * 4 * MEL + 3 * MEL; }
        } else { gidx = 5; Kd = DFF; Ap = RR + R_G; Bp = WB + 14 * MEL + (size_t)li * 9 * MEL + 6 * MEL; }
        E.gate = mods_l + gidx * DM;
        g = pg8::Gemm{Ap, Bp, ML, DM, Kd, 0, 0};
        pg8::StaticOrder S; S.init(g.M, g.N, G, opaque_bid());
        pg8::gemm_phase<EpiRes, pg8::StaticOrder>(lds, g, S, E);
        if (li != 3) {
            const int nkc = Kd == DFF ? 6 : 4;
            pg8::Gemm g2{Ap, Bp, MT, DM, Kd / nkc, 0, Kd};
            CtxSplitOrder S2{nkc, G, opaque_bid(), ML / 256};
            EpiPart E2{(float*)(ws + WS_PART)};
            pg8::gemm_phase<EpiPart, CtxSplitOrder>(lds, g2, S2, E2);
        }
    } else if constexpr (OP == OP_GUP) {
        pg8::Gemm g{HN - DM, WB + 14 * MEL + (size_t)li * 9 * MEL, 138 * 256, 6144, DM, 254, 0};
        pg8::StaticOrder S; S.init(g.M, g.N, G, opaque_bid());
        EpiUpConv E{RR + R_G, a.in[23] + (size_t)li * 3 * 6144, a.in[24] + (size_t)li * 6144, (LAS float*)(lds + 132096)};
        pg8::gemm_phase<EpiUpConv, pg8::StaticOrder>(lds, g, S, E);
    } else if constexpr (OP == OP_ATTN) {
        attn_phase(RR + R_Q, rep ? RR + R_YP : RR + R_Q, RR + R_K, RR + R_VT, a.in[11] + (size_t)j * NH * 465, lds, tid, lane, wave, G);
    } else if constexpr (OP == OP_LCONV) {
        lconv_phase(RR + R_REC, RR + R_XR, a.in[14] + (size_t)j * 4 * DM, a.in[15] + (size_t)j * DM, tid, G);
    } else if constexpr (OP == OP_LRUA) {
    } else if constexpr (OP == OP_LRUC) {
        lru_block_phase(RR + R_XR, RR + R_GATE, RR + R_YP, (u32x4*)HN, BDW + (size_t)j * 4 * 16 * 4096, a.in[17] + (size_t)j * 2 * DM, a.in[19] + (size_t)j * 2 * DM, a.in[20] + (size_t)j * 2 * DM, lds, lane, wave, G);
    } else if constexpr (OP == OP_FCONV) {
        const int rbeg = arg == 2 ? 0 : 16384, nrows = arg == 2 ? 16384 : (li == 3 ? 16384 : 18432);
        fconv_phase(RR + R_U, RR + R_G, a.in[23] + (size_t)li * 3 * 6144, a.in[24] + (size_t)li * 6144, rbeg, nrows, tid, G);
    }
}

#ifdef MULTI_LAUNCH
template <int OP> __global__ void __launch_bounds__(512, 2) op_kernel(Args a, int li, int arg) {
    extern __shared__ __attribute__((aligned(16))) unsigned char lds_raw[];
    run_op<OP>(a, (LAS unsigned char*)lds_raw, li, arg, 0);
}
template <int OP> static void launch_op(const Args& a, int li, int arg, int grid, hipStream_t stream) {
    static bool attr = false;
    if (!attr) { (void)hipFuncSetAttribute((const void*)op_kernel<OP>, hipFuncAttributeMaxDynamicSharedMemorySize, LDS_BYTES); attr = true; }
    hipLaunchKernelGGL(op_kernel<OP>, dim3(grid), dim3(512), LDS_BYTES, stream, a, li, arg);
}
#else
__global__ void __launch_bounds__(512, 2) fwd_kernel(Args a) {
    extern __shared__ __attribute__((aligned(16))) unsigned char lds_raw[];
    LAS unsigned char* lds = (LAS unsigned char*)lds_raw;
    cg::grid_group grid = cg::this_grid();
    volatile LAS unsigned* bst = (volatile LAS unsigned*)(lds + 131072 + 64);
    if (threadIdx.x < 4) bst[threadIdx.x] = 0u;
    __syncthreads();
    const XcdBarrier bar = xcd_barrier_post((unsigned*)(a.ws + WS_BAR), bst);
    typedef const __attribute__((address_space(4))) Args* KArgP;
    const int pc_lo = a.pc_lo, pc_hi = a.pc_hi;
    for (int pc = pc_lo; pc < pc_hi; ++pc) {
        const int op = PROG[pc][0], li = PROG[pc][1], arg = PROG[pc][2], sync = PROG[pc][3];
        KArgP kap = (KArgP)__builtin_amdgcn_kernarg_segment_ptr();
        asm volatile("" : "+s"(kap));
        const Args& a = *(const Args*)kap;
        const int rep = (op == OP_ATTN) ? arg : 0;
        switch (op) {
            case OP_PRO: run_op<OP_PRO>(a, lds, li, arg, rep); break;
            case OP_NORM: run_op<OP_NORM>(a, lds, li, arg, rep); break;
            case OP_GQK: run_op<OP_GQK>(a, lds, li, arg, rep); break;
            case OP_GST: run_op<OP_GST>(a, lds, li, arg, rep); break;
            case OP_GRES: run_op<OP_GRES>(a, lds, li, arg, rep); break;
            case OP_ATTN: run_op<OP_ATTN>(a, lds, li, arg, rep); break;
            case OP_LCONV: run_op<OP_LCONV>(a, lds, li, arg, rep); break;
            case OP_LRUA: run_op<OP_LRUA>(a, lds, li, arg, rep); break;
            case OP_LRUC: run_op<OP_LRUC>(a, lds, li, arg, rep); break;
            default: run_op<OP_GUP>(a, lds, li, arg, rep); break;
        }
        if (sync && pc + 1 < pc_hi) { if (pc == 0) grid.sync(); else xcd_barrier(bar); }
    }
}
#endif

extern "C" void kernel_launch(void* const* d_in, const int* in_sizes, int n_in, void* d_out, int out_size, void* d_ws, size_t ws_size, hipStream_t stream) {
    static int grid = 0;
    if (grid == 0) {
        if (n_in != 26 || out_size != ML * DM || ws_size < WS_END) { fprintf(stderr, "kernel_launch: unexpected shapes: n_in %d out %d ws %zu (need %zu)\n", n_in, out_size, ws_size, (size_t)WS_END); grid = -1; return; }
        int dev = 0, cus = 0, per_cu = 1;
        (void)hipGetDevice(&dev);
        (void)hipDeviceGetAttribute(&cus, hipDeviceAttributeMultiprocessorCount, dev);
#ifndef MULTI_LAUNCH
        if (hipFuncSetAttribute((const void*)fwd_kernel, hipFuncAttributeMaxDynamicSharedMemorySize, LDS_BYTES) != hipSuccess) { fprintf(stderr, "kernel_launch: hipFuncSetAttribute failed\n"); grid = -1; return; }
        if (hipOccupancyMaxActiveBlocksPerMultiprocessor(&per_cu, (const void*)fwd_kernel, 512, LDS_BYTES) != hipSuccess || per_cu < 1) { fprintf(stderr, "kernel_launch: occupancy query gave %d\n", per_cu); per_cu = 1; }
        (void)hipGetLastError();
#endif
        grid = cus * per_cu;
        fprintf(stderr, "kernel_launch: grid %d (cus %d x %d), ws %zu\n", grid, cus, per_cu, ws_size);
    }
    if (grid < 0) return;
    Args a{};
    for (int i = 0; i < 26; ++i) a.in[i] = (const float*)d_in[i];
    a.out = (float*)d_out; a.ws = (unsigned char*)d_ws;
    a.pc_lo = 0; a.pc_hi = NPROG;
#ifdef MULTI_LAUNCH
    for (int pc = 0; pc < NPROG; ++pc) {
        const int op = HOSTPROG[pc][0], li = HOSTPROG[pc][1], arg = HOSTPROG[pc][2];
        switch (op) {
            case OP_PRO: launch_op<OP_PRO>(a, li, arg, grid, stream); break;
            case OP_NORM: launch_op<OP_NORM>(a, li, arg, grid, stream); break;
            case OP_GQK: launch_op<OP_GQK>(a, li, arg, grid, stream); break;
            case OP_GST: launch_op<OP_GST>(a, li, arg, grid, stream); break;
            case OP_GRES: launch_op<OP_GRES>(a, li, arg, grid, stream); break;
            case OP_ATTN: launch_op<OP_ATTN>(a, li, arg, grid, stream); break;
            case OP_LCONV: launch_op<OP_LCONV>(a, li, arg, grid, stream); break;
            case OP_LRUA: launch_op<OP_LRUA>(a, li, arg, grid, stream); break;
            case OP_LRUC: launch_op<OP_LRUC>(a, li, arg, grid, stream); break;
            default: launch_op<OP_GUP>(a, li, arg, grid, stream); break;
        }
    }
#else
    (void)hipMemsetAsync((char*)d_ws + WS_BAR, 0, 16384, stream);
    void* args[] = {&a};
    hipError_t e = hipLaunchCooperativeKernel((const void*)fwd_kernel, dim3(grid), dim3(512), args, LDS_BYTES, stream);
    if (e != hipSuccess) fprintf(stderr, "kernel_launch: cooperative launch failed: %s (grid %d)\n", hipGetErrorString(e), grid);
#endif
}
```
